# Optimizing an MI355X kernel written in HIP

```python
import math
import jax, jax.numpy as jnp
from jax import lax
import numpy as np

D_MODEL = 1024
BATCH = 16
SEQ = 2048
DEPTH = 2

HEAD_DIM = 64
MLA_HEADS = 6
MLA_Q_RANK = 384
MLA_KV_RANK = 256
MLA_NOPE = 64
MLA_ROPE = 32
MLA_V = 64
ROPE_THETA = 10000.0
FOX_HEADS = 6
FOX_FORGET_BIAS = 3.0
NSA_HEADS = 4
NSA_BRANCHES = 3
NSA_CMP_BLOCK = 32
NSA_CMP_STRIDE = 16
NSA_CMP_HIDDEN = 128
NSA_SEL_BLOCK = 64
NSA_SEL_TOPN = 8
NSA_WINDOW = 256
NSA_FORCE_SCORE = 1.0e4
Q_BLOCK = 128
D_FF = 2816
N_EXPERTS = 8
TOP_K = 2
D_FF_EXPERT = 1408
NORM_EPS = 1e-5
DEEPNORM_ALPHA = (2 * DEPTH) ** 0.25
DEEPNORM_BETA = (8 * DEPTH) ** -0.25
MLA_COLS = MLA_Q_RANK + MLA_KV_RANK + MLA_ROPE
FOX_COLS = 3 * FOX_HEADS * HEAD_DIM + FOX_HEADS
NSA_COLS = NSA_HEADS * HEAD_DIM + 2 * NSA_BRANCHES * HEAD_DIM + NSA_HEADS * NSA_BRANCHES
IN_COLS = MLA_COLS + FOX_COLS + NSA_COLS
MIX_WIDTH = MLA_HEADS * MLA_V + FOX_HEADS * HEAD_DIM + NSA_HEADS * HEAD_DIM
N_DENSE_LAYERS = (DEPTH + 1) // 2
N_MOE_LAYERS = DEPTH // 2

kernel_name = "hymba_mla_fox_nsa_deepnorm_moe"


def layer_norm(x, g, b):
    xf = x.astype(jnp.float32)
    mu = jnp.mean(xf, -1, keepdims=True)
    var = jnp.mean(jnp.square(xf - mu), -1, keepdims=True)
    return ((xf - mu) * lax.rsqrt(var + NORM_EPS) * g + b).astype(x.dtype)


def rms_norm(x, g):
    xf = x.astype(jnp.float32)
    return (xf * lax.rsqrt(jnp.mean(xf * xf, -1, keepdims=True) + NORM_EPS) * g).astype(x.dtype)


def masked_softmax(scores, mask):
    s = jnp.where(mask, scores, -1e30)
    m = jnp.max(s, -1, keepdims=True)
    p = jnp.where(mask, jnp.exp(s - m), 0.0)
    return p / jnp.maximum(jnp.sum(p, -1, keepdims=True), 1e-30)


def alibi_slopes(n):
    return jnp.asarray([2.0 ** (-8.0 * (i + 1) / n) for i in range(n)], jnp.float32)


def rope(x, pos):
    half = x.shape[-1] // 2
    freqs = ROPE_THETA ** (-jnp.arange(half, dtype=jnp.float32) / half)
    ang = pos.astype(jnp.float32)[:, None] * freqs[None, :]
    cos, sin = jnp.cos(ang), jnp.sin(ang)
    x1 = x[..., :half].astype(jnp.float32)
    x2 = x[..., half:].astype(jnp.float32)
    return jnp.concatenate([x1 * cos - x2 * sin, x2 * cos + x1 * sin], -1).astype(x.dtype)


def split_cols(z, sizes):
    offs = np.cumsum(np.asarray(sizes))[:-1].tolist()
    return jnp.split(z, offs, axis=-1)


def blocked_causal_attention(q, k, v, decay_cum=None):
    B, H, S, dk = q.shape
    nb = S // Q_BLOCK
    scale = dk ** -0.5
    k_pos = jnp.arange(S)
    q_blocks = jnp.moveaxis(q.reshape(B, H, nb, Q_BLOCK, dk), 2, 0)
    c_blocks = None if decay_cum is None else jnp.moveaxis(decay_cum.reshape(B, H, nb, Q_BLOCK), 2, 0)

    def one_block(args):
        i, q_blk, c_blk = args
        s = jnp.einsum("bhqd,bhkd->bhqk", q_blk, k).astype(jnp.float32) * scale
        if c_blk is not None:
            s = s + (c_blk[..., :, None] - decay_cum[..., None, :])
        q_pos = i * Q_BLOCK + jnp.arange(Q_BLOCK)
        p = masked_softmax(s, q_pos[:, None] >= k_pos[None, :])
        return jnp.einsum("bhqk,bhkd->bhqd", p.astype(v.dtype), v)

    o = lax.map(one_block, (jnp.arange(nb), q_blocks, c_blocks))
    return jnp.moveaxis(o, 0, 2).reshape(B, H, S, v.shape[-1])


def mla_mixer(cq_raw, ckv_raw, kr_raw, pos, g_cq, w_uq, g_ckv, w_ukv):
    B, S, _ = cq_raw.shape
    H = MLA_HEADS
    q = (rms_norm(cq_raw, g_cq) @ w_uq).reshape(B, S, H, MLA_NOPE + MLA_ROPE).transpose(0, 2, 1, 3)
    q = jnp.concatenate([q[..., :MLA_NOPE], rope(q[..., MLA_NOPE:], pos)], -1)
    kv = (rms_norm(ckv_raw, g_ckv) @ w_ukv).reshape(B, S, H, MLA_NOPE + MLA_V).transpose(0, 2, 1, 3)
    k_nope, v = kv[..., :MLA_NOPE], kv[..., MLA_NOPE:]
    k_rope = rope(kr_raw, pos)
    k = jnp.concatenate([k_nope, jnp.broadcast_to(k_rope[:, None], (B, H, S, MLA_ROPE))], -1)
    o = blocked_causal_attention(q, k, v)
    return o.transpose(0, 2, 1, 3).reshape(B, S, H * MLA_V)


def fox_mixer(qkv, f_logit, b_forget):
    B, S, _ = qkv.shape
    H = FOX_HEADS
    qkv = qkv.reshape(B, S, 3, H, HEAD_DIM).transpose(2, 0, 3, 1, 4)
    log_f = jax.nn.log_sigmoid(f_logit.astype(jnp.float32) + b_forget)
    c = jnp.cumsum(log_f, axis=1).transpose(0, 2, 1)
    o = blocked_causal_attention(qkv[0], qkv[1], qkv[2], c)
    return o.transpose(0, 2, 1, 3).reshape(B, S, H * HEAD_DIM)


def nsa_mixer(q, k_cmp_raw, v_cmp_raw, k_slc, v_slc, k_win, v_win, gate_logit,
              cmp_k_pos, cmp_k_w1, cmp_k_w2, cmp_v_pos, cmp_v_w1, cmp_v_w2):
    B, S, _ = q.shape
    H = NSA_HEADS
    f32 = jnp.float32
    q = q.reshape(B, S, H, HEAD_DIM).transpose(0, 2, 1, 3)
    scale = HEAD_DIM ** -0.5
    slopes = alibi_slopes(H)
    pos = jnp.arange(S)

    n_cmp = (S - NSA_CMP_BLOCK) // NSA_CMP_STRIDE + 1
    starts = jnp.arange(n_cmp) * NSA_CMP_STRIDE
    blk_idx = starts[:, None] + jnp.arange(NSA_CMP_BLOCK)[None, :]

    def compress(t, pos_emb, w1, w2):
        blocks = t[:, blk_idx] + pos_emb
        return jax.nn.silu(blocks.reshape(B, n_cmp, NSA_CMP_BLOCK * HEAD_DIM) @ w1) @ w2

    k_c = compress(k_cmp_raw, cmp_k_pos, cmp_k_w1, cmp_k_w2)
    v_c = compress(v_cmp_raw, cmp_v_pos, cmp_v_w1, cmp_v_w2)
    blk_end = starts + NSA_CMP_BLOCK - 1
    dist_c = (pos[:, None] - blk_end[None, :]).astype(f32)
    s_c = jnp.einsum("bhtd,bnd->bhtn", q, k_c).astype(f32) * scale - slopes[:, None, None] * dist_c
    p_c = masked_softmax(s_c, dist_c >= 0)
    o_c = jnp.einsum("bhtn,bnd->bhtd", p_c.astype(v_c.dtype), v_c)

    n_blk = S // NSA_SEL_BLOCK
    n_sel = min(NSA_SEL_TOPN, n_blk)
    sel_start = jnp.arange(n_blk) * NSA_SEL_BLOCK
    overlap = ((starts[:, None] < sel_start[None, :] + NSA_SEL_BLOCK)
               & (starts[:, None] + NSA_CMP_BLOCK > sel_start[None, :])).astype(f32)
    imp = jnp.einsum("bhtn,nj->btj", p_c, overlap)
    cur = pos // NSA_SEL_BLOCK
    blk_ids = jnp.arange(n_blk)
    forced = (blk_ids[None, :] == 0) | (blk_ids[None, :] == cur[:, None]) | (blk_ids[None, :] == cur[:, None] - 1)
    future = sel_start[None, :] > pos[:, None]
    imp = jnp.where(forced, NSA_FORCE_SCORE, jnp.where(future, -1.0, imp))

    nb = S // Q_BLOCK
    q_blocks = jnp.moveaxis(q.reshape(B, H, nb, Q_BLOCK, HEAD_DIM), 2, 0)
    imp_blocks = jnp.moveaxis(imp.reshape(B, nb, Q_BLOCK, n_blk), 1, 0)
    pad = jnp.zeros((B, NSA_WINDOW, HEAD_DIM), k_win.dtype)
    k_win_pad = jnp.concatenate([pad, k_win], 1)
    v_win_pad = jnp.concatenate([pad, v_win], 1)
    win_len = Q_BLOCK + NSA_WINDOW

    def sel_win_block(args):
        i, q_blk, imp_blk = args
        q_pos = i * Q_BLOCK + jnp.arange(Q_BLOCK)
        _, top = lax.top_k(imp_blk, n_sel)
        tok = (top[..., None] * NSA_SEL_BLOCK + jnp.arange(NSA_SEL_BLOCK)).reshape(B, Q_BLOCK, n_sel * NSA_SEL_BLOCK)
        k_g = jax.vmap(lambda kk, ii: kk[ii])(k_slc, tok)
        v_g = jax.vmap(lambda vv, ii: vv[ii])(v_slc, tok)
        dist_s = (q_pos[None, :, None] - tok).astype(f32)
        s_s = jnp.einsum("bhqd,bqkd->bhqk", q_blk, k_g).astype(f32) * scale - slopes[None, :, None, None] * dist_s[:, None]
        p_s = masked_softmax(s_s, (dist_s >= 0)[:, None])
        o_s = jnp.einsum("bhqk,bqkd->bhqd", p_s.astype(v_g.dtype), v_g)
        k_w = lax.dynamic_slice_in_dim(k_win_pad, i * Q_BLOCK, win_len, axis=1)
        v_w = lax.dynamic_slice_in_dim(v_win_pad, i * Q_BLOCK, win_len, axis=1)
        kp = i * Q_BLOCK - NSA_WINDOW + jnp.arange(win_len)
        d_w = q_pos[:, None] - kp[None, :]
        m_w = (d_w >= 0) & (d_w < NSA_WINDOW) & (kp >= 0)[None, :]
        s_w = jnp.einsum("bhqd,bkd->bhqk", q_blk, k_w).astype(f32) * scale - slopes[:, None, None] * d_w.astype(f32)
        p_w = masked_softmax(s_w, m_w)
        o_w = jnp.einsum("bhqk,bkd->bhqd", p_w.astype(v_w.dtype), v_w)
        return o_s, o_w

    o_s, o_w = lax.map(sel_win_block, (jnp.arange(nb), q_blocks, imp_blocks))
    o_s = jnp.moveaxis(o_s, 0, 2).reshape(B, H, S, HEAD_DIM)
    o_w = jnp.moveaxis(o_w, 0, 2).reshape(B, H, S, HEAD_DIM)

    g = jax.nn.sigmoid(gate_logit.astype(f32)).reshape(B, S, H, NSA_BRANCHES).transpose(0, 2, 1, 3)
    o = (g[..., 0:1] * o_c.astype(f32) + g[..., 1:2] * o_s.astype(f32) + g[..., 2:3] * o_w.astype(f32)).astype(q.dtype)
    return o.transpose(0, 2, 1, 3).reshape(B, S, H * HEAD_DIM)


def hybrid_mixer(x, pos, w_in, b_forget, g_cq, w_uq, g_ckv, w_ukv,
                 cmp_k_pos, cmp_k_w1, cmp_k_w2, cmp_v_pos, cmp_v_w1, cmp_v_w2, w_out):
    z = x @ w_in
    (cq, ckv, kr, fox_qkv, fox_f, nsa_q, k_cmp, v_cmp, k_slc, v_slc, k_win, v_win, nsa_g) = split_cols(
        z, [MLA_Q_RANK, MLA_KV_RANK, MLA_ROPE,
            3 * FOX_HEADS * HEAD_DIM, FOX_HEADS,
            NSA_HEADS * HEAD_DIM, HEAD_DIM, HEAD_DIM, HEAD_DIM, HEAD_DIM, HEAD_DIM, HEAD_DIM,
            NSA_HEADS * NSA_BRANCHES])
    o_mla = mla_mixer(cq, ckv, kr, pos, g_cq, w_uq, g_ckv, w_ukv)
    o_fox = fox_mixer(fox_qkv, fox_f, b_forget)
    o_nsa = nsa_mixer(nsa_q, k_cmp, v_cmp, k_slc, v_slc, k_win, v_win, nsa_g,
                      cmp_k_pos, cmp_k_w1, cmp_k_w2, cmp_v_pos, cmp_v_w1, cmp_v_w2)
    return jnp.concatenate([o_mla, o_fox, o_nsa], -1) @ w_out


def swiglu(h, w1, w3, w2):
    return (jax.nn.silu(h @ w1) * (h @ w3)) @ w2


def moe_swiglu(x, router_w, w1, w3, w2):
    B, S, D = x.shape
    h = x.reshape(B * S, D)
    probs = jax.nn.softmax((h @ router_w).astype(jnp.float32), -1)
    top_p, top_i = lax.top_k(probs, TOP_K)
    top_p = top_p / jnp.sum(top_p, -1, keepdims=True)
    gates = jnp.sum(jax.nn.one_hot(top_i, N_EXPERTS, dtype=jnp.float32) * top_p[..., None], axis=1)
    out = jnp.zeros_like(h)
    for e in range(N_EXPERTS):
        out = out + gates[:, e:e + 1].astype(h.dtype) * swiglu(h, w1[e], w3[e], w2[e])
    return out.reshape(B, S, D)


def setup_inputs(seed: int = 0) -> dict:
    key = jax.random.key(seed)
    ks = iter(jax.random.split(key, 32))
    L = DEPTH
    nrm = lambda shape, scale: jax.random.normal(next(ks), shape, jnp.float32) * scale
    return {
        "x": nrm((BATCH, SEQ, D_MODEL), 1.0),
        "w_in": nrm((L, D_MODEL, IN_COLS), D_MODEL ** -0.5),
        "b_forget": FOX_FORGET_BIAS + nrm((L, FOX_HEADS), 0.1),
        "g_cq": 1.0 + nrm((L, MLA_Q_RANK), 0.02),
        "w_uq": nrm((L, MLA_Q_RANK, MLA_HEADS * (MLA_NOPE + MLA_ROPE)), MLA_Q_RANK ** -0.5),
        "g_ckv": 1.0 + nrm((L, MLA_KV_RANK), 0.02),
        "w_ukv": nrm((L, MLA_KV_RANK, MLA_HEADS * (MLA_NOPE + MLA_V)), MLA_KV_RANK ** -0.5),
        "cmp_k_pos": nrm((L, NSA_CMP_BLOCK, HEAD_DIM), 0.02),
        "cmp_k_w1": nrm((L, NSA_CMP_BLOCK * HEAD_DIM, NSA_CMP_HIDDEN), (NSA_CMP_BLOCK * HEAD_DIM) ** -0.5),
        "cmp_k_w2": nrm((L, NSA_CMP_HIDDEN, HEAD_DIM), NSA_CMP_HIDDEN ** -0.5),
        "cmp_v_pos": nrm((L, NSA_CMP_BLOCK, HEAD_DIM), 0.02),
        "cmp_v_w1": nrm((L, NSA_CMP_BLOCK * HEAD_DIM, NSA_CMP_HIDDEN), (NSA_CMP_BLOCK * HEAD_DIM) ** -0.5),
        "cmp_v_w2": nrm((L, NSA_CMP_HIDDEN, HEAD_DIM), NSA_CMP_HIDDEN ** -0.5),
        "w_out": nrm((L, MIX_WIDTH, D_MODEL), MIX_WIDTH ** -0.5 * DEEPNORM_BETA),
        "ln1_g": 1.0 + nrm((L, D_MODEL), 0.02),
        "ln1_b": nrm((L, D_MODEL), 0.02),
        "ln2_g": 1.0 + nrm((L, D_MODEL), 0.02),
        "ln2_b": nrm((L, D_MODEL), 0.02),
        "ffn_w1": nrm((N_DENSE_LAYERS, D_MODEL, D_FF), D_MODEL ** -0.5),
        "ffn_w3": nrm((N_DENSE_LAYERS, D_MODEL, D_FF), D_MODEL ** -0.5),
        "ffn_w2": nrm((N_DENSE_LAYERS, D_FF, D_MODEL), D_FF ** -0.5 * DEEPNORM_BETA),
        "router_w": nrm((N_MOE_LAYERS, D_MODEL, N_EXPERTS), D_MODEL ** -0.5),
        "moe_w1": nrm((N_MOE_LAYERS, N_EXPERTS, D_MODEL, D_FF_EXPERT), D_MODEL ** -0.5),
        "moe_w3": nrm((N_MOE_LAYERS, N_EXPERTS, D_MODEL, D_FF_EXPERT), D_MODEL ** -0.5),
        "moe_w2": nrm((N_MOE_LAYERS, N_EXPERTS, D_FF_EXPERT, D_MODEL), D_FF_EXPERT ** -0.5 * DEEPNORM_BETA),
    }


def reference(x, w_in, b_forget, g_cq, w_uq, g_ckv, w_ukv,
              cmp_k_pos, cmp_k_w1, cmp_k_w2, cmp_v_pos, cmp_v_w1, cmp_v_w2,
              w_out, ln1_g, ln1_b, ln2_g, ln2_b,
              ffn_w1, ffn_w3, ffn_w2, router_w, moe_w1, moe_w3, moe_w2):
    pos = jnp.arange(x.shape[1])
    for layer in range(DEPTH):
        mix = hybrid_mixer(x, pos, w_in[layer], b_forget[layer], g_cq[layer], w_uq[layer], g_ckv[layer], w_ukv[layer],
                           cmp_k_pos[layer], cmp_k_w1[layer], cmp_k_w2[layer],
                           cmp_v_pos[layer], cmp_v_w1[layer], cmp_v_w2[layer], w_out[layer])
        x = layer_norm(DEEPNORM_ALPHA * x + mix, ln1_g[layer], ln1_b[layer])
        j = layer // 2
        if layer % 2 == 0:
            f = swiglu(x, ffn_w1[j], ffn_w3[j], ffn_w2[j])
        else:
            f = moe_swiglu(x, router_w[j], moe_w1[j], moe_w3[j], moe_w2[j])
        x = layer_norm(DEEPNORM_ALPHA * x + f, ln2_g[layer], ln2_b[layer])
    return x
```

```cpp
#ifndef HOST_TEST
#include <hip/hip_runtime.h>
#define HD __host__ __device__ __forceinline__
#else
#include <cmath>
#include <cstdint>
#include <cstring>
#include <cstdio>
#define HD inline
#endif
#include <stdint.h>

#ifndef CFG_D
#define CFG_D 1024
#define CFG_B 16
#define CFG_S 2048
#define CFG_DFF 2816
#define CFG_DFE 1408
#endif
constexpr int D = CFG_D, NB = CFG_B, S = CFG_S, M = NB * S, DFF = CFG_DFF, DFE = CFG_DFE;
constexpr int NE = 8, MIXW = 1024, IN_COLS = 2482, NBLK = S / 64, NCMP = (S - 32) / 16 + 1;
constexpr int CMPP = S / 16;
constexpr int ZC_CQ = 0, ZC_CKV = 384, ZC_KR = 640, ZC_FOX = 672, ZC_FF = 1824, ZC_NQ = 1830, ZC_KC = 2086, ZC_VC = 2150, ZC_KS = 2214, ZC_VS = 2278, ZC_KW = 2342, ZC_VW = 2406, ZC_NG = 2470;
constexpr float LOG2E = 1.4426950408889634f;
constexpr float MLA_QS = 0.10206207261596575f * LOG2E;
constexpr float HD_QS = 0.125f * LOG2E;
constexpr float ALPHA = 1.4142135623730951f;
constexpr float EPS = 1e-5f;
typedef uint16_t bf16_t;
struct alignas(16) U4 { uint32_t x, y, z, w; };

constexpr size_t al256(size_t x) { return (x + 255) & ~(size_t)255; }
constexpr size_t OFF_CTL = 0;
constexpr size_t OFF_XB = 65536;
constexpr size_t OFF_MIX = OFF_XB + al256((size_t)M * D * 2);
constexpr size_t OFF_EIDX = OFF_MIX + al256((size_t)M * MIXW * 2);
constexpr size_t OFF_EGATE = OFF_EIDX + al256((size_t)M * 2 * 4);
constexpr size_t OFF_ARENA = OFF_EGATE + al256((size_t)M * 2 * 4);
constexpr size_t OFF_CQ = OFF_ARENA;
constexpr size_t OFF_CKV = OFF_CQ + al256((size_t)M * 384 * 2);
constexpr size_t OFF_RQ = OFF_CKV + al256((size_t)M * 256 * 2);
constexpr size_t OFF_RKV = OFF_RQ + al256((size_t)M * 4);
constexpr size_t OFF_QM = OFF_RKV + al256((size_t)M * 4);
constexpr size_t OFF_KM = OFF_QM + al256((size_t)M * 576 * 2);
constexpr size_t OFF_VM = OFF_KM + al256((size_t)M * 576 * 2);
constexpr size_t OFF_FQ = OFF_VM + al256((size_t)M * 384 * 2);
constexpr size_t OFF_FK = OFF_FQ + al256((size_t)M * 384 * 2);
constexpr size_t OFF_FV = OFF_FK + al256((size_t)M * 384 * 2);
constexpr size_t OFF_FL = OFF_FV + al256((size_t)M * 384 * 2);
constexpr size_t OFF_FC = OFF_FL + al256((size_t)M * 8 * 4);
constexpr size_t OFF_NQ = OFF_FC + al256((size_t)NB * 6 * S * 4);
constexpr size_t OFF_KCR = OFF_NQ + al256((size_t)M * 256 * 2);
constexpr size_t OFF_VCR = OFF_KCR + al256((size_t)(M * 64 + 2048) * 2);
constexpr size_t OFF_KS = OFF_VCR + al256((size_t)(M * 64 + 2048) * 2);
constexpr size_t OFF_VS = OFF_KS + al256((size_t)M * 64 * 2);
constexpr size_t OFF_KW = OFF_VS + al256((size_t)M * 64 * 2);
constexpr size_t OFF_VW = OFF_KW + al256((size_t)M * 64 * 2);
constexpr size_t OFF_NG = OFF_VW + al256((size_t)M * 64 * 2);
constexpr size_t OFF_HID = OFF_NG + al256((size_t)M * 16 * 4);
constexpr size_t OFF_KCC = OFF_HID + al256((size_t)2 * NB * CMPP * 128 * 4);
constexpr size_t OFF_VCC = OFF_KCC + al256((size_t)NB * CMPP * 64 * 2);
constexpr size_t OFF_CST = OFF_VCC + al256((size_t)NB * CMPP * 64 * 2);
constexpr size_t OFF_IMP = OFF_CST + al256((size_t)M * 8 * 4);
constexpr size_t OFF_SEL = OFF_IMP + al256((size_t)M * 32 * 4);
constexpr size_t OFF_ARENA_END = OFF_SEL + al256((size_t)M * 4);
constexpr size_t OFF_H = OFF_ARENA;
constexpr size_t OFF_H2 = OFF_ARENA;
static_assert(OFF_H + (size_t)M * DFF * 2 <= OFF_ARENA_END && OFF_H2 + (size_t)M * 2 * DFE * 2 <= OFF_ARENA_END, "overlay fits");
constexpr size_t WS_NEEDED = OFF_ARENA_END;

struct P {
    const float *x, *w_in, *b_forget, *g_cq, *w_uq, *g_ckv, *w_ukv, *ckp, *ckw1, *ckw2, *cvp, *cvw1, *cvw2, *w_out, *ln1g, *ln1b, *ln2g, *ln2b, *fw1, *fw3, *fw2, *rw, *mw1, *mw3, *mw2;
    float* out; unsigned char* ws;
};
#define WSP(T, off) ((T*)(p.ws + (off)))

HD float u2f(uint32_t u) { return __builtin_bit_cast(float, u); }
HD uint32_t f2u(float f) { return __builtin_bit_cast(uint32_t, f); }
HD float bf2f(bf16_t v) { return u2f((uint32_t)v << 16); }
HD bf16_t f2bf(float f) { uint32_t u = f2u(f); return (bf16_t)((u + 0x7fffu + ((u >> 16) & 1u)) >> 16); }
HD float bflo(uint32_t u) { return u2f(u << 16); }
HD float bfhi(uint32_t u) { return u2f(u & 0xffff0000u); }
HD float sigmoidf_(float x) { return 1.0f / (1.0f + expf(-x)); }
HD float siluf_(float x) { return x / (1.0f + expf(-x)); }
HD float dot8(const U4& a, const float* w) { return bflo(a.x) * w[0] + bfhi(a.x) * w[1] + bflo(a.y) * w[2] + bfhi(a.y) * w[3] + bflo(a.z) * w[4] + bfhi(a.z) * w[5] + bflo(a.w) * w[6] + bfhi(a.w) * w[7]; }
HD void unpack8(const U4& a, float* w) { w[0] = bflo(a.x); w[1] = bfhi(a.x); w[2] = bflo(a.y); w[3] = bfhi(a.y); w[4] = bflo(a.z); w[5] = bfhi(a.z); w[6] = bflo(a.w); w[7] = bfhi(a.w); }
HD void rope_cs(int pos, int i, float& c, float& s) {
    const float fr = exp2f(-(float)i * 0.830482023721841f);
    double a = (double)pos * (double)fr; a -= 6.283185307179586 * floor(a * 0.15915494309189535);
#ifdef HOST_TEST
    c = (float)cos(a); s = (float)sin(a);
#else
    c = __cosf((float)a); s = __sinf((float)a);
#endif
}

template <int RG> HD void dot_rows(const bf16_t* A, long lda, const float* W, long ldw, int K, const float* gk, float (&acc)[RG]) {
#pragma unroll
    for (int r = 0; r < RG; ++r) acc[r] = 0.f;
    for (int k = 0; k < K; k += 8) {
        float w[8];
#pragma unroll
        for (int j = 0; j < 8; ++j) w[j] = W[(long)(k + j) * ldw] * (gk ? gk[k + j] : 1.f);
#pragma unroll
        for (int r = 0; r < RG; ++r) { const U4 a = *(const U4*)(A + r * lda + k); acc[r] += dot8(a, w); }
    }
}
constexpr int RG = 8;

HD void nv_prologue(const P& p, long gtid, long gn) {
    bf16_t* xb = WSP(bf16_t, OFF_XB);
    for (long i = gtid; i < (long)M * D; i += gn) xb[i] = f2bf(p.x[i]);
    bf16_t* kcr = WSP(bf16_t, OFF_KCR); bf16_t* vcr = WSP(bf16_t, OFF_VCR);
    for (long i = gtid; i < 2048; i += gn) { kcr[(long)M * 64 + i] = 0; vcr[(long)M * 64 + i] = 0; }
}

HD void store_z(const P& p, long row, int col, float v) {
    if (col < ZC_CKV) WSP(bf16_t, OFF_CQ)[row * 384 + col] = f2bf(v);
    else if (col < ZC_KR) WSP(bf16_t, OFF_CKV)[row * 256 + (col - ZC_CKV)] = f2bf(v);
    else if (col < ZC_FOX) {   }
    else if (col < ZC_FF) { const int c = col - ZC_FOX, which = c / 384, hd = c % 384;
        if (which == 0) WSP(bf16_t, OFF_FQ)[row * 384 + hd] = f2bf(v * HD_QS);
        else if (which == 1) WSP(bf16_t, OFF_FK)[row * 384 + hd] = f2bf(v);
        else WSP(bf16_t, OFF_FV)[row * 384 + hd] = f2bf(v); }
    else if (col < ZC_NQ) WSP(float, OFF_FL)[row * 8 + (col - ZC_FF)] = v;
    else if (col < ZC_KC) WSP(bf16_t, OFF_NQ)[row * 256 + (col - ZC_NQ)] = f2bf(v * HD_QS);
    else if (col < ZC_VC) WSP(bf16_t, OFF_KCR)[row * 64 + (col - ZC_KC)] = f2bf(v);
    else if (col < ZC_KS) WSP(bf16_t, OFF_VCR)[row * 64 + (col - ZC_VC)] = f2bf(v);
    else if (col < ZC_VS) WSP(bf16_t, OFF_KS)[row * 64 + (col - ZC_KS)] = f2bf(v);
    else if (col < ZC_KW) WSP(bf16_t, OFF_VS)[row * 64 + (col - ZC_VS)] = f2bf(v);
    else if (col < ZC_VW) WSP(bf16_t, OFF_KW)[row * 64 + (col - ZC_KW)] = f2bf(v);
    else if (col < ZC_NG) WSP(bf16_t, OFF_VW)[row * 64 + (col - ZC_VW)] = f2bf(v);
    else WSP(float, OFF_NG)[row * 16 + (col - ZC_NG)] = v;
}

HD void nv_inproj(const P& p, int layer, long gtid, long gn) {
    const bf16_t* xb = WSP(bf16_t, OFF_XB); const float* w = p.w_in + (size_t)layer * D * IN_COLS;
    for (long it = gtid; it < (long)(M / RG) * IN_COLS; it += gn) {
        const long rg = it / IN_COLS; const int col = (int)(it % IN_COLS); const long r0 = rg * RG;
        if (col >= ZC_KR + 16 && col < ZC_FOX) continue;
        float acc[RG]; dot_rows<RG>(xb + r0 * D, D, w + col, IN_COLS, D, nullptr, acc);
        if (col >= ZC_KR && col < ZC_KR + 16) {
            float acc2[RG]; dot_rows<RG>(xb + r0 * D, D, w + col + 16, IN_COLS, D, nullptr, acc2);
            const int i = col - ZC_KR;
#pragma unroll
            for (int r = 0; r < RG; ++r) { const long row = r0 + r; float c, s; rope_cs((int)(row % S), i, c, s);
                const bf16_t o1 = f2bf(acc[r] * c - acc2[r] * s), o2 = f2bf(acc2[r] * c + acc[r] * s);
                bf16_t* km = WSP(bf16_t, OFF_KM) + row * 576;
                for (int h = 0; h < 6; ++h) { km[h * 96 + 64 + i] = o1; km[h * 96 + 80 + i] = o2; } }
        } else {
#pragma unroll
            for (int r = 0; r < RG; ++r) store_z(p, r0 + r, col, acc[r]);
        }
    }
}

HD void nv_post1(const P& p, int layer, long gtid, long gn) {
    for (long row = gtid; row < M; row += gn) {
        const bf16_t* cq = WSP(bf16_t, OFF_CQ) + row * 384; const bf16_t* ckv = WSP(bf16_t, OFF_CKV) + row * 256;
        float s1 = 0.f, s2 = 0.f;
        for (int k = 0; k < 384; ++k) { const float v = bf2f(cq[k]); s1 += v * v; }
        for (int k = 0; k < 256; ++k) { const float v = bf2f(ckv[k]); s2 += v * v; }
        WSP(float, OFF_RQ)[row] = 1.0f / sqrtf(s1 / 384.f + EPS); WSP(float, OFF_RKV)[row] = 1.0f / sqrtf(s2 / 256.f + EPS);
    }
    for (long it = gtid; it < NB * 6; it += gn) {
        const int b = (int)(it / 6), h = (int)(it % 6); const float bias = p.b_forget[layer * 6 + h];
        const float* fl = WSP(float, OFF_FL) + (long)b * S * 8 + h; float* fc = WSP(float, OFF_FC) + ((long)b * 6 + h) * S;
        float c = 0.f;
        for (int t = 0; t < S; ++t) { const float xv = fl[(long)t * 8] + bias;
            const float ls = fminf(xv, 0.f) - log1pf(expf(-fabsf(xv)));
            c += ls; fc[t] = c * LOG2E; }
    }
}

HD void nv_up(const P& p, int layer, long gtid, long gn) {
    { const bf16_t* cq = WSP(bf16_t, OFF_CQ); const float* w = p.w_uq + (size_t)layer * 384 * 576; const float* g = p.g_cq + layer * 384; const float* rq = WSP(float, OFF_RQ);
      bf16_t* qm = WSP(bf16_t, OFF_QM);
      for (long it = gtid; it < (long)(M / RG) * 480; it += gn) {
          const long rg = it / 480; const int j = (int)(it % 480), h = j / 80, c = j % 80; const long r0 = rg * RG;
          if (c < 64) { float acc[RG]; dot_rows<RG>(cq + r0 * 384, 384, w + h * 96 + c, 576, 384, g, acc);
#pragma unroll
              for (int r = 0; r < RG; ++r) qm[(r0 + r) * 576 + h * 96 + c] = f2bf(acc[r] * rq[r0 + r] * MLA_QS);
          } else { const int i = c - 64; float a1[RG], a2[RG];
              dot_rows<RG>(cq + r0 * 384, 384, w + h * 96 + 64 + i, 576, 384, g, a1); dot_rows<RG>(cq + r0 * 384, 384, w + h * 96 + 80 + i, 576, 384, g, a2);
#pragma unroll
              for (int r = 0; r < RG; ++r) { const long row = r0 + r; float cs, sn; rope_cs((int)(row % S), i, cs, sn); const float x1 = a1[r] * rq[row], x2 = a2[r] * rq[row];
                  qm[row * 576 + h * 96 + 64 + i] = f2bf((x1 * cs - x2 * sn) * MLA_QS); qm[row * 576 + h * 96 + 80 + i] = f2bf((x2 * cs + x1 * sn) * MLA_QS); } }
      } }
    { const bf16_t* ckv = WSP(bf16_t, OFF_CKV); const float* w = p.w_ukv + (size_t)layer * 256 * 768; const float* g = p.g_ckv + layer * 256; const float* rkv = WSP(float, OFF_RKV);
      for (long it = gtid; it < (long)(M / RG) * 768; it += gn) {
          const long rg = it / 768; const int col = (int)(it % 768), h = col / 128, c = col % 128; const long r0 = rg * RG;
          float acc[RG]; dot_rows<RG>(ckv + r0 * 256, 256, w + col, 768, 256, g, acc);
#pragma unroll
          for (int r = 0; r < RG; ++r) { const float v = acc[r] * rkv[r0 + r];
              if (c < 64) WSP(bf16_t, OFF_KM)[(r0 + r) * 576 + h * 96 + c] = f2bf(v); else WSP(bf16_t, OFF_VM)[(r0 + r) * 384 + h * 64 + (c - 64)] = f2bf(v); }
      } }
    for (long it = gtid; it < (long)2 * NB * CMPP * 128; it += gn) {
        const int j = (int)(it % 128); const long t2 = it / 128; const int n = (int)(t2 % CMPP); const long t3 = t2 / CMPP; const int b = (int)(t3 % NB), wch = (int)(t3 / NB);
        float* hid = WSP(float, OFF_HID);
        if (n >= NCMP) { hid[it] = 0.f; continue; }
        const bf16_t* T = WSP(bf16_t, wch ? OFF_VCR : OFF_KCR) + ((long)b * S + 16 * n) * 64;
        const float* pe = (wch ? p.cvp : p.ckp) + (size_t)layer * 2048; const float* w1 = (wch ? p.cvw1 : p.ckw1) + (size_t)layer * 2048 * 128 + j;
        float acc = 0.f;
        for (int k = 0; k < 2048; ++k) acc += (bf2f(T[k]) + pe[k]) * w1[(long)k * 128];
        hid[it] = siluf_(acc);
    }
}

HD void nv_cmp2(const P& p, int layer, long gtid, long gn) {
    for (long it = gtid; it < (long)2 * NB * CMPP * 64; it += gn) {
        const int d = (int)(it % 64); const long t2 = it / 64; const int n = (int)(t2 % CMPP); const long t3 = t2 / CMPP; const int b = (int)(t3 % NB), wch = (int)(t3 / NB);
        const float* hid = WSP(float, OFF_HID) + (((long)wch * NB + b) * CMPP + n) * 128; const float* w2 = (wch ? p.cvw2 : p.ckw2) + (size_t)layer * 128 * 64 + d;
        float acc = 0.f;
        for (int j = 0; j < 128; ++j) acc += hid[j] * w2[j * 64];
        WSP(bf16_t, wch ? OFF_VCC : OFF_KCC)[((long)b * CMPP + n) * 64 + d] = f2bf(acc);
    }
}

HD float slope2(int h) { return LOG2E * (h == 0 ? 0.25f : h == 1 ? 0.0625f : h == 2 ? 0.015625f : 0.00390625f); }

template <int DK> HD float qk_dot(const float (&q)[DK], const bf16_t* k) {
    float s = 0.f;
#pragma unroll
    for (int d = 0; d < DK; d += 8) { const U4 a = *(const U4*)(k + d); s += dot8(a, &q[d]); }
    return s;
}
template <int DK> HD void load_q(float (&q)[DK], const bf16_t* src) {
#pragma unroll
    for (int d = 0; d < DK; d += 8) { const U4 a = *(const U4*)(src + d); unpack8(a, &q[d]); }
}
HD void sm_step(float sc, const bf16_t* v, float& m, float& l, float (&o)[64]) {
    if (sc > m) { const float f = exp2f(m - sc); l *= f;
#pragma unroll
        for (int d = 0; d < 64; ++d) o[d] *= f;
        m = sc; }
    const float pp = exp2f(sc - m); l += pp;
#pragma unroll
    for (int d = 0; d < 64; d += 8) { const U4 a = *(const U4*)(v + d); float vv[8]; unpack8(a, vv);
#pragma unroll
        for (int j = 0; j < 8; ++j) o[d + j] += pp * vv[j]; }
}

HD void nv_nsa_a(const P& p, long gtid, long gn) {
    for (long it = gtid; it < (long)M * 4; it += gn) {
        const int t = (int)(it % S); const long t2 = it / S; const int h = (int)(t2 % 4), b = (int)(t2 / 4); const long row = (long)b * S + t;
        float q[64]; load_q<64>(q, WSP(bf16_t, OFF_NQ) + row * 256 + h * 64);
        const int nmax = t >= 31 ? ((t - 31) / 16 < NCMP - 1 ? (t - 31) / 16 : NCMP - 1) : -1; const float sl = slope2(h);
        float m = -INFINITY, l = 0.f;
        for (int n = 0; n <= nmax; ++n) { const float sc = qk_dot<64>(q, WSP(bf16_t, OFF_KCC) + ((long)b * CMPP + n) * 64) - sl * (float)(t - (16 * n + 31));
            if (sc > m) { l *= exp2f(m - sc); m = sc; } l += exp2f(sc - m); }
        float* cst = WSP(float, OFF_CST) + (row * 4 + h) * 2; cst[0] = nmax >= 0 ? m : 0.f; cst[1] = l;
    }
}
HD void nv_nsa_b(const P& p, long gtid, long gn) {
    for (long it = gtid; it < (long)M * NBLK; it += gn) {
        const int j = (int)(it % NBLK); const long row = it / NBLK; const int t = (int)(row % S), b = (int)(row / S), cur = t / 64;
        float imp;
        if (j == 0 || j == cur || j == cur - 1) imp = 1.0e4f;
        else if (64 * j > t) imp = -1.0f;
        else { imp = 0.f;
            for (int h = 0; h < 4; ++h) { float q[64]; load_q<64>(q, WSP(bf16_t, OFF_NQ) + row * 256 + h * 64); const float* cst = WSP(float, OFF_CST) + (row * 4 + h) * 2; const float m = cst[0], l = cst[1], sl = slope2(h);
                float sum = 0.f;
                for (int n = 4 * j - 1; n <= 4 * j + 3; ++n) { if (n < 0 || n >= NCMP || 16 * n + 31 > t) continue;
                    const float sc = qk_dot<64>(q, WSP(bf16_t, OFF_KCC) + ((long)b * CMPP + n) * 64) - sl * (float)(t - (16 * n + 31)); sum += exp2f(sc - m); }
                imp += sum / fmaxf(l, 1e-30f); } }
        WSP(float, OFF_IMP)[row * 32 + j] = imp;
    }
}
HD void nv_nsa_c(const P& p, long gtid, long gn) {
    for (long row = gtid; row < M; row += gn) {
        const float* imp = WSP(float, OFF_IMP) + row * 32; uint32_t mask = 0;
        for (int j = 0; j < NBLK; ++j) { const float v = imp[j]; int rank = 0;
            for (int k = 0; k < NBLK; ++k) { const float u = imp[k]; rank += (u > v || (u == v && k < j)) ? 1 : 0; }
            if (rank < 8) mask |= 1u << j; }
        WSP(uint32_t, OFF_SEL)[row] = mask;
    }
}

HD void nv_attn(const P& p, long gtid, long gn) {
    for (long it = gtid; it < (long)M * 6; it += gn) {
        const int t = (int)(it % S); const long t2 = it / S; const int h = (int)(t2 % 6), b = (int)(t2 / 6); const long row = (long)b * S + t;
        float q[96]; load_q<96>(q, WSP(bf16_t, OFF_QM) + row * 576 + h * 96);
        float o[64]; float m = -INFINITY, l = 0.f;
#pragma unroll
        for (int d = 0; d < 64; ++d) o[d] = 0.f;
        for (int s = 0; s <= t; ++s) { const long sr = (long)b * S + s; const float sc = qk_dot<96>(q, WSP(bf16_t, OFF_KM) + sr * 576 + h * 96); sm_step(sc, WSP(bf16_t, OFF_VM) + sr * 384 + h * 64, m, l, o); }
        const float il = 1.0f / l; bf16_t* dst = WSP(bf16_t, OFF_MIX) + row * MIXW + h * 64;
#pragma unroll
        for (int d = 0; d < 64; ++d) dst[d] = f2bf(o[d] * il);
    }
    for (long it = gtid; it < (long)M * 6; it += gn) {
        const int t = (int)(it % S); const long t2 = it / S; const int h = (int)(t2 % 6), b = (int)(t2 / 6); const long row = (long)b * S + t;
        float q[64]; load_q<64>(q, WSP(bf16_t, OFF_FQ) + row * 384 + h * 64);
        const float* fc = WSP(float, OFF_FC) + ((long)b * 6 + h) * S; const float ct = fc[t];
        float o[64]; float m = -INFINITY, l = 0.f;
#pragma unroll
        for (int d = 0; d < 64; ++d) o[d] = 0.f;
        for (int s = 0; s <= t; ++s) { const long sr = (long)b * S + s; const float sc = qk_dot<64>(q, WSP(bf16_t, OFF_FK) + sr * 384 + h * 64) + (ct - fc[s]); sm_step(sc, WSP(bf16_t, OFF_FV) + sr * 384 + h * 64, m, l, o); }
        const float il = 1.0f / l; bf16_t* dst = WSP(bf16_t, OFF_MIX) + row * MIXW + 384 + h * 64;
#pragma unroll
        for (int d = 0; d < 64; ++d) dst[d] = f2bf(o[d] * il);
    }
    for (long it = gtid; it < (long)M * 4; it += gn) {
        const int t = (int)(it % S); const long t2 = it / S; const int h = (int)(t2 % 4), b = (int)(t2 / 4); const long row = (long)b * S + t; const float sl = slope2(h);
        float q[64]; load_q<64>(q, WSP(bf16_t, OFF_NQ) + row * 256 + h * 64);
        const float* ng = WSP(float, OFF_NG) + row * 16 + h * 3;
        float out[64], o[64];
#pragma unroll
        for (int d = 0; d < 64; ++d) out[d] = 0.f;
        {
            const int nmax = t >= 31 ? ((t - 31) / 16 < NCMP - 1 ? (t - 31) / 16 : NCMP - 1) : -1;
            if (nmax >= 0) { float m = -INFINITY, l = 0.f;
#pragma unroll
                for (int d = 0; d < 64; ++d) o[d] = 0.f;
                for (int n = 0; n <= nmax; ++n) { const long cr = ((long)b * CMPP + n) * 64; const float sc = qk_dot<64>(q, WSP(bf16_t, OFF_KCC) + cr) - sl * (float)(t - (16 * n + 31)); sm_step(sc, WSP(bf16_t, OFF_VCC) + cr, m, l, o); }
                const float g = sigmoidf_(ng[0]) / l;
#pragma unroll
                for (int d = 0; d < 64; ++d) out[d] += g * o[d]; } }
        {
            const uint32_t mask = WSP(uint32_t, OFF_SEL)[row]; float m = -INFINITY, l = 0.f;
#pragma unroll
            for (int d = 0; d < 64; ++d) o[d] = 0.f;
            for (int j = 0; j <= t / 64; ++j) { if (!((mask >> j) & 1u)) continue;
                const int s1 = (64 * j + 63 < t) ? 64 * j + 63 : t;
                for (int s = 64 * j; s <= s1; ++s) { const long sr = ((long)b * S + s) * 64; const float sc = qk_dot<64>(q, WSP(bf16_t, OFF_KS) + sr) - sl * (float)(t - s); sm_step(sc, WSP(bf16_t, OFF_VS) + sr, m, l, o); } }
            const float g = sigmoidf_(ng[1]) / l;
#pragma unroll
            for (int d = 0; d < 64; ++d) out[d] += g * o[d]; }
        {
            float m = -INFINITY, l = 0.f;
#pragma unroll
            for (int d = 0; d < 64; ++d) o[d] = 0.f;
            for (int s = (t >= 255 ? t - 255 : 0); s <= t; ++s) { const long sr = ((long)b * S + s) * 64; const float sc = qk_dot<64>(q, WSP(bf16_t, OFF_KW) + sr) - sl * (float)(t - s); sm_step(sc, WSP(bf16_t, OFF_VW) + sr, m, l, o); }
            const float g = sigmoidf_(ng[2]) / l;
#pragma unroll
            for (int d = 0; d < 64; ++d) out[d] += g * o[d]; }
        bf16_t* dst = WSP(bf16_t, OFF_MIX) + row * MIXW + 768 + h * 64;
#pragma unroll
        for (int d = 0; d < 64; ++d) dst[d] = f2bf(out[d]);
    }
}

HD void nv_wout(const P& p, int layer, long gtid, long gn) {
    const bf16_t* mix = WSP(bf16_t, OFF_MIX); const float* w = p.w_out + (size_t)layer * MIXW * D; const float* base = layer == 0 ? p.x : p.out;
    for (long it = gtid; it < (long)(M / RG) * D; it += gn) {
        const long rg = it / D; const int col = (int)(it % D); const long r0 = rg * RG;
        float acc[RG]; dot_rows<RG>(mix + r0 * MIXW, MIXW, w + col, D, MIXW, nullptr, acc);
#pragma unroll
        for (int r = 0; r < RG; ++r) p.out[(r0 + r) * D + col] = ALPHA * base[(r0 + r) * D + col] + acc[r];
    }
}

HD void nv_ln(const P& p, const float* g, const float* bta, const float* rw, long gtid, long gn) {
    for (long row = gtid; row < M; row += gn) {
        float* xr = p.out + row * D; bf16_t* xb = WSP(bf16_t, OFF_XB) + row * D;
        float s = 0.f; for (int k = 0; k < D; ++k) s += xr[k];
        const float mu = s / D; float q = 0.f; for (int k = 0; k < D; ++k) { const float d = xr[k] - mu; q += d * d; }
        const float rs = 1.0f / sqrtf(q / D + EPS);
        float lg[NE];
#pragma unroll
        for (int e = 0; e < NE; ++e) lg[e] = 0.f;
        for (int k = 0; k < D; ++k) { const float v = (xr[k] - mu) * rs * g[k] + bta[k]; xr[k] = v; xb[k] = f2bf(v);
            if (rw) {
#pragma unroll
                for (int e = 0; e < NE; ++e) lg[e] += v * rw[k * NE + e]; } }
        if (rw) { float mx = lg[0];
#pragma unroll
            for (int e = 1; e < NE; ++e) mx = fmaxf(mx, lg[e]);
            float pr[NE]; float sum = 0.f;
#pragma unroll
            for (int e = 0; e < NE; ++e) { pr[e] = expf(lg[e] - mx); sum += pr[e]; }
            int i1 = 0; float p1 = pr[0] / sum;
#pragma unroll
            for (int e = 1; e < NE; ++e) { const float pe = pr[e] / sum; if (pe > p1) { p1 = pe; i1 = e; } }
            int i2 = -1; float p2 = -1.f;
#pragma unroll
            for (int e = 0; e < NE; ++e) { const float pe = pr[e] / sum; if (e != i1 && pe > p2) { p2 = pe; i2 = e; } }
            WSP(int, OFF_EIDX)[row * 2] = i1; WSP(int, OFF_EIDX)[row * 2 + 1] = i2;
            WSP(float, OFF_EGATE)[row * 2] = p1 / (p1 + p2); WSP(float, OFF_EGATE)[row * 2 + 1] = p2 / (p1 + p2); }
    }
}

HD void nv_ffn_up(const P& p, long gtid, long gn) {
    const bf16_t* xb = WSP(bf16_t, OFF_XB); bf16_t* hb = WSP(bf16_t, OFF_H);
    for (long it = gtid; it < (long)(M / RG) * DFF; it += gn) {
        const long rg = it / DFF; const int j = (int)(it % DFF); const long r0 = rg * RG;
        float a[RG], c[RG]; dot_rows<RG>(xb + r0 * D, D, p.fw1 + j, DFF, D, nullptr, a); dot_rows<RG>(xb + r0 * D, D, p.fw3 + j, DFF, D, nullptr, c);
#pragma unroll
        for (int r = 0; r < RG; ++r) hb[(r0 + r) * DFF + j] = f2bf(siluf_(a[r]) * c[r]);
    }
}
HD void nv_ffn_down(const P& p, long gtid, long gn) {
    const bf16_t* hb = WSP(bf16_t, OFF_H);
    for (long it = gtid; it < (long)(M / RG) * D; it += gn) {
        const long rg = it / D; const int col = (int)(it % D); const long r0 = rg * RG;
        float acc[RG]; dot_rows<RG>(hb + r0 * DFF, DFF, p.fw2 + col, D, DFF, nullptr, acc);
#pragma unroll
        for (int r = 0; r < RG; ++r) p.out[(r0 + r) * D + col] = ALPHA * p.out[(r0 + r) * D + col] + acc[r];
    }
}
HD void nv_moe_up(const P& p, long gtid, long gn) {
    const bf16_t* xb = WSP(bf16_t, OFF_XB); bf16_t* h2 = WSP(bf16_t, OFF_H2);
    for (long it = gtid; it < (long)M * 2 * DFE; it += gn) {
        const int j = (int)(it % DFE); const long rs = it / DFE; const long row = rs / 2; const int e = WSP(int, OFF_EIDX)[rs];
        float a[1], c[1]; dot_rows<1>(xb + row * D, D, p.mw1 + (size_t)e * D * DFE + j, DFE, D, nullptr, a); dot_rows<1>(xb + row * D, D, p.mw3 + (size_t)e * D * DFE + j, DFE, D, nullptr, c);
        h2[rs * DFE + j] = f2bf(siluf_(a[0]) * c[0]);
    }
}
HD void nv_moe_down(const P& p, long gtid, long gn) {
    const bf16_t* h2 = WSP(bf16_t, OFF_H2);
    for (long it = gtid; it < (long)M * D; it += gn) {
        const int col = (int)(it % D); const long row = it / D; float tot = 0.f;
        for (int sl = 0; sl < 2; ++sl) { const int e = WSP(int, OFF_EIDX)[row * 2 + sl]; float acc[1];
            dot_rows<1>(h2 + (row * 2 + sl) * DFE, DFE, p.mw2 + (size_t)e * DFE * D + col, D, DFE, nullptr, acc); tot += WSP(float, OFF_EGATE)[row * 2 + sl] * acc[0]; }
        p.out[it] = ALPHA * p.out[it] + tot;
    }
}

constexpr int N_LAYER_PHASES = 13;
HD void run_phase(const P& p, int ph, int layer, long gtid, long gn) {
    switch (ph) {
        case 0: nv_prologue(p, gtid, gn); break;
        case 1: nv_inproj(p, layer, gtid, gn); break;
        case 2: nv_post1(p, layer, gtid, gn); break;
        case 3: nv_up(p, layer, gtid, gn); break;
        case 4: nv_cmp2(p, layer, gtid, gn); break;
        case 5: nv_nsa_a(p, gtid, gn); break;
        case 6: nv_nsa_b(p, gtid, gn); break;
        case 7: nv_nsa_c(p, gtid, gn); break;
        case 8: nv_attn(p, gtid, gn); break;
        case 9: nv_wout(p, layer, gtid, gn); break;
        case 10: nv_ln(p, p.ln1g + layer * D, p.ln1b + layer * D, (layer & 1) ? p.rw : nullptr, gtid, gn); break;
        case 11: if (layer & 1) nv_moe_up(p, gtid, gn); else nv_ffn_up(p, gtid, gn); break;
        case 12: if (layer & 1) nv_moe_down(p, gtid, gn); else nv_ffn_down(p, gtid, gn); break;
        case 13: nv_ln(p, p.ln2g + layer * D, p.ln2b + layer * D, nullptr, gtid, gn); break;
    }
}

#ifndef HOST_TEST
#define XB_TMO      128
#define XB_XCNT(j)  (256  + 64 * (j))
#define XB_XSUB(j)  (1280 + 64 * (j))
#define XB_XGEN(j)  (2304 + 64 * (j))
#define XB_TOP      3328
#define XB_TOPGEN   3392
#define XCD_BAR_WORDS 3456
#define XB_SPIN_CAP (1u << 24)
#define LAS __attribute__((address_space(3)))

__device__ __forceinline__ unsigned xb_ld(unsigned* p)              { return __hip_atomic_load(p, __ATOMIC_RELAXED, __HIP_MEMORY_SCOPE_AGENT); }
__device__ __forceinline__ unsigned xb_add(unsigned* p, unsigned v) { return __hip_atomic_fetch_add(p, v, __ATOMIC_RELAXED, __HIP_MEMORY_SCOPE_AGENT); }
__device__ __forceinline__ unsigned xb_xcc_id() { return (unsigned)__builtin_amdgcn_s_getreg((3 << 11) | 20) & 0xFu; }
#define XB_SPIN(cond, bar) do { unsigned _sp = 0; while (cond) { __builtin_amdgcn_s_sleep(1); \
    if ((++_sp & 255u) == 0u) { if (xb_ld(&(bar)[XB_TMO])) break; if (_sp > XB_SPIN_CAP) { atomicAdd(&(bar)[XB_TMO], 1u); break; } } } } while (0)

struct XcdBarrier {
    unsigned* bar; unsigned x;
    volatile LAS unsigned* st;
};
__device__ __forceinline__ XcdBarrier xcd_barrier_post(unsigned* bar, volatile LAS unsigned* st) {
    XcdBarrier b; b.bar = bar; b.x = xb_xcc_id(); b.st = st;
    if (threadIdx.x == 0) (void)xb_add(&bar[XB_XCNT(b.x)], 1u);
    return b;
}
__device__ __forceinline__ void xcd_barrier_complete(unsigned* bar, unsigned x, unsigned& nloc, unsigned& nx) {
    const unsigned G = gridDim.x * gridDim.y * gridDim.z;
    unsigned sum, cnt, mine, sp = 0u;
    for (;;) {
        sum = 0u; cnt = 0u; mine = 0u;
#pragma unroll
        for (unsigned j = 0; j < 16; ++j) { const unsigned c = xb_ld(&bar[XB_XCNT(j)]); sum += c; cnt += (c > 0u) ? 1u : 0u; mine = (j == x) ? c : mine; }
        if (sum == G) break;
        __builtin_amdgcn_s_sleep(1);
        if ((++sp & 255u) == 0u) { if (xb_ld(&bar[XB_TMO])) break; if (sp > XB_SPIN_CAP) { atomicAdd(&bar[XB_TMO], 1u); break; } }
    }
    nloc = mine > 0u ? mine : 1u; nx = cnt > 0u ? cnt : 1u;
}
__device__ __forceinline__ void xcd_barrier(const XcdBarrier& b) {
    asm volatile("s_waitcnt vmcnt(0)" ::: "memory");
    __syncthreads();
    if (threadIdx.x == 0) {
        unsigned* bar = b.bar;
        __builtin_amdgcn_s_waitcnt(0);
        unsigned nloc = b.st[0], nx = b.st[1];
        if (nloc == 0u) { xcd_barrier_complete(bar, b.x, nloc, nx); b.st[0] = nloc; b.st[1] = nx; }
        const unsigned old = xb_add(&bar[XB_XSUB(b.x)], 1u);
        const unsigned gen = old / nloc;
        if (old + 1u == (gen + 1u) * nloc) {
            __builtin_amdgcn_fence(__ATOMIC_RELEASE, "agent");
            asm volatile("s_waitcnt vmcnt(0)" ::: "memory");
            const unsigned og = xb_add(&bar[XB_TOP], 1u);
            const unsigned tg = og / nx;
            if (og + 1u == (tg + 1u) * nx) xb_add(&bar[XB_TOPGEN], 1u);
            else XB_SPIN(xb_ld(&bar[XB_TOPGEN]) == tg, bar);
            __builtin_amdgcn_fence(__ATOMIC_ACQUIRE, "agent");
            xb_add(&bar[XB_XGEN(b.x)], 1u);
            asm volatile("s_waitcnt vmcnt(0)" ::: "memory");
        } else {
            XB_SPIN(xb_ld(&bar[XB_XGEN(b.x)]) == gen, bar);
            __builtin_amdgcn_fence(__ATOMIC_ACQUIRE, "agent");
            asm volatile("s_waitcnt vmcnt(0)" ::: "memory");
        }
    }
    __syncthreads();
}

constexpr int MEGA_THREADS = 256;
template <int LAYER> __device__ __forceinline__ void run_layer(const P& p, const XcdBarrier& bar, long gtid, long gn) {
    nv_inproj(p, LAYER, gtid, gn); xcd_barrier(bar);
    nv_post1(p, LAYER, gtid, gn); xcd_barrier(bar);
    nv_up(p, LAYER, gtid, gn); xcd_barrier(bar);
    nv_cmp2(p, LAYER, gtid, gn); xcd_barrier(bar);
    nv_nsa_a(p, gtid, gn); xcd_barrier(bar);
    nv_nsa_b(p, gtid, gn); xcd_barrier(bar);
    nv_nsa_c(p, gtid, gn); xcd_barrier(bar);
    nv_attn(p, gtid, gn); xcd_barrier(bar);
    nv_wout(p, LAYER, gtid, gn); xcd_barrier(bar);
    nv_ln(p, p.ln1g + LAYER * D, p.ln1b + LAYER * D, (LAYER & 1) ? p.rw : nullptr, gtid, gn); xcd_barrier(bar);
    if (LAYER & 1) nv_moe_up(p, gtid, gn); else nv_ffn_up(p, gtid, gn);
    xcd_barrier(bar);
    if (LAYER & 1) nv_moe_down(p, gtid, gn); else nv_ffn_down(p, gtid, gn);
    xcd_barrier(bar);
    nv_ln(p, p.ln2g + LAYER * D, p.ln2b + LAYER * D, nullptr, gtid, gn);
}
__global__ void __launch_bounds__(MEGA_THREADS, 1) mega(P p) {
    __shared__ uint4 xb_words;
    if (threadIdx.x == 0) xb_words = make_uint4(0u, 0u, 0u, 0u);
    __syncthreads();
    XcdBarrier bar = xcd_barrier_post((unsigned*)(p.ws + OFF_CTL), (volatile LAS unsigned*)&xb_words);
    const long gtid = (long)blockIdx.x * blockDim.x + threadIdx.x, gn = (long)gridDim.x * blockDim.x;
    nv_prologue(p, gtid, gn); xcd_barrier(bar);
    run_layer<0>(p, bar, gtid, gn); xcd_barrier(bar);
    run_layer<1>(p, bar, gtid, gn);
}

extern "C" void kernel_launch(void* const* d_in, const int* in_sizes, int n_in, void* d_out, int out_size, void* d_ws, size_t ws_size, hipStream_t stream) {
    P p{};
    const float** pp = (const float**)&p;
    for (int i = 0; i < 25; ++i) pp[i] = (const float*)d_in[i];
    p.out = (float*)d_out; p.ws = (unsigned char*)d_ws;
    if (ws_size < WS_NEEDED) return;
    static int grid = 0;
    if (!grid) {
        int dev = 0, cus = 0, per_cu = 0;
        hipGetDevice(&dev);
        hipDeviceGetAttribute(&cus, hipDeviceAttributeMultiprocessorCount, dev);
        hipOccupancyMaxActiveBlocksPerMultiprocessor(&per_cu, mega, MEGA_THREADS, 0);
        grid = cus * (per_cu < 1 ? per_cu : 1);
    }
    if (grid <= 0) return;
    hipMemsetAsync(d_ws, 0, 65536, stream);
    mega<<<grid, MEGA_THREADS, 0, stream>>>(p);
}
#endif
```

```cpp
#ifndef HOST_TEST
#include <hip/hip_runtime.h>
#define HD __host__ __device__ __forceinline__
#else
#include <cmath>
#include <cstdint>
#include <cstring>
#include <cstdio>
#define HD inline
#endif
#include <stdint.h>

#ifndef CFG_D
#define CFG_D 1024
#define CFG_B 16
#define CFG_S 2048
#define CFG_DFF 2816
#define CFG_DFE 1408
#endif
constexpr int D = CFG_D, NB = CFG_B, S = CFG_S, M = NB * S, DFF = CFG_DFF, DFE = CFG_DFE;
constexpr int NE = 8, MIXW = 1024, IN_COLS = 2482, NBLK = S / 64, NCMP = (S - 32) / 16 + 1;
constexpr int CMPP = S / 16;
constexpr int ZC_CQ = 0, ZC_CKV = 384, ZC_KR = 640, ZC_FOX = 672, ZC_FF = 1824, ZC_NQ = 1830, ZC_KC = 2086, ZC_VC = 2150, ZC_KS = 2214, ZC_VS = 2278, ZC_KW = 2342, ZC_VW = 2406, ZC_NG = 2470;
constexpr float LOG2E = 1.4426950408889634f;
constexpr float MLA_QS = 0.10206207261596575f * LOG2E;
constexpr float HD_QS = 0.125f * LOG2E;
constexpr float ALPHA = 1.4142135623730951f;
constexpr float EPS = 1e-5f;
typedef uint16_t bf16_t;
struct alignas(16) U4 { uint32_t x, y, z, w; };

constexpr size_t al256(size_t x) { return (x + 255) & ~(size_t)255; }
constexpr int NPAD_IN = 2560;
constexpr int ROWS_PAD = 2 * M + NE * 256;
constexpr size_t OFF_CTL = 0;
constexpr size_t OFF_SSQ = 65536;
constexpr size_t OFF_ROPE = OFF_SSQ + al256((size_t)M * 20 * 4);
constexpr size_t OFF_CBIAS = OFF_ROPE + al256((size_t)S * 32 * 4);
constexpr size_t OFF_EIDX = OFF_CBIAS + al256(2 * 2 * 128 * 4);
constexpr size_t OFF_EGATE = OFF_EIDX + al256((size_t)M * 2 * 4);
constexpr size_t OFF_TOKSLOT = OFF_EGATE + al256((size_t)M * 2 * 4);
constexpr size_t OFF_GATES = OFF_TOKSLOT + al256((size_t)M * 2 * 4);
constexpr size_t OFF_ATTLIST = OFF_GATES + al256((size_t)ROWS_PAD * 4);
constexpr size_t OFF_W_IN = OFF_ATTLIST + al256(4096 * 4);
constexpr size_t OFF_W_UQ = OFF_W_IN + al256((size_t)2 * NPAD_IN * D * 2);
constexpr size_t OFF_W_UKV = OFF_W_UQ + al256((size_t)2 * 768 * 384 * 2);
constexpr size_t OFF_W_C1 = OFF_W_UKV + al256((size_t)2 * 768 * 256 * 2);
constexpr size_t OFF_W_C2 = OFF_W_C1 + al256((size_t)2 * 2 * 128 * 2048 * 2);
constexpr size_t OFF_W_OUT = OFF_W_C2 + al256((size_t)2 * 2 * 64 * 128 * 2);
constexpr size_t OFF_W_F13 = OFF_W_OUT + al256((size_t)2 * D * MIXW * 2);
constexpr size_t OFF_W_F2 = OFF_W_F13 + al256((size_t)2 * DFF * D * 2);
constexpr size_t OFF_W_M13 = OFF_W_F2 + al256((size_t)D * DFF * 2);
constexpr size_t OFF_W_M2 = OFF_W_M13 + al256((size_t)NE * 2 * DFE * D * 2);
constexpr size_t OFF_BIG = OFF_W_M2 + al256((size_t)NE * D * DFE * 2);
constexpr size_t OFF_XB = OFF_BIG;
constexpr size_t OFF_MIX = OFF_XB + al256((size_t)M * D * 2);
constexpr size_t OFF_ARENA = OFF_MIX + al256((size_t)M * MIXW * 2);
constexpr size_t OFF_CQ = OFF_ARENA;
constexpr size_t OFF_CKV = OFF_CQ + al256((size_t)M * 384 * 2);
constexpr size_t OFF_RQ = OFF_CKV + al256((size_t)M * 256 * 2);
constexpr size_t OFF_RKV = OFF_RQ + al256((size_t)M * 4);
constexpr size_t OFF_QM = OFF_RKV + al256((size_t)M * 4);
constexpr size_t OFF_KM = OFF_QM + al256((size_t)M * 576 * 2);
constexpr size_t OFF_VM = OFF_KM + al256((size_t)M * 576 * 2);
constexpr size_t OFF_FQ = OFF_VM + al256((size_t)M * 384 * 2);
constexpr size_t OFF_FK = OFF_FQ + al256((size_t)M * 384 * 2);
constexpr size_t OFF_FV = OFF_FK + al256((size_t)M * 384 * 2);
constexpr size_t OFF_FL = OFF_FV + al256((size_t)M * 384 * 2);
constexpr size_t OFF_FC = OFF_FL + al256((size_t)M * 8 * 4);
constexpr size_t OFF_NQ = OFF_FC + al256((size_t)NB * 6 * S * 4);
constexpr size_t OFF_KCR = OFF_NQ + al256((size_t)M * 256 * 2);
constexpr size_t OFF_VCR = OFF_KCR + al256((size_t)(M * 64 + 2048) * 2);
constexpr size_t OFF_KS = OFF_VCR + al256((size_t)(M * 64 + 2048) * 2);
constexpr size_t OFF_VS = OFF_KS + al256((size_t)M * 64 * 2);
constexpr size_t OFF_KW = OFF_VS + al256((size_t)M * 64 * 2);
constexpr size_t OFF_VW = OFF_KW + al256((size_t)M * 64 * 2);
constexpr size_t OFF_NG = OFF_VW + al256((size_t)M * 64 * 2);
constexpr size_t OFF_HID = OFF_NG + al256((size_t)M * 16 * 4);
constexpr size_t OFF_KCC = OFF_HID + al256((size_t)2 * NB * CMPP * 128 * 4);
constexpr size_t OFF_VCC = OFF_KCC + al256((size_t)NB * CMPP * 64 * 2);
constexpr size_t OFF_CST = OFF_VCC + al256((size_t)NB * CMPP * 64 * 2);
constexpr size_t OFF_IMP = OFF_CST + al256((size_t)M * 8 * 4);
constexpr size_t OFF_SEL = OFF_IMP + al256((size_t)M * 32 * 4);
constexpr size_t OFF_ATT_END = OFF_SEL + al256((size_t)M * 4);
constexpr size_t OFF_H = OFF_ARENA;
constexpr size_t OFF_H2 = OFF_ARENA;
constexpr size_t OFF_HE = OFF_MIX;
constexpr size_t OFF_XS = OFF_HE + al256((size_t)ROWS_PAD * DFE * 2);
constexpr size_t OFF_MOE_END = OFF_XS + al256((size_t)ROWS_PAD * D * 2);
constexpr size_t cmax(size_t a, size_t b) { return a > b ? a : b; }
constexpr size_t WS_NEEDED = cmax(cmax(OFF_ATT_END, OFF_MOE_END), cmax(OFF_H + (size_t)M * DFF * 2, OFF_H2 + (size_t)M * 2 * DFE * 2));
#if CFG_D == 1024
static_assert(WS_NEEDED <= (size_t)512 * 1024 * 1024, "workspace fits in 4 x the largest tensor");
#endif

struct P {
    const float *x, *w_in, *b_forget, *g_cq, *w_uq, *g_ckv, *w_ukv, *ckp, *ckw1, *ckw2, *cvp, *cvw1, *cvw2, *w_out, *ln1g, *ln1b, *ln2g, *ln2b, *fw1, *fw3, *fw2, *rw, *mw1, *mw3, *mw2;
    float* out; unsigned char* ws;
};
#define WSP(T, off) ((T*)(p.ws + (off)))

HD float u2f(uint32_t u) { return __builtin_bit_cast(float, u); }
HD uint32_t f2u(float f) { return __builtin_bit_cast(uint32_t, f); }
HD float bf2f(bf16_t v) { return u2f((uint32_t)v << 16); }
HD bf16_t f2bf(float f) { uint32_t u = f2u(f); return (bf16_t)((u + 0x7fffu + ((u >> 16) & 1u)) >> 16); }
HD float bflo(uint32_t u) { return u2f(u << 16); }
HD float bfhi(uint32_t u) { return u2f(u & 0xffff0000u); }
HD float sigmoidf_(float x) { return 1.0f / (1.0f + expf(-x)); }
HD float siluf_(float x) { return x / (1.0f + expf(-x)); }
HD float dot8(const U4& a, const float* w) { return bflo(a.x) * w[0] + bfhi(a.x) * w[1] + bflo(a.y) * w[2] + bfhi(a.y) * w[3] + bflo(a.z) * w[4] + bfhi(a.z) * w[5] + bflo(a.w) * w[6] + bfhi(a.w) * w[7]; }
HD void unpack8(const U4& a, float* w) { w[0] = bflo(a.x); w[1] = bfhi(a.x); w[2] = bflo(a.y); w[3] = bfhi(a.y); w[4] = bflo(a.z); w[5] = bfhi(a.z); w[6] = bflo(a.w); w[7] = bfhi(a.w); }
HD void rope_cs(int pos, int i, float& c, float& s) {
    const float fr = exp2f(-(float)i * 0.830482023721841f);
    double a = (double)pos * (double)fr; a -= 6.283185307179586 * floor(a * 0.15915494309189535);
#ifdef HOST_TEST
    c = (float)cos(a); s = (float)sin(a);
#else
    c = __cosf((float)a); s = __sinf((float)a);
#endif
}

template <int RG> HD void dot_rows(const bf16_t* A, long lda, const float* W, long ldw, int K, const float* gk, float (&acc)[RG]) {
#pragma unroll
    for (int r = 0; r < RG; ++r) acc[r] = 0.f;
    for (int k = 0; k < K; k += 8) {
        float w[8];
#pragma unroll
        for (int j = 0; j < 8; ++j) w[j] = W[(long)(k + j) * ldw] * (gk ? gk[k + j] : 1.f);
#pragma unroll
        for (int r = 0; r < RG; ++r) { const U4 a = *(const U4*)(A + r * lda + k); acc[r] += dot8(a, w); }
    }
}
constexpr int RG = 8;

HD void nv_prologue(const P& p, long gtid, long gn) {
    bf16_t* xb = WSP(bf16_t, OFF_XB);
    for (long i = gtid; i < (long)M * D; i += gn) xb[i] = f2bf(p.x[i]);
    bf16_t* kcr = WSP(bf16_t, OFF_KCR); bf16_t* vcr = WSP(bf16_t, OFF_VCR);
    for (long i = gtid; i < 2048; i += gn) { kcr[(long)M * 64 + i] = 0; vcr[(long)M * 64 + i] = 0; }
}

HD void store_z(const P& p, long row, int col, float v) {
    if (col < ZC_CKV) WSP(bf16_t, OFF_CQ)[row * 384 + col] = f2bf(v);
    else if (col < ZC_KR) WSP(bf16_t, OFF_CKV)[row * 256 + (col - ZC_CKV)] = f2bf(v);
    else if (col < ZC_FOX) {   }
    else if (col < ZC_FF) { const int c = col - ZC_FOX, which = c / 384, hd = c % 384;
        if (which == 0) WSP(bf16_t, OFF_FQ)[row * 384 + hd] = f2bf(v * HD_QS);
        else if (which == 1) WSP(bf16_t, OFF_FK)[row * 384 + hd] = f2bf(v);
        else WSP(bf16_t, OFF_FV)[row * 384 + hd] = f2bf(v); }
    else if (col < ZC_NQ) WSP(float, OFF_FL)[row * 8 + (col - ZC_FF)] = v;
    else if (col < ZC_KC) WSP(bf16_t, OFF_NQ)[row * 256 + (col - ZC_NQ)] = f2bf(v * HD_QS);
    else if (col < ZC_VC) WSP(bf16_t, OFF_KCR)[row * 64 + (col - ZC_KC)] = f2bf(v);
    else if (col < ZC_KS) WSP(bf16_t, OFF_VCR)[row * 64 + (col - ZC_VC)] = f2bf(v);
    else if (col < ZC_VS) WSP(bf16_t, OFF_KS)[row * 64 + (col - ZC_KS)] = f2bf(v);
    else if (col < ZC_KW) WSP(bf16_t, OFF_VS)[row * 64 + (col - ZC_VS)] = f2bf(v);
    else if (col < ZC_VW) WSP(bf16_t, OFF_KW)[row * 64 + (col - ZC_KW)] = f2bf(v);
    else if (col < ZC_NG) WSP(bf16_t, OFF_VW)[row * 64 + (col - ZC_VW)] = f2bf(v);
    else WSP(float, OFF_NG)[row * 16 + (col - ZC_NG)] = v;
}

HD void nv_inproj(const P& p, int layer, long gtid, long gn) {
    const bf16_t* xb = WSP(bf16_t, OFF_XB); const float* w = p.w_in + (size_t)layer * D * IN_COLS;
    for (long it = gtid; it < (long)(M / RG) * IN_COLS; it += gn) {
        const long rg = it / IN_COLS; const int col = (int)(it % IN_COLS); const long r0 = rg * RG;
        if (col >= ZC_KR + 16 && col < ZC_FOX) continue;
        float acc[RG]; dot_rows<RG>(xb + r0 * D, D, w + col, IN_COLS, D, nullptr, acc);
        if (col >= ZC_KR && col < ZC_KR + 16) {
            float acc2[RG]; dot_rows<RG>(xb + r0 * D, D, w + col + 16, IN_COLS, D, nullptr, acc2);
            const int i = col - ZC_KR;
#pragma unroll
            for (int r = 0; r < RG; ++r) { const long row = r0 + r; float c, s; rope_cs((int)(row % S), i, c, s);
                const bf16_t o1 = f2bf(acc[r] * c - acc2[r] * s), o2 = f2bf(acc2[r] * c + acc[r] * s);
                bf16_t* km = WSP(bf16_t, OFF_KM) + row * 576;
                for (int h = 0; h < 6; ++h) { km[h * 96 + 64 + i] = o1; km[h * 96 + 80 + i] = o2; } }
        } else {
#pragma unroll
            for (int r = 0; r < RG; ++r) store_z(p, r0 + r, col, acc[r]);
        }
    }
}

HD void nv_post1(const P& p, int layer, long gtid, long gn) {
    for (long row = gtid; row < M; row += gn) {
        const bf16_t* cq = WSP(bf16_t, OFF_CQ) + row * 384; const bf16_t* ckv = WSP(bf16_t, OFF_CKV) + row * 256;
        float s1 = 0.f, s2 = 0.f;
        for (int k = 0; k < 384; ++k) { const float v = bf2f(cq[k]); s1 += v * v; }
        for (int k = 0; k < 256; ++k) { const float v = bf2f(ckv[k]); s2 += v * v; }
        WSP(float, OFF_RQ)[row] = 1.0f / sqrtf(s1 / 384.f + EPS); WSP(float, OFF_RKV)[row] = 1.0f / sqrtf(s2 / 256.f + EPS);
    }
    for (long it = gtid; it < NB * 6; it += gn) {
        const int b = (int)(it / 6), h = (int)(it % 6); const float bias = p.b_forget[layer * 6 + h];
        const float* fl = WSP(float, OFF_FL) + (long)b * S * 8 + h; float* fc = WSP(float, OFF_FC) + ((long)b * 6 + h) * S;
        float c = 0.f;
        for (int t = 0; t < S; ++t) { const float xv = fl[(long)t * 8] + bias;
            const float ls = fminf(xv, 0.f) - log1pf(expf(-fabsf(xv)));
            c += ls; fc[t] = c * LOG2E; }
    }
}

HD void nv_qup(const P& p, int layer, long gtid, long gn) {
    { const bf16_t* cq = WSP(bf16_t, OFF_CQ); const float* w = p.w_uq + (size_t)layer * 384 * 576; const float* g = p.g_cq + layer * 384; const float* rq = WSP(float, OFF_RQ);
      bf16_t* qm = WSP(bf16_t, OFF_QM);
      for (long it = gtid; it < (long)(M / RG) * 480; it += gn) {
          const long rg = it / 480; const int j = (int)(it % 480), h = j / 80, c = j % 80; const long r0 = rg * RG;
          if (c < 64) { float acc[RG]; dot_rows<RG>(cq + r0 * 384, 384, w + h * 96 + c, 576, 384, g, acc);
#pragma unroll
              for (int r = 0; r < RG; ++r) qm[(r0 + r) * 576 + h * 96 + c] = f2bf(acc[r] * rq[r0 + r] * MLA_QS);
          } else { const int i = c - 64; float a1[RG], a2[RG];
              dot_rows<RG>(cq + r0 * 384, 384, w + h * 96 + 64 + i, 576, 384, g, a1); dot_rows<RG>(cq + r0 * 384, 384, w + h * 96 + 80 + i, 576, 384, g, a2);
#pragma unroll
              for (int r = 0; r < RG; ++r) { const long row = r0 + r; float cs, sn; rope_cs((int)(row % S), i, cs, sn); const float x1 = a1[r] * rq[row], x2 = a2[r] * rq[row];
                  qm[row * 576 + h * 96 + 64 + i] = f2bf((x1 * cs - x2 * sn) * MLA_QS); qm[row * 576 + h * 96 + 80 + i] = f2bf((x2 * cs + x1 * sn) * MLA_QS); } }
      } }
}
HD void nv_kvup(const P& p, int layer, long gtid, long gn) {
    { const bf16_t* ckv = WSP(bf16_t, OFF_CKV); const float* w = p.w_ukv + (size_t)layer * 256 * 768; const float* g = p.g_ckv + layer * 256; const float* rkv = WSP(float, OFF_RKV);
      for (long it = gtid; it < (long)(M / RG) * 768; it += gn) {
          const long rg = it / 768; const int col = (int)(it % 768), h = col / 128, c = col % 128; const long r0 = rg * RG;
          float acc[RG]; dot_rows<RG>(ckv + r0 * 256, 256, w + col, 768, 256, g, acc);
#pragma unroll
          for (int r = 0; r < RG; ++r) { const float v = acc[r] * rkv[r0 + r];
              if (c < 64) WSP(bf16_t, OFF_KM)[(r0 + r) * 576 + h * 96 + c] = f2bf(v); else WSP(bf16_t, OFF_VM)[(r0 + r) * 384 + h * 64 + (c - 64)] = f2bf(v); }
      } }
}
HD void nv_cmp1(const P& p, int layer, long gtid, long gn) {
    for (long it = gtid; it < (long)2 * NB * CMPP * 128; it += gn) {
        const int j = (int)(it % 128); const long t2 = it / 128; const int n = (int)(t2 % CMPP); const long t3 = t2 / CMPP; const int b = (int)(t3 % NB), wch = (int)(t3 / NB);
        float* hid = WSP(float, OFF_HID);
        if (n >= NCMP) { hid[it] = 0.f; continue; }
        const bf16_t* T = WSP(bf16_t, wch ? OFF_VCR : OFF_KCR) + ((long)b * S + 16 * n) * 64;
        const float* pe = (wch ? p.cvp : p.ckp) + (size_t)layer * 2048; const float* w1 = (wch ? p.cvw1 : p.ckw1) + (size_t)layer * 2048 * 128 + j;
        float acc = 0.f;
        for (int k = 0; k < 2048; ++k) acc += (bf2f(T[k]) + pe[k]) * w1[(long)k * 128];
        hid[it] = siluf_(acc);
    }
}

HD void nv_cmp2(const P& p, int layer, long gtid, long gn) {
    for (long it = gtid; it < (long)2 * NB * CMPP * 64; it += gn) {
        const int d = (int)(it % 64); const long t2 = it / 64; const int n = (int)(t2 % CMPP); const long t3 = t2 / CMPP; const int b = (int)(t3 % NB), wch = (int)(t3 / NB);
        const float* hid = WSP(float, OFF_HID) + (((long)wch * NB + b) * CMPP + n) * 128; const float* w2 = (wch ? p.cvw2 : p.ckw2) + (size_t)layer * 128 * 64 + d;
        float acc = 0.f;
        for (int j = 0; j < 128; ++j) acc += hid[j] * w2[j * 64];
        WSP(bf16_t, wch ? OFF_VCC : OFF_KCC)[((long)b * CMPP + n) * 64 + d] = f2bf(acc);
    }
}

HD float slope2(int h) { return LOG2E * (h == 0 ? 0.25f : h == 1 ? 0.0625f : h == 2 ? 0.015625f : 0.00390625f); }

template <int DK> HD float qk_dot(const float (&q)[DK], const bf16_t* k) {
    float s = 0.f;
#pragma unroll
    for (int d = 0; d < DK; d += 8) { const U4 a = *(const U4*)(k + d); s += dot8(a, &q[d]); }
    return s;
}
template <int DK> HD void load_q(float (&q)[DK], const bf16_t* src) {
#pragma unroll
    for (int d = 0; d < DK; d += 8) { const U4 a = *(const U4*)(src + d); unpack8(a, &q[d]); }
}
HD void sm_step(float sc, const bf16_t* v, float& m, float& l, float (&o)[64]) {
    if (sc > m) { const float f = exp2f(m - sc); l *= f;
#pragma unroll
        for (int d = 0; d < 64; ++d) o[d] *= f;
        m = sc; }
    const float pp = exp2f(sc - m); l += pp;
#pragma unroll
    for (int d = 0; d < 64; d += 8) { const U4 a = *(const U4*)(v + d); float vv[8]; unpack8(a, vv);
#pragma unroll
        for (int j = 0; j < 8; ++j) o[d + j] += pp * vv[j]; }
}

HD void nv_nsa_a(const P& p, long gtid, long gn) {
    for (long it = gtid; it < (long)M * 4; it += gn) {
        const int t = (int)(it % S); const long t2 = it / S; const int h = (int)(t2 % 4), b = (int)(t2 / 4); const long row = (long)b * S + t;
        float q[64]; load_q<64>(q, WSP(bf16_t, OFF_NQ) + row * 256 + h * 64);
        const int nmax = t >= 31 ? ((t - 31) / 16 < NCMP - 1 ? (t - 31) / 16 : NCMP - 1) : -1; const float sl = slope2(h);
        float m = -INFINITY, l = 0.f;
        for (int n = 0; n <= nmax; ++n) { const float sc = qk_dot<64>(q, WSP(bf16_t, OFF_KCC) + ((long)b * CMPP + n) * 64) - sl * (float)(t - (16 * n + 31));
            if (sc > m) { l *= exp2f(m - sc); m = sc; } l += exp2f(sc - m); }
        float* cst = WSP(float, OFF_CST) + (row * 4 + h) * 2; cst[0] = nmax >= 0 ? m : 0.f; cst[1] = l;
    }
}
HD void nv_nsa_b(const P& p, long gtid, long gn) {
    for (long it = gtid; it < (long)M * NBLK; it += gn) {
        const int j = (int)(it % NBLK); const long row = it / NBLK; const int t = (int)(row % S), b = (int)(row / S), cur = t / 64;
        float imp;
        if (j == 0 || j == cur || j == cur - 1) imp = 1.0e4f;
        else if (64 * j > t) imp = -1.0f;
        else { imp = 0.f;
            for (int h = 0; h < 4; ++h) { float q[64]; load_q<64>(q, WSP(bf16_t, OFF_NQ) + row * 256 + h * 64); const float* cst = WSP(float, OFF_CST) + (row * 4 + h) * 2; const float m = cst[0], l = cst[1], sl = slope2(h);
                float sum = 0.f;
                for (int n = 4 * j - 1; n <= 4 * j + 3; ++n) { if (n < 0 || n >= NCMP || 16 * n + 31 > t) continue;
                    const float sc = qk_dot<64>(q, WSP(bf16_t, OFF_KCC) + ((long)b * CMPP + n) * 64) - sl * (float)(t - (16 * n + 31)); sum += exp2f(sc - m); }
                imp += sum / fmaxf(l, 1e-30f); } }
        WSP(float, OFF_IMP)[row * 32 + j] = imp;
    }
}
HD void nv_nsa_c(const P& p, long gtid, long gn) {
    for (long row = gtid; row < M; row += gn) {
        const float* imp = WSP(float, OFF_IMP) + row * 32; uint32_t mask = 0;
        for (int j = 0; j < NBLK; ++j) { const float v = imp[j]; int rank = 0;
            for (int k = 0; k < NBLK; ++k) { const float u = imp[k]; rank += (u > v || (u == v && k < j)) ? 1 : 0; }
            if (rank < 8) mask |= 1u << j; }
        WSP(uint32_t, OFF_SEL)[row] = mask;
    }
}

HD void nv_attn(const P& p, long gtid, long gn) {
    for (long it = gtid; it < (long)M * 6; it += gn) {
        const int t = (int)(it % S); const long t2 = it / S; const int h = (int)(t2 % 6), b = (int)(t2 / 6); const long row = (long)b * S + t;
        float q[96]; load_q<96>(q, WSP(bf16_t, OFF_QM) + row * 576 + h * 96);
        float o[64]; float m = -INFINITY, l = 0.f;
#pragma unroll
        for (int d = 0; d < 64; ++d) o[d] = 0.f;
        for (int s = 0; s <= t; ++s) { const long sr = (long)b * S + s; const float sc = qk_dot<96>(q, WSP(bf16_t, OFF_KM) + sr * 576 + h * 96); sm_step(sc, WSP(bf16_t, OFF_VM) + sr * 384 + h * 64, m, l, o); }
        const float il = 1.0f / l; bf16_t* dst = WSP(bf16_t, OFF_MIX) + row * MIXW + h * 64;
#pragma unroll
        for (int d = 0; d < 64; ++d) dst[d] = f2bf(o[d] * il);
    }
    for (long it = gtid; it < (long)M * 6; it += gn) {
        const int t = (int)(it % S); const long t2 = it / S; const int h = (int)(t2 % 6), b = (int)(t2 / 6); const long row = (long)b * S + t;
        float q[64]; load_q<64>(q, WSP(bf16_t, OFF_FQ) + row * 384 + h * 64);
        const float* fc = WSP(float, OFF_FC) + ((long)b * 6 + h) * S; const float ct = fc[t];
        float o[64]; float m = -INFINITY, l = 0.f;
#pragma unroll
        for (int d = 0; d < 64; ++d) o[d] = 0.f;
        for (int s = 0; s <= t; ++s) { const long sr = (long)b * S + s; const float sc = qk_dot<64>(q, WSP(bf16_t, OFF_FK) + sr * 384 + h * 64) + (ct - fc[s]); sm_step(sc, WSP(bf16_t, OFF_FV) + sr * 384 + h * 64, m, l, o); }
        const float il = 1.0f / l; bf16_t* dst = WSP(bf16_t, OFF_MIX) + row * MIXW + 384 + h * 64;
#pragma unroll
        for (int d = 0; d < 64; ++d) dst[d] = f2bf(o[d] * il);
    }
    for (long it = gtid; it < (long)M * 4; it += gn) {
        const int t = (int)(it % S); const long t2 = it / S; const int h = (int)(t2 % 4), b = (int)(t2 / 4); const long row = (long)b * S + t; const float sl = slope2(h);
        float q[64]; load_q<64>(q, WSP(bf16_t, OFF_NQ) + row * 256 + h * 64);
        const float* ng = WSP(float, OFF_NG) + row * 16 + h * 3;
        float out[64], o[64];
#pragma unroll
        for (int d = 0; d < 64; ++d) out[d] = 0.f;
        {
            const int nmax = t >= 31 ? ((t - 31) / 16 < NCMP - 1 ? (t - 31) / 16 : NCMP - 1) : -1;
            if (nmax >= 0) { float m = -INFINITY, l = 0.f;
#pragma unroll
                for (int d = 0; d < 64; ++d) o[d] = 0.f;
                for (int n = 0; n <= nmax; ++n) { const long cr = ((long)b * CMPP + n) * 64; const float sc = qk_dot<64>(q, WSP(bf16_t, OFF_KCC) + cr) - sl * (float)(t - (16 * n + 31)); sm_step(sc, WSP(bf16_t, OFF_VCC) + cr, m, l, o); }
                const float g = sigmoidf_(ng[0]) / l;
#pragma unroll
                for (int d = 0; d < 64; ++d) out[d] += g * o[d]; } }
        {
            const uint32_t mask = WSP(uint32_t, OFF_SEL)[row]; float m = -INFINITY, l = 0.f;
#pragma unroll
            for (int d = 0; d < 64; ++d) o[d] = 0.f;
            for (int j = 0; j <= t / 64; ++j) { if (!((mask >> j) & 1u)) continue;
                const int s1 = (64 * j + 63 < t) ? 64 * j + 63 : t;
                for (int s = 64 * j; s <= s1; ++s) { const long sr = ((long)b * S + s) * 64; const float sc = qk_dot<64>(q, WSP(bf16_t, OFF_KS) + sr) - sl * (float)(t - s); sm_step(sc, WSP(bf16_t, OFF_VS) + sr, m, l, o); } }
            const float g = sigmoidf_(ng[1]) / l;
#pragma unroll
            for (int d = 0; d < 64; ++d) out[d] += g * o[d]; }
        {
            float m = -INFINITY, l = 0.f;
#pragma unroll
            for (int d = 0; d < 64; ++d) o[d] = 0.f;
            for (int s = (t >= 255 ? t - 255 : 0); s <= t; ++s) { const long sr = ((long)b * S + s) * 64; const float sc = qk_dot<64>(q, WSP(bf16_t, OFF_KW) + sr) - sl * (float)(t - s); sm_step(sc, WSP(bf16_t, OFF_VW) + sr, m, l, o); }
            const float g = sigmoidf_(ng[2]) / l;
#pragma unroll
            for (int d = 0; d < 64; ++d) out[d] += g * o[d]; }
        bf16_t* dst = WSP(bf16_t, OFF_MIX) + row * MIXW + 768 + h * 64;
#pragma unroll
        for (int d = 0; d < 64; ++d) dst[d] = f2bf(out[d]);
    }
}

HD void nv_wout(const P& p, int layer, long gtid, long gn) {
    const bf16_t* mix = WSP(bf16_t, OFF_MIX); const float* w = p.w_out + (size_t)layer * MIXW * D; const float* base = layer == 0 ? p.x : p.out;
    for (long it = gtid; it < (long)(M / RG) * D; it += gn) {
        const long rg = it / D; const int col = (int)(it % D); const long r0 = rg * RG;
        float acc[RG]; dot_rows<RG>(mix + r0 * MIXW, MIXW, w + col, D, MIXW, nullptr, acc);
#pragma unroll
        for (int r = 0; r < RG; ++r) p.out[(r0 + r) * D + col] = ALPHA * base[(r0 + r) * D + col] + acc[r];
    }
}

HD void nv_ln(const P& p, const float* g, const float* bta, const float* rw, long gtid, long gn) {
    for (long row = gtid; row < M; row += gn) {
        float* xr = p.out + row * D; bf16_t* xb = WSP(bf16_t, OFF_XB) + row * D;
        float s = 0.f; for (int k = 0; k < D; ++k) s += xr[k];
        const float mu = s / D; float q = 0.f; for (int k = 0; k < D; ++k) { const float d = xr[k] - mu; q += d * d; }
        const float rs = 1.0f / sqrtf(q / D + EPS);
        float lg[NE];
#pragma unroll
        for (int e = 0; e < NE; ++e) lg[e] = 0.f;
        for (int k = 0; k < D; ++k) { const float v = (xr[k] - mu) * rs * g[k] + bta[k]; xr[k] = v; xb[k] = f2bf(v);
            if (rw) {
#pragma unroll
                for (int e = 0; e < NE; ++e) lg[e] += v * rw[k * NE + e]; } }
        if (rw) { float mx = lg[0];
#pragma unroll
            for (int e = 1; e < NE; ++e) mx = fmaxf(mx, lg[e]);
            float pr[NE]; float sum = 0.f;
#pragma unroll
            for (int e = 0; e < NE; ++e) { pr[e] = expf(lg[e] - mx); sum += pr[e]; }
            int i1 = 0; float p1 = pr[0] / sum;
#pragma unroll
            for (int e = 1; e < NE; ++e) { const float pe = pr[e] / sum; if (pe > p1) { p1 = pe; i1 = e; } }
            int i2 = -1; float p2 = -1.f;
#pragma unroll
            for (int e = 0; e < NE; ++e) { const float pe = pr[e] / sum; if (e != i1 && pe > p2) { p2 = pe; i2 = e; } }
            WSP(int, OFF_EIDX)[row * 2] = i1; WSP(int, OFF_EIDX)[row * 2 + 1] = i2;
            WSP(float, OFF_EGATE)[row * 2] = p1 / (p1 + p2); WSP(float, OFF_EGATE)[row * 2 + 1] = p2 / (p1 + p2); }
    }
}

HD void nv_ffn_up(const P& p, long gtid, long gn) {
    const bf16_t* xb = WSP(bf16_t, OFF_XB); bf16_t* hb = WSP(bf16_t, OFF_H);
    for (long it = gtid; it < (long)(M / RG) * DFF; it += gn) {
        const long rg = it / DFF; const int j = (int)(it % DFF); const long r0 = rg * RG;
        float a[RG], c[RG]; dot_rows<RG>(xb + r0 * D, D, p.fw1 + j, DFF, D, nullptr, a); dot_rows<RG>(xb + r0 * D, D, p.fw3 + j, DFF, D, nullptr, c);
#pragma unroll
        for (int r = 0; r < RG; ++r) hb[(r0 + r) * DFF + j] = f2bf(siluf_(a[r]) * c[r]);
    }
}
HD void nv_ffn_down(const P& p, long gtid, long gn) {
    const bf16_t* hb = WSP(bf16_t, OFF_H);
    for (long it = gtid; it < (long)(M / RG) * D; it += gn) {
        const long rg = it / D; const int col = (int)(it % D); const long r0 = rg * RG;
        float acc[RG]; dot_rows<RG>(hb + r0 * DFF, DFF, p.fw2 + col, D, DFF, nullptr, acc);
#pragma unroll
        for (int r = 0; r < RG; ++r) p.out[(r0 + r) * D + col] = ALPHA * p.out[(r0 + r) * D + col] + acc[r];
    }
}
HD void nv_moe_up(const P& p, long gtid, long gn) {
    const bf16_t* xb = WSP(bf16_t, OFF_XB); bf16_t* h2 = WSP(bf16_t, OFF_H2);
    for (long it = gtid; it < (long)M * 2 * DFE; it += gn) {
        const int j = (int)(it % DFE); const long rs = it / DFE; const long row = rs / 2; const int e = WSP(int, OFF_EIDX)[rs];
        float a[1], c[1]; dot_rows<1>(xb + row * D, D, p.mw1 + (size_t)e * D * DFE + j, DFE, D, nullptr, a); dot_rows<1>(xb + row * D, D, p.mw3 + (size_t)e * D * DFE + j, DFE, D, nullptr, c);
        h2[rs * DFE + j] = f2bf(siluf_(a[0]) * c[0]);
    }
}
HD void nv_moe_down(const P& p, long gtid, long gn) {
    const bf16_t* h2 = WSP(bf16_t, OFF_H2);
    for (long it = gtid; it < (long)M * D; it += gn) {
        const int col = (int)(it % D); const long row = it / D; float tot = 0.f;
        for (int sl = 0; sl < 2; ++sl) { const int e = WSP(int, OFF_EIDX)[row * 2 + sl]; float acc[1];
            dot_rows<1>(h2 + (row * 2 + sl) * DFE, DFE, p.mw2 + (size_t)e * DFE * D + col, D, DFE, nullptr, acc); tot += WSP(float, OFF_EGATE)[row * 2 + sl] * acc[0]; }
        p.out[it] = ALPHA * p.out[it] + tot;
    }
}

constexpr int N_LAYER_PHASES = 13;
HD void run_phase(const P& p, int ph, int layer, long gtid, long gn) {
    switch (ph) {
        case 0: nv_prologue(p, gtid, gn); break;
        case 1: nv_inproj(p, layer, gtid, gn); break;
        case 2: nv_post1(p, layer, gtid, gn); break;
        case 3: nv_qup(p, layer, gtid, gn); nv_kvup(p, layer, gtid, gn); nv_cmp1(p, layer, gtid, gn); break;
        case 14: nv_cmp1(p, layer, gtid, gn); break;
        case 4: nv_cmp2(p, layer, gtid, gn); break;
        case 5: nv_nsa_a(p, gtid, gn); break;
        case 6: nv_nsa_b(p, gtid, gn); break;
        case 7: nv_nsa_c(p, gtid, gn); break;
        case 8: nv_attn(p, gtid, gn); break;
        case 9: nv_wout(p, layer, gtid, gn); break;
        case 10: nv_ln(p, p.ln1g + layer * D, p.ln1b + layer * D, (layer & 1) ? p.rw : nullptr, gtid, gn); break;
        case 11: if (layer & 1) nv_moe_up(p, gtid, gn); else nv_ffn_up(p, gtid, gn); break;
        case 12: if (layer & 1) nv_moe_down(p, gtid, gn); else nv_ffn_down(p, gtid, gn); break;
        case 13: nv_ln(p, p.ln2g + layer * D, p.ln2b + layer * D, nullptr, gtid, gn); break;
    }
}

#ifndef HOST_TEST
#define XB_TMO      128
#define XB_XCNT(j)  (256  + 64 * (j))
#define XB_XSUB(j)  (1280 + 64 * (j))
#define XB_XGEN(j)  (2304 + 64 * (j))
#define XB_TOP      3328
#define XB_TOPGEN   3392
#define XCD_BAR_WORDS 3456
#define XB_SPIN_CAP (1u << 24)
#define LAS __attribute__((address_space(3)))

__device__ __forceinline__ unsigned xb_ld(unsigned* p)              { return __hip_atomic_load(p, __ATOMIC_RELAXED, __HIP_MEMORY_SCOPE_AGENT); }
__device__ __forceinline__ unsigned xb_add(unsigned* p, unsigned v) { return __hip_atomic_fetch_add(p, v, __ATOMIC_RELAXED, __HIP_MEMORY_SCOPE_AGENT); }
__device__ __forceinline__ unsigned xb_xcc_id() { return (unsigned)__builtin_amdgcn_s_getreg((3 << 11) | 20) & 0xFu; }
#define XB_SPIN(cond, bar) do { unsigned _sp = 0; while (cond) { __builtin_amdgcn_s_sleep(1); \
    if ((++_sp & 255u) == 0u) { if (xb_ld(&(bar)[XB_TMO])) break; if (_sp > XB_SPIN_CAP) { atomicAdd(&(bar)[XB_TMO], 1u); break; } } } } while (0)

struct XcdBarrier {
    unsigned* bar; unsigned x;
    volatile LAS unsigned* st;
};
__device__ __forceinline__ XcdBarrier xcd_barrier_post(unsigned* bar, volatile LAS unsigned* st) {
    XcdBarrier b; b.bar = bar; b.x = xb_xcc_id(); b.st = st;
    if (threadIdx.x == 0) (void)xb_add(&bar[XB_XCNT(b.x)], 1u);
    return b;
}
__device__ __forceinline__ void xcd_barrier_complete(unsigned* bar, unsigned x, unsigned& nloc, unsigned& nx) {
    const unsigned G = gridDim.x * gridDim.y * gridDim.z;
    unsigned sum, cnt, mine, sp = 0u;
    for (;;) {
        sum = 0u; cnt = 0u; mine = 0u;
#pragma unroll
        for (unsigned j = 0; j < 16; ++j) { const unsigned c = xb_ld(&bar[XB_XCNT(j)]); sum += c; cnt += (c > 0u) ? 1u : 0u; mine = (j == x) ? c : mine; }
        if (sum == G) break;
        __builtin_amdgcn_s_sleep(1);
        if ((++sp & 255u) == 0u) { if (xb_ld(&bar[XB_TMO])) break; if (sp > XB_SPIN_CAP) { atomicAdd(&bar[XB_TMO], 1u); break; } }
    }
    nloc = mine > 0u ? mine : 1u; nx = cnt > 0u ? cnt : 1u;
}
__device__ __forceinline__ void xcd_barrier(const XcdBarrier& b) {
    asm volatile("s_waitcnt vmcnt(0)" ::: "memory");
    __syncthreads();
    if (threadIdx.x == 0) {
        unsigned* bar = b.bar;
        __builtin_amdgcn_s_waitcnt(0);
        unsigned nloc = b.st[0], nx = b.st[1];
        if (nloc == 0u) { xcd_barrier_complete(bar, b.x, nloc, nx); b.st[0] = nloc; b.st[1] = nx; }
        const unsigned old = xb_add(&bar[XB_XSUB(b.x)], 1u);
        const unsigned gen = old / nloc;
        if (old + 1u == (gen + 1u) * nloc) {
            __builtin_amdgcn_fence(__ATOMIC_RELEASE, "agent");
            asm volatile("s_waitcnt vmcnt(0)" ::: "memory");
            const unsigned og = xb_add(&bar[XB_TOP], 1u);
            const unsigned tg = og / nx;
            if (og + 1u == (tg + 1u) * nx) xb_add(&bar[XB_TOPGEN], 1u);
            else XB_SPIN(xb_ld(&bar[XB_TOPGEN]) == tg, bar);
            __builtin_amdgcn_fence(__ATOMIC_ACQUIRE, "agent");
            xb_add(&bar[XB_XGEN(b.x)], 1u);
            asm volatile("s_waitcnt vmcnt(0)" ::: "memory");
        } else {
            XB_SPIN(xb_ld(&bar[XB_XGEN(b.x)]) == gen, bar);
            __builtin_amdgcn_fence(__ATOMIC_ACQUIRE, "agent");
            asm volatile("s_waitcnt vmcnt(0)" ::: "memory");
        }
    }
    __syncthreads();
}


namespace pg8 {
#define PG8_LAS __attribute__((address_space(3)))
typedef unsigned short bf16_t;
typedef short bf16x8 __attribute__((ext_vector_type(8)));
typedef float f32x4 __attribute__((ext_vector_type(4)));
typedef unsigned u32x4 __attribute__((ext_vector_type(4)));
constexpr int BM = 256, BK = 64, HALF = 128, HTB = HALF * BK * 2  , STAGE_BYTES = 8 * HTB, NXCD = 8, WGM = 8;

__host__ __device__ __forceinline__ int lds_byte(int r, int c) { const int st = (r >> 4) * 2 + (c >> 5), rr = r & 15, cc = c & 31, ob = rr * 64 + cc * 2; return st * 1024 + (ob ^ (((ob >> 9) & 1) << 5)); }
__host__ __device__ __forceinline__ void stage_rc(int b, int& R, int& C) { const int st = b / 1024, sb = b % 1024, swz = sb ^ (((sb >> 9) & 1) << 5); R = (st >> 1) * 16 + swz / 64; C = (st & 1) * 32 + (swz % 64) / 2; }
__host__ __device__ __forceinline__ int perm32(int rho) { const int n = rho >> 4, i = rho & 15; return 8 * (i >> 2) + 4 * n + (i & 3); }

struct Unit { int pm, pn; };
struct Gemm { const bf16_t* A; const bf16_t* Bt; int M, N, K; };

struct StaticOrder {
    int nM, nN, nwg, G, c;
    __host__ __device__ void init(int M, int N, int G_, int c_) { nM = M / BM; nN = N / BM; nwg = nM * nN; G = G_; c = c_; }
    __host__ __device__ bool next(int i, Unit& u) const {
        const long L = (long)i * G + c; if (L >= nwg) return false;
        int wgid = (int)L; { const int q = nwg / NXCD, r = nwg % NXCD, xcd = wgid % NXCD, off = wgid / NXCD; wgid = (xcd < r ? xcd * (q + 1) : r * (q + 1) + (xcd - r) * q) + off; }
        const int nig = WGM * nN, gid = wgid / nig, fm = gid * WGM, gsz = (nM - fm) < WGM ? (nM - fm) : WGM;
        u.pm = fm + ((wgid % nig) % gsz); u.pn = (wgid % nig) / gsz; return true;
    }
    __device__ __forceinline__ void a_ready(const Unit&) const {}
    __device__ __forceinline__ void done(const Unit&) const {}
};

__device__ __forceinline__ unsigned cvt_pk_bf16(float lo, float hi) { unsigned r; asm volatile("v_cvt_pk_bf16_f32 %0, %1, %2" : "=v"(r) : "v"(lo), "v"(hi)); return r; }
typedef float f32x2 __attribute__((ext_vector_type(2)));
template <class Epi, class Sched, bool ALIGN_EPI = false, bool SP2 = false>
__device__ __forceinline__ void gemm_phase(PG8_LAS unsigned char* lds, const Gemm g, const Sched& S, const Epi& E, const int tid) {
    const int  wid = __builtin_amdgcn_readfirstlane(tid >> 6), lane = tid & 63, wr = wid >> 2, wc = wid & 3, fr = lane & 15, fq = lane >> 4;
    const int K = g.K, nt = K / BK;
    unsigned voffA[2], voffB[2];
#pragma unroll
    for (int i = 0; i < 2; ++i) { int R, C; stage_rc(tid * 16 + i * 8192, R, C); const int Rb = Epi::PERM ? ((R & ~31) + perm32(R & 31)) : R;
        voffA[i] = (unsigned)(R * K + C) * 2u; voffB[i] = (unsigned)(Rb * K + C) * 2u; }
    const size_t kstep = (size_t)(BK * 2);
    const size_t hstep = (size_t)HALF * K * 2;
    const size_t tstep = 2 * hstep;
    const unsigned ldsw = (unsigned)wid * 1024u;
    const int aoff = lds_byte(wr * 64 + fr, fq * 8), boff = lds_byte(wc * 32 + fr, fq * 8);
#define PG8_SA(b, h) (((b) * 2 + (h)) * HTB)
#define PG8_SB(b, h) ((4 + (b) * 2 + (h)) * HTB)
#define PG8_STAGE(bufoff, gbase, voff) do { _Pragma("unroll") for (int _i = 0; _i < 2; ++_i) \
        __builtin_amdgcn_global_load_lds((const unsigned*)((const char*)(gbase) + (voff)[_i]), (PG8_LAS unsigned*)(lds + (bufoff) + ldsw + _i * 8192), 16, 0, 0); } while (0)
#define PG8_LDA(dst, b, h) do { _Pragma("unroll") for (int m = 0; m < 4; ++m) _Pragma("unroll") for (int k = 0; k < 2; ++k) dst[m][k] = *(const PG8_LAS bf16x8*)(lds + PG8_SA(b, h) + aoff + m * 2048 + k * 1024); } while (0)
#define PG8_LDB(dst, b, h) do { _Pragma("unroll") for (int n = 0; n < 2; ++n) _Pragma("unroll") for (int k = 0; k < 2; ++k) dst[n][k] = *(const PG8_LAS bf16x8*)(lds + PG8_SB(b, h) + boff + n * 2048 + k * 1024); } while (0)
#define PG8_MMA(ai, bj, At, Bt) do { __builtin_amdgcn_s_setprio(1); _Pragma("unroll") for (int m = 0; m < 4; ++m) _Pragma("unroll") for (int n = 0; n < 2; ++n) _Pragma("unroll") for (int k = 0; k < 2; ++k) \
        acc[ai][bj][m][n] = __builtin_amdgcn_mfma_f32_16x16x32_bf16(Bt[n][k], At[m][k], acc[ai][bj][m][n], 0, 0, 0); __builtin_amdgcn_s_setprio(0); } while (0)
#define PG8_WAIT_V(n) asm volatile("s_waitcnt vmcnt(" #n ")" ::: "memory")
#define PG8_WAIT_L(n) asm volatile("s_waitcnt lgkmcnt(" #n ")" ::: "memory")
#define PG8_BAR __builtin_amdgcn_s_barrier()
#define PG8_SCHED __builtin_amdgcn_sched_barrier(0)
    Unit cur, nxt; int ui = 0;
    if (!S.next(0, cur)) return;
    f32x4 acc[2][2][4][2];
#pragma unroll
    for (int a = 0; a < 2; ++a)
#pragma unroll
        for (int b = 0; b < 2; ++b)
#pragma unroll
            for (int m = 0; m < 4; ++m)
#pragma unroll
                for (int n = 0; n < 2; ++n) acc[a][b][m][n] = (f32x4){0.f, 0.f, 0.f, 0.f};
    bf16x8 At[4][2], B0[2][2], B1[2][2];
    const char* cA = (const char*)g.A + (size_t)cur.pm * tstep; const char* cB = (const char*)g.Bt + (size_t)cur.pn * tstep;
    S.a_ready(cur);
    if constexpr (SP2) {
        PG8_STAGE(PG8_SB(0, 0), cB, voffB); PG8_STAGE(PG8_SB(0, 1), cB + hstep, voffB); PG8_STAGE(PG8_SA(0, 0), cA, voffA); PG8_STAGE(PG8_SA(0, 1), cA + hstep, voffA);
        if (wr == 1) PG8_BAR;
        PG8_WAIT_V(2); PG8_BAR;
        PG8_STAGE(PG8_SB(1, 0), cB + kstep, voffB); PG8_STAGE(PG8_SA(1, 0), cA + kstep, voffA); PG8_STAGE(PG8_SB(1, 1), cB + hstep + kstep, voffB);
        PG8_WAIT_V(6); PG8_BAR;
    } else {
        PG8_STAGE(PG8_SB(0, 0), cB, voffB); PG8_STAGE(PG8_SA(0, 0), cA, voffA); PG8_STAGE(PG8_SB(0, 1), cB + hstep, voffB); PG8_STAGE(PG8_SA(0, 1), cA + hstep, voffA);
        if (wr == 1) PG8_BAR;
        PG8_WAIT_V(4); PG8_BAR;
        PG8_STAGE(PG8_SB(1, 0), cB + kstep, voffB); PG8_STAGE(PG8_SA(1, 0), cA + kstep, voffA); PG8_STAGE(PG8_SB(1, 1), cB + hstep + kstep, voffB);
        PG8_WAIT_V(6); PG8_BAR;
    }
    for (;;) {
        const bool has_next = S.next(ui + 1, nxt);
        const char* nA = has_next ? (const char*)g.A + (size_t)nxt.pm * tstep : cA; const char* nB = has_next ? (const char*)g.Bt + (size_t)nxt.pn * tstep : cB;
#pragma nounroll
        for (int t = 0; t < nt; t += 2) {
            const bool last = (t == nt - 2);
            const char* a1 = cA + (size_t)(t + 1) * kstep;
            const char* a2 = last ? nA : cA + (size_t)(t + 2) * kstep; const char* b2 = last ? nB : cB + (size_t)(t + 2) * kstep;
            const char* a3 = a2 + kstep; const char* b3 = b2 + kstep;
            if (last && has_next) S.a_ready(nxt);
            if constexpr (SP2) {
            PG8_LDB(B0, 0, 0); PG8_LDB(B1, 0, 1); PG8_SCHED; PG8_LDA(At, 0, 0); PG8_STAGE(PG8_SA(1, 1), a1 + hstep, voffA);
            PG8_WAIT_V(8); PG8_WAIT_L(0); PG8_BAR; PG8_MMA(0, 0, At, B0); PG8_MMA(0, 1, At, B1); PG8_BAR; PG8_SCHED;
            PG8_LDA(At, 0, 1); PG8_STAGE(PG8_SB(0, 0), b2, voffB); PG8_STAGE(PG8_SB(0, 1), b2 + hstep, voffB); PG8_STAGE(PG8_SA(0, 0), a2, voffA);
            PG8_WAIT_V(8); PG8_WAIT_L(0); PG8_BAR; PG8_MMA(1, 0, At, B0); PG8_MMA(1, 1, At, B1); PG8_BAR; PG8_SCHED;
            PG8_LDB(B0, 1, 0); PG8_LDB(B1, 1, 1); PG8_SCHED; PG8_LDA(At, 1, 0); PG8_STAGE(PG8_SA(0, 1), a2 + hstep, voffA);
            PG8_WAIT_V(8); PG8_WAIT_L(0); PG8_BAR; PG8_MMA(0, 0, At, B0); PG8_MMA(0, 1, At, B1); PG8_BAR; PG8_SCHED;
            PG8_LDA(At, 1, 1); PG8_STAGE(PG8_SB(1, 0), b3, voffB); PG8_STAGE(PG8_SB(1, 1), b3 + hstep, voffB); PG8_STAGE(PG8_SA(1, 0), a3, voffA);
            PG8_WAIT_V(8); PG8_WAIT_L(0); PG8_BAR; PG8_MMA(1, 0, At, B0); PG8_MMA(1, 1, At, B1); PG8_BAR; PG8_SCHED;
            } else {
            PG8_LDB(B0, 0, 0); PG8_SCHED; PG8_LDA(At, 0, 0); PG8_STAGE(PG8_SA(1, 1), a1 + hstep, voffA);
            PG8_WAIT_L(8); PG8_BAR; PG8_WAIT_L(0); PG8_MMA(0, 0, At, B0); PG8_BAR; PG8_SCHED;
            PG8_LDB(B1, 0, 1); PG8_STAGE(PG8_SB(0, 0), b2, voffB);
            PG8_BAR; PG8_WAIT_L(0); PG8_MMA(0, 1, At, B1); PG8_BAR;
            PG8_LDA(At, 0, 1); PG8_STAGE(PG8_SA(0, 0), a2, voffA);
            PG8_BAR; PG8_WAIT_L(0); PG8_MMA(1, 0, At, B0); PG8_BAR; PG8_SCHED;
            PG8_STAGE(PG8_SB(0, 1), b2 + hstep, voffB);
            PG8_WAIT_V(6); PG8_BAR; PG8_MMA(1, 1, At, B1); PG8_BAR;
            PG8_LDB(B0, 1, 0); PG8_SCHED; PG8_LDA(At, 1, 0); PG8_STAGE(PG8_SA(0, 1), a2 + hstep, voffA);
            PG8_WAIT_L(8); PG8_BAR; PG8_WAIT_L(0); PG8_MMA(0, 0, At, B0); PG8_BAR; PG8_SCHED;
            PG8_LDB(B1, 1, 1); PG8_STAGE(PG8_SB(1, 0), b3, voffB);
            PG8_BAR; PG8_WAIT_L(0); PG8_MMA(0, 1, At, B1); PG8_BAR;
            PG8_LDA(At, 1, 1); PG8_STAGE(PG8_SA(1, 0), a3, voffA);
            PG8_BAR; PG8_WAIT_L(0); PG8_MMA(1, 0, At, B0); PG8_BAR; PG8_SCHED;
            PG8_STAGE(PG8_SB(1, 1), b3 + hstep, voffB);
            PG8_WAIT_V(6); PG8_BAR; PG8_MMA(1, 1, At, B1); PG8_BAR;
            }
        }
        if constexpr (ALIGN_EPI) { if (wr == 0) PG8_BAR; }
        if constexpr (!Epi::AFTER_DRAIN) { E(acc, cur, wr, wc, fr, fq); S.done(cur); }
        if (!has_next) break;
#pragma unroll
        for (int a = 0; a < 2; ++a)
#pragma unroll
            for (int b = 0; b < 2; ++b)
#pragma unroll
                for (int m = 0; m < 4; ++m)
#pragma unroll
                    for (int n = 0; n < 2; ++n) acc[a][b][m][n] = (f32x4){0.f, 0.f, 0.f, 0.f};
        cur = nxt; cA = nA; cB = nB; ++ui;
        if constexpr (ALIGN_EPI) { if (wr == 1) PG8_BAR; }
    }
    PG8_WAIT_V(0);
    if constexpr (!ALIGN_EPI) { if (wr == 0) PG8_BAR; }
    PG8_BAR;
    if constexpr (Epi::AFTER_DRAIN) { E.fused(acc, cur, wr, wc, fr, fq, lds, wid, lane); S.done(cur); }
#undef PG8_SA
#undef PG8_SB
#undef PG8_STAGE
#undef PG8_LDA
#undef PG8_LDB
#undef PG8_MMA
#undef PG8_WAIT_V
#undef PG8_WAIT_L
#undef PG8_BAR
#undef PG8_SCHED
}
}

#define OPT_THREADS 512
constexpr int LDS_BYTES = 147456;
typedef pg8::f32x4 f32x4;
#define GLB __attribute__((address_space(1)))

typedef float f32x2_t __attribute__((ext_vector_type(2))); typedef __bf16 bf16x2_t __attribute__((ext_vector_type(2)));
__device__ __forceinline__ unsigned pk2(float lo, float hi) { f32x2_t v = {lo, hi}; bf16x2_t b = __builtin_convertvector(v, bf16x2_t); return __builtin_bit_cast(unsigned, b); }
__device__ __forceinline__ U4 pack8(const f32x4& a, const f32x4& b) { U4 w; w.x = pk2(a[0], a[1]); w.y = pk2(a[2], a[3]); w.z = pk2(b[0], b[1]); w.w = pk2(b[2], b[3]); return w; }
__device__ __forceinline__ void atomic_addf(float* p, float v) { __hip_atomic_fetch_add(p, v, __ATOMIC_RELAXED, __HIP_MEMORY_SCOPE_AGENT); }

template <int MODE> __device__ __forceinline__ int wsrc_col(int n, int nsrc, int& which) {
    which = 0;
    if (MODE == 0) return n < nsrc ? n : -1;
    if (MODE == 1) { if (n >= 640 && n < 672) { const int c = n - 640; return 640 + ((c >> 2) & 1) * 16 + 4 * (c >> 3) + (c & 3); }
        if (n < 1824) return n; if (n < 2080) return n + 6; if (n < 2464) return n + 6; if (n < 2470) return n - 2464 + 1824; if (n < 2472) return -1; if (n < 2484) return n - 2472 + 2470; return -1; }
    if (MODE == 3) { if (n >= nsrc) return -1; const int h = n / 96, cc = n % 96; if (cc < 64) return n; const int c = cc - 64; return h * 96 + 64 + ((c >> 2) & 1) * 16 + 4 * (c >> 3) + (c & 3); }
    const int t = n >> 8, r = n & 255; which = r >> 7; return t * 128 + (r & 127);
}
template <int MODE> __device__ __forceinline__ void wconv(const float* W, const float* W2, int ldw, int K, int Nd, int nsrc, const float* gk, bf16_t* Bt, LAS float* scr, int gw, int ngw, int rot, int lane) {
    const int nkb = K / 64, nitems = nkb * (Nd / 32);
    for (int it = (gw + rot) % ngw; it < nitems; it += ngw) {
        const int kb = it % nkb, nb = it / nkb, k0 = 64 * kb, n0 = 32 * nb;
        int which; const int sc = wsrc_col<MODE>(n0 + (lane & 31), nsrc, which); const float* Ws = (MODE == 2 && which) ? W2 : W;
#pragma unroll 8
        for (int i = 0; i < 32; ++i) { const int kk = 2 * i + (lane >> 5); float v = 0.f; if (sc >= 0) { v = Ws[(size_t)(k0 + kk) * ldw + sc]; if (gk) v *= gk[k0 + kk]; } scr[kk * 33 + (lane & 31)] = v; }
        asm volatile("s_waitcnt lgkmcnt(0)" ::: "memory");
        const int c = lane & 7;
#pragma unroll
        for (int j = 0; j < 4; ++j) { const int n = (lane >> 3) + 8 * j; const LAS float* s = scr + (8 * c) * 33 + n;
            U4 o; o.x = pk2(s[0 * 33], s[1 * 33]); o.y = pk2(s[2 * 33], s[3 * 33]); o.z = pk2(s[4 * 33], s[5 * 33]); o.w = pk2(s[6 * 33], s[7 * 33]);
            *(U4*)(Bt + (size_t)(n0 + n) * K + k0 + 8 * c) = o; }
        asm volatile("s_waitcnt lgkmcnt(0)" ::: "memory");
    }
}
__device__ __forceinline__ void build_att_list(const P& p, int tid);
__device__ __forceinline__ void op_prologue(const P& p, LAS unsigned char* lds, const int tid) {
    const int lane = tid & 63, wave = tid >> 6, gw = blockIdx.x * 8 + wave, ngw = gridDim.x * 8;
    const long gtid = (long)blockIdx.x * OPT_THREADS + tid, gn = (long)gridDim.x * OPT_THREADS;
    { const f32x4* x4 = (const f32x4*)p.x; U4* xb = WSP(U4, OFF_XB);
      for (long i = gtid; i < (long)M * D / 8; i += gn) { const f32x4 a = x4[2 * i], b = x4[2 * i + 1]; xb[i] = pack8(a, b); } }
    for (long i = gtid; i < 2048; i += gn) { WSP(bf16_t, OFF_KCR)[(long)M * 64 + i] = 0; WSP(bf16_t, OFF_VCR)[(long)M * 64 + i] = 0; }
    for (long i = gtid; i < (long)S * 16; i += gn) { float c, s; rope_cs((int)(i >> 4), (int)(i & 15), c, s); WSP(float, OFF_ROPE)[2 * i] = c; WSP(float, OFF_ROPE)[2 * i + 1] = s; }
    for (long i = gtid; i < 2 * 2 * 128; i += gn) { const int j = (int)(i & 127), wch = (int)((i >> 7) & 1), layer = (int)(i >> 8);
        const float* pe = (wch ? p.cvp : p.ckp) + (size_t)layer * 2048; const float* w1 = (wch ? p.cvw1 : p.ckw1) + (size_t)layer * 2048 * 128 + j;
        float acc = 0.f; for (int k = 0; k < 2048; ++k) acc += pe[k] * w1[(size_t)k * 128]; WSP(float, OFF_CBIAS)[i] = acc; }
    if (blockIdx.x == gridDim.x - 1) build_att_list(p, tid);
    LAS float* scr = (LAS float*)(lds + wave * 16384);
    for (int l = 0; l < 2; ++l) {
        wconv<1>(p.w_in + (size_t)l * D * IN_COLS, nullptr, IN_COLS, D, NPAD_IN, IN_COLS, nullptr, WSP(bf16_t, OFF_W_IN) + (size_t)l * NPAD_IN * D, scr, gw, ngw, 0, lane);
        wconv<3>(p.w_uq + (size_t)l * 384 * 576, nullptr, 576, 384, 768, 576, p.g_cq + l * 384, WSP(bf16_t, OFF_W_UQ) + (size_t)l * 768 * 384, scr, gw, ngw, 300, lane);
        wconv<0>(p.w_ukv + (size_t)l * 256 * 768, nullptr, 768, 256, 768, 768, p.g_ckv + l * 256, WSP(bf16_t, OFF_W_UKV) + (size_t)l * 768 * 256, scr, gw, ngw, 600, lane);
        wconv<0>(p.ckw1 + (size_t)l * 2048 * 128, nullptr, 128, 2048, 128, 128, nullptr, WSP(bf16_t, OFF_W_C1) + (size_t)(l * 2 + 0) * 128 * 2048, scr, gw, ngw, 900, lane);
        wconv<0>(p.cvw1 + (size_t)l * 2048 * 128, nullptr, 128, 2048, 128, 128, nullptr, WSP(bf16_t, OFF_W_C1) + (size_t)(l * 2 + 1) * 128 * 2048, scr, gw, ngw, 1000, lane);
        wconv<0>(p.ckw2 + (size_t)l * 128 * 64, nullptr, 64, 128, 64, 64, nullptr, WSP(bf16_t, OFF_W_C2) + (size_t)(l * 2 + 0) * 64 * 128, scr, gw, ngw, 1100, lane);
        wconv<0>(p.cvw2 + (size_t)l * 128 * 64, nullptr, 64, 128, 64, 64, nullptr, WSP(bf16_t, OFF_W_C2) + (size_t)(l * 2 + 1) * 64 * 128, scr, gw, ngw, 1104, lane);
        wconv<0>(p.w_out + (size_t)l * MIXW * D, nullptr, D, MIXW, D, D, nullptr, WSP(bf16_t, OFF_W_OUT) + (size_t)l * D * MIXW, scr, gw, ngw, 1200, lane);
    }
    wconv<2>(p.fw1, p.fw3, DFF, D, 2 * DFF, DFF, nullptr, WSP(bf16_t, OFF_W_F13), scr, gw, ngw, 0, lane);
    wconv<0>(p.fw2, nullptr, D, DFF, D, D, nullptr, WSP(bf16_t, OFF_W_F2), scr, gw, ngw, 400, lane);
    for (int e = 0; e < NE; ++e) {
        wconv<2>(p.mw1 + (size_t)e * D * DFE, p.mw3 + (size_t)e * D * DFE, DFE, D, 2 * DFE, DFE, nullptr, WSP(bf16_t, OFF_W_M13) + (size_t)e * 2 * DFE * D, scr, gw, ngw, e * 200, lane);
        wconv<0>(p.mw2 + (size_t)e * DFE * D, nullptr, D, DFE, D, D, nullptr, WSP(bf16_t, OFF_W_M2) + (size_t)e * D * DFE, scr, gw, ngw, e * 200 + 100, lane);
    }
}

struct EpiInproj {
    static constexpr bool PERM = true, AFTER_DRAIN = false;
    P p; int layer;
    __device__ __forceinline__ void operator()(const f32x4 (&acc)[2][2][4][2], const pg8::Unit& u, int wr, int wc, int fr, int fq) const {
        const int rowb = u.pm * 256 + wr * 64 + fr;
#pragma unroll
        for (int bj = 0; bj < 2; ++bj) {
            const int sb = u.pn * 256 + bj * 128 + wc * 32;
            if (sb >= 2496) continue;
            if (sb == 640) {
                const float* rt = WSP(float, OFF_ROPE);
#pragma unroll
                for (int ai = 0; ai < 2; ++ai)
#pragma unroll
                    for (int m = 0; m < 4; ++m) { const int row = rowb + ai * 128 + m * 16; const int pos = row % S;
                        const f32x4 v0 = acc[ai][bj][m][0], v1 = acc[ai][bj][m][1];
                        const f32x4* cs = (const f32x4*)(rt + (unsigned)(pos * 16 + 4 * fq) * 2u); const f32x4 c01 = cs[0], c23 = cs[1]; f32x4 o0, o1;
                        o0[0] = v0[0] * c01[0] - v1[0] * c01[1]; o0[1] = v0[1] * c01[2] - v1[1] * c01[3]; o0[2] = v0[2] * c23[0] - v1[2] * c23[1]; o0[3] = v0[3] * c23[2] - v1[3] * c23[3];
                        o1[0] = v1[0] * c01[0] + v0[0] * c01[1]; o1[1] = v1[1] * c01[2] + v0[1] * c01[3]; o1[2] = v1[2] * c23[0] + v0[2] * c23[1]; o1[3] = v1[3] * c23[2] + v0[3] * c23[3];
                        const U4 w = pack8(o0, o1); bf16_t* km = WSP(bf16_t, OFF_KM) + (size_t)row * 576 + 64 + 8 * fq;
#pragma unroll
                        for (int h = 0; h < 6; ++h) *(U4*)(km + h * 96) = w; }
            } else if (sb == 2464) {
#pragma unroll
                for (int ai = 0; ai < 2; ++ai)
#pragma unroll
                    for (int m = 0; m < 4; ++m) { const int row = rowb + ai * 128 + m * 16; const f32x4 v0 = acc[ai][bj][m][0], v1 = acc[ai][bj][m][1];
                        if (fq == 0) { f32x4* d = (f32x4*)(WSP(float, OFF_FL) + (size_t)row * 8); d[0] = v0; d[1] = v1; }
                        else if (fq < 3) { f32x4* d = (f32x4*)(WSP(float, OFF_NG) + (size_t)row * 16 + 8 * (fq - 1)); d[0] = v0; d[1] = v1; } }
            } else {
                bf16_t* dst; int pitch; float sc = 1.f; float* ssq = nullptr;
                if (sb < 384) { dst = WSP(bf16_t, OFF_CQ) + sb; pitch = 384; ssq = WSP(float, OFF_SSQ) + (sb >> 5); }
                else if (sb < 640) { dst = WSP(bf16_t, OFF_CKV) + (sb - 384); pitch = 256; ssq = WSP(float, OFF_SSQ) + (sb >> 5); }
                else if (sb < 1824) { const int c = sb - 672, which = c / 384, hd = c % 384; pitch = 384; dst = WSP(bf16_t, which == 0 ? OFF_FQ : which == 1 ? OFF_FK : OFF_FV) + hd; if (which == 0) sc = HD_QS; }
                else if (sb < 2080) { dst = WSP(bf16_t, OFF_NQ) + (sb - 1824); pitch = 256; sc = HD_QS; }
                else { const int c = sb - 2080, idx = c >> 6; pitch = 64;
                    dst = WSP(bf16_t, idx == 0 ? OFF_KCR : idx == 1 ? OFF_VCR : idx == 2 ? OFF_KS : idx == 3 ? OFF_VS : idx == 4 ? OFF_KW : OFF_VW) + (c & 63); }
#pragma unroll
                for (int ai = 0; ai < 2; ++ai)
#pragma unroll
                    for (int m = 0; m < 4; ++m) { const int row = rowb + ai * 128 + m * 16; const f32x4 v0 = acc[ai][bj][m][0] * sc, v1 = acc[ai][bj][m][1] * sc;
                        if (ssq) { float s = (v0[0] * v0[0] + v0[1] * v0[1]) + (v0[2] * v0[2] + v0[3] * v0[3]) + (v1[0] * v1[0] + v1[1] * v1[1]) + (v1[2] * v1[2] + v1[3] * v1[3]);
                            s += __shfl_xor(s, 16); s += __shfl_xor(s, 32); if (fq == 0) ssq[(size_t)row * 20] = s; }
                        *(U4*)(dst + (size_t)row * pitch + 8 * fq) = pack8(v0, v1); }
            }
        }
    }
};

__device__ __forceinline__ void op_inproj(const P& p, int layer, LAS unsigned char* lds, const int tid) {
    pg8::Gemm g{WSP(bf16_t, OFF_XB), WSP(bf16_t, OFF_W_IN) + (size_t)layer * NPAD_IN * D, M, NPAD_IN, D};
    pg8::StaticOrder S; S.init(M, NPAD_IN, (int)gridDim.x, (int)blockIdx.x);
    EpiInproj E{p, layer};
    pg8::gemm_phase<EpiInproj, pg8::StaticOrder, true, true>(lds, g, S, E, tid);
}

struct EpiQup {
    static constexpr bool PERM = true, AFTER_DRAIN = false;
    P p; int layer;
    __device__ __forceinline__ void operator()(const f32x4 (&acc)[2][2][4][2], const pg8::Unit& u, int wr, int wc, int fr, int fq) const {
        const int rowb = u.pm * 256 + wr * 64 + fr; const float* ssq = WSP(float, OFF_SSQ); const float* rt = WSP(float, OFF_ROPE); bf16_t* qm = WSP(bf16_t, OFF_QM);
#pragma unroll
        for (int bj = 0; bj < 2; ++bj) {
            const int sb = u.pn * 256 + bj * 128 + wc * 32;
            if (sb >= 576) continue;
            const int h = sb / 96, part = (sb % 96) / 32; const unsigned cofs = (unsigned)(h * 96 + part * 32 + 8 * fq);
            if (part == 2) {
#pragma unroll
                for (int ai = 0; ai < 2; ++ai)
#pragma unroll
                    for (int m = 0; m < 4; ++m) { const int row = rowb + ai * 128 + m * 16; const f32x4* sq = (const f32x4*)(ssq + (unsigned)row * 20u); const f32x4 s0 = sq[0], s1 = sq[1], s2 = sq[2]; const float r = MLA_QS * __builtin_amdgcn_rsqf((((s0[0] + s0[1]) + (s0[2] + s0[3])) + ((s1[0] + s1[1]) + (s1[2] + s1[3])) + ((s2[0] + s2[1]) + (s2[2] + s2[3]))) * (1.0f / 384.f) + EPS);
                        const f32x4 v0 = acc[ai][bj][m][0] * r, v1 = acc[ai][bj][m][1] * r; const int pos = row % S;
                        const f32x4* cs = (const f32x4*)(rt + (unsigned)(pos * 16 + 4 * fq) * 2u); const f32x4 c01 = cs[0], c23 = cs[1]; f32x4 o0, o1;
                        o0[0] = v0[0] * c01[0] - v1[0] * c01[1]; o0[1] = v0[1] * c01[2] - v1[1] * c01[3]; o0[2] = v0[2] * c23[0] - v1[2] * c23[1]; o0[3] = v0[3] * c23[2] - v1[3] * c23[3];
                        o1[0] = v1[0] * c01[0] + v0[0] * c01[1]; o1[1] = v1[1] * c01[2] + v0[1] * c01[3]; o1[2] = v1[2] * c23[0] + v0[2] * c23[1]; o1[3] = v1[3] * c23[2] + v0[3] * c23[3];
                        *(U4*)(qm + ((unsigned)row * 576u + cofs)) = pack8(o0, o1);
                        asm volatile("" ::: "memory"); }
            } else {
#pragma unroll
                for (int ai = 0; ai < 2; ++ai)
#pragma unroll
                    for (int m = 0; m < 4; ++m) { const int row = rowb + ai * 128 + m * 16; const f32x4* sq = (const f32x4*)(ssq + (unsigned)row * 20u); const f32x4 s0 = sq[0], s1 = sq[1], s2 = sq[2]; const float r = MLA_QS * __builtin_amdgcn_rsqf((((s0[0] + s0[1]) + (s0[2] + s0[3])) + ((s1[0] + s1[1]) + (s1[2] + s1[3])) + ((s2[0] + s2[1]) + (s2[2] + s2[3]))) * (1.0f / 384.f) + EPS);
                        *(U4*)(qm + ((unsigned)row * 576u + cofs)) = pack8(acc[ai][bj][m][0] * r, acc[ai][bj][m][1] * r);
                        asm volatile("" ::: "memory"); }
            }
        }
    }
};
struct EpiKVup {
    static constexpr bool PERM = true, AFTER_DRAIN = false;
    P p; int layer;
    __device__ __forceinline__ void operator()(const f32x4 (&acc)[2][2][4][2], const pg8::Unit& u, int wr, int wc, int fr, int fq) const {
        const int rowb = u.pm * 256 + wr * 64 + fr; const float* ssq = WSP(float, OFF_SSQ) + 12;
        bf16_t* km = WSP(bf16_t, OFF_KM); bf16_t* vm = WSP(bf16_t, OFF_VM);
        const int sb0 = u.pn * 256 + wc * 32;
#pragma unroll
        for (int ai = 0; ai < 2; ++ai)
#pragma unroll
            for (int m = 0; m < 4; ++m) { const int row = rowb + ai * 128 + m * 16; const f32x4* sq = (const f32x4*)(ssq + (unsigned)row * 20u); const f32x4 s0 = sq[0], s1 = sq[1]; const float r = __builtin_amdgcn_rsqf((((s0[0] + s0[1]) + (s0[2] + s0[3])) + ((s1[0] + s1[1]) + (s1[2] + s1[3]))) * (1.0f / 256.f) + EPS);
#pragma unroll
                for (int bj = 0; bj < 2; ++bj) { const int sb = sb0 + bj * 128, h = sb >> 7, cc = sb & 127;
                    const U4 w = pack8(acc[ai][bj][m][0] * r, acc[ai][bj][m][1] * r);
                    if (cc < 64) *(U4*)(km + (unsigned)(row * 576 + h * 96 + cc + 8 * fq)) = w; else *(U4*)(vm + (unsigned)(row * 384 + h * 64 + (cc - 64) + 8 * fq)) = w; }
                asm volatile("" ::: "memory"); }
    }
};
struct EpiResid {
    static constexpr bool PERM = true, AFTER_DRAIN = false;
    const float* base; float* out;
    __device__ __forceinline__ void operator()(const f32x4 (&acc)[2][2][4][2], const pg8::Unit& u, int wr, int wc, int fr, int fq) const {
        const int rowb = u.pm * 256 + wr * 64 + fr;
#pragma unroll
        for (int ai = 0; ai < 2; ++ai)
#pragma unroll
            for (int m = 0; m < 4; ++m) { const size_t ro = (size_t)(rowb + ai * 128 + m * 16) * D;
#pragma unroll
                for (int bj = 0; bj < 2; ++bj) { const size_t o = ro + u.pn * 256 + bj * 128 + wc * 32 + 8 * fq;
                    const f32x4 b0 = *(const f32x4*)(base + o), b1 = *(const f32x4*)(base + o + 4);
                    *(f32x4*)(out + o) = b0 * ALPHA + acc[ai][bj][m][0]; *(f32x4*)(out + o + 4) = b1 * ALPHA + acc[ai][bj][m][1]; } }
    }
};
struct EpiSwiglu {
    static constexpr bool PERM = true, AFTER_DRAIN = false;
    bf16_t* Hout; int ldh;
    __device__ __forceinline__ void operator()(const f32x4 (&acc)[2][2][4][2], const pg8::Unit& u, int wr, int wc, int fr, int fq) const {
        const int rowb = u.pm * 256 + wr * 64 + fr; const int col = u.pn * 128 + wc * 32 + 8 * fq;
#pragma unroll
        for (int ai = 0; ai < 2; ++ai)
#pragma unroll
            for (int m = 0; m < 4; ++m) { f32x4 h0, h1;
#pragma unroll
                for (int j = 0; j < 4; ++j) { const float a0 = acc[ai][0][m][0][j], a1 = acc[ai][0][m][1][j];
                    h0[j] = a0 * acc[ai][1][m][0][j] * __builtin_amdgcn_rcpf(1.0f + __expf(-a0)); h1[j] = a1 * acc[ai][1][m][1][j] * __builtin_amdgcn_rcpf(1.0f + __expf(-a1)); }
                *(U4*)(Hout + (size_t)(rowb + ai * 128 + m * 16) * ldh + col) = pack8(h0, h1); }
    }
};

__device__ __forceinline__ void op_mla_qup(const P& p, int layer, LAS unsigned char* lds, const int tid) {
    { pg8::Gemm g{WSP(bf16_t, OFF_CQ), WSP(bf16_t, OFF_W_UQ) + (size_t)layer * 768 * 384, M, 768, 384};
      pg8::StaticOrder S; S.init(M, 768, (int)gridDim.x, (int)blockIdx.x); EpiQup E{p, layer};
      pg8::gemm_phase<EpiQup, pg8::StaticOrder, true, true>(lds, g, S, E, tid); }
}
__device__ __forceinline__ void op_mla_kvup(const P& p, int layer, LAS unsigned char* lds, const int tid) {
    { pg8::Gemm g{WSP(bf16_t, OFF_CKV), WSP(bf16_t, OFF_W_UKV) + (size_t)layer * 768 * 256, M, 768, 256};
      pg8::StaticOrder S; S.init(M, 768, (int)gridDim.x, (int)((blockIdx.x + gridDim.x / 2) % gridDim.x)); EpiKVup E{p, layer};
      pg8::gemm_phase<EpiKVup, pg8::StaticOrder, true, true>(lds, g, S, E, tid); }
}
__device__ __forceinline__ void op_wout(const P& p, int layer, LAS unsigned char* lds, const int tid) {
    pg8::Gemm g{WSP(bf16_t, OFF_MIX), WSP(bf16_t, OFF_W_OUT) + (size_t)layer * D * MIXW, M, D, MIXW};
    pg8::StaticOrder S; S.init(M, D, (int)gridDim.x, (int)blockIdx.x); EpiResid E{layer == 0 ? p.x : p.out, p.out};
    pg8::gemm_phase<EpiResid, pg8::StaticOrder, true, true>(lds, g, S, E, tid);
}
__device__ __forceinline__ void op_ffn_up(const P& p, LAS unsigned char* lds, const int tid) {
    pg8::Gemm g{WSP(bf16_t, OFF_XB), WSP(bf16_t, OFF_W_F13), M, 2 * DFF, D};
    pg8::StaticOrder S; S.init(M, 2 * DFF, (int)gridDim.x, (int)blockIdx.x); EpiSwiglu E{WSP(bf16_t, OFF_H), DFF};
    pg8::gemm_phase<EpiSwiglu, pg8::StaticOrder, true, true>(lds, g, S, E, tid);
}
__device__ __forceinline__ void op_ffn_down(const P& p, LAS unsigned char* lds, const int tid) {
    pg8::Gemm g{WSP(bf16_t, OFF_H), WSP(bf16_t, OFF_W_F2), M, D, DFF};
    pg8::StaticOrder S; S.init(M, D, (int)gridDim.x, (int)blockIdx.x); EpiResid E{p.out, p.out};
    pg8::gemm_phase<EpiResid, pg8::StaticOrder, true, true>(lds, g, S, E, tid);
}
__device__ __forceinline__ float wave_sum(float v) {
#pragma unroll
    for (int o = 1; o < 64; o <<= 1) v += __shfl_xor(v, o);
    return v;
}
__device__ __forceinline__ void op_ln(const P& p, const float* g, const float* bta, const int tid) {
    static_assert(D == 1024, "op_ln: 16 floats per lane");
    const int lane = tid & 63, gw = blockIdx.x * (OPT_THREADS / 64) + (tid >> 6), ngw = gridDim.x * (OPT_THREADS / 64);
    f32x4 gv[4], bv[4];
#pragma unroll
    for (int j = 0; j < 4; ++j) { gv[j] = ((const f32x4*)g)[lane + 64 * j]; bv[j] = ((const f32x4*)bta)[lane + 64 * j]; }
    for (int row = gw; row < M; row += ngw) {
        f32x4* xr = (f32x4*)(p.out + (size_t)row * D) + lane; f32x4 v[4]; float s = 0.f;
#pragma unroll
        for (int j = 0; j < 4; ++j) { v[j] = xr[64 * j]; s += (v[j][0] + v[j][1]) + (v[j][2] + v[j][3]); }
        const float mean = wave_sum(s) * (1.f / D); float s2 = 0.f;
#pragma unroll
        for (int j = 0; j < 4; ++j) { v[j] = v[j] - mean; s2 += (v[j][0] * v[j][0] + v[j][1] * v[j][1]) + (v[j][2] * v[j][2] + v[j][3] * v[j][3]); }
        const float rstd = 1.f / sqrtf(wave_sum(s2) * (1.f / D) + EPS);
        unsigned long long* o8 = (unsigned long long*)(WSP(bf16_t, OFF_XB) + (size_t)row * D) + lane;
#pragma unroll
        for (int j = 0; j < 4; ++j) { const f32x4 y = v[j] * rstd * gv[j] + bv[j]; xr[64 * j] = y; o8[64 * j] = (unsigned long long)pk2(y[0], y[1]) | ((unsigned long long)pk2(y[2], y[3]) << 32); }
    }
}

constexpr int CW_GCNT = 4096;
__device__ __forceinline__ float bf_lo(unsigned u) { return __uint_as_float(u << 16); }
__device__ __forceinline__ float bf_hi(unsigned u) { return __uint_as_float(u & 0xffff0000u); }
__device__ __forceinline__ void op_ln_router(const P& p, const float* g, const float* bta, LAS unsigned char* lds, const int tid) {
    static_assert(D == 1024, "op_ln_router: 16 floats per lane");
    const int lane = tid & 63, gw = blockIdx.x * (OPT_THREADS / 64) + (tid >> 6), ngw = gridDim.x * (OPT_THREADS / 64);
    LAS unsigned* lcnt = (LAS unsigned*)lds; LAS unsigned* lbase = lcnt + 8;
    if (tid < 16) lcnt[tid] = 0u;
    __syncthreads();
    f32x4 gv[4], bv[4];
#pragma unroll
    for (int j = 0; j < 4; ++j) { gv[j] = ((const f32x4*)g)[lane + 64 * j]; bv[j] = ((const f32x4*)bta)[lane + 64 * j]; }
    unsigned* gcnt = WSP(unsigned, OFF_CTL) + CW_GCNT; int* eidx = WSP(int, OFF_EIDX); float* egate = WSP(float, OFF_EGATE); int* tsl = WSP(int, OFF_TOKSLOT);
    for (int row = gw; row < M; row += ngw) {
        f32x4* xr = (f32x4*)(p.out + (size_t)row * D) + lane; f32x4 v[4]; float s = 0.f;
#pragma unroll
        for (int j = 0; j < 4; ++j) { v[j] = xr[64 * j]; s += (v[j][0] + v[j][1]) + (v[j][2] + v[j][3]); }
        const float mean = wave_sum(s) * (1.f / D); float s2 = 0.f;
#pragma unroll
        for (int j = 0; j < 4; ++j) { v[j] = v[j] - mean; s2 += (v[j][0] * v[j][0] + v[j][1] * v[j][1]) + (v[j][2] * v[j][2] + v[j][3] * v[j][3]); }
        const float rstd = 1.f / sqrtf(wave_sum(s2) * (1.f / D) + EPS);
        unsigned long long* o8 = (unsigned long long*)(WSP(bf16_t, OFF_XB) + (size_t)row * D) + lane;
        float lg[NE];
#pragma unroll
        for (int e = 0; e < NE; ++e) lg[e] = 0.f;
#pragma unroll
        for (int j = 0; j < 4; ++j) { const f32x4 y = v[j] * rstd * gv[j] + bv[j]; xr[64 * j] = y; o8[64 * j] = (unsigned long long)pk2(y[0], y[1]) | ((unsigned long long)pk2(y[2], y[3]) << 32);
            const f32x4* rw4 = (const f32x4*)(p.rw + (size_t)(4 * lane + 256 * j) * NE);
#pragma unroll
            for (int c = 0; c < 4; ++c) { const f32x4 r0 = rw4[2 * c], r1 = rw4[2 * c + 1];
                lg[0] += y[c] * r0[0]; lg[1] += y[c] * r0[1]; lg[2] += y[c] * r0[2]; lg[3] += y[c] * r0[3]; lg[4] += y[c] * r1[0]; lg[5] += y[c] * r1[1]; lg[6] += y[c] * r1[2]; lg[7] += y[c] * r1[3]; } }
#pragma unroll
        for (int e = 0; e < NE; ++e) lg[e] = wave_sum(lg[e]);
        float mx = lg[0];
#pragma unroll
        for (int e = 1; e < NE; ++e) mx = fmaxf(mx, lg[e]);
        float pr[NE]; float sum = 0.f;
#pragma unroll
        for (int e = 0; e < NE; ++e) { pr[e] = expf(lg[e] - mx); sum += pr[e]; }
        int i1 = 0; float p1 = pr[0] / sum;
#pragma unroll
        for (int e = 1; e < NE; ++e) { const float pe = pr[e] / sum; if (pe > p1) { p1 = pe; i1 = e; } }
        int i2 = -1; float p2 = -1.f;
#pragma unroll
        for (int e = 0; e < NE; ++e) { const float pe = pr[e] / sum; if (e != i1 && pe > p2) { p2 = pe; i2 = e; } }
        if (lane == 0) {
            const unsigned q1 = __hip_atomic_fetch_add(lcnt + i1, 1u, __ATOMIC_RELAXED, __HIP_MEMORY_SCOPE_WORKGROUP), q2 = __hip_atomic_fetch_add(lcnt + i2, 1u, __ATOMIC_RELAXED, __HIP_MEMORY_SCOPE_WORKGROUP);
            eidx[row * 2] = i1; eidx[row * 2 + 1] = i2; egate[row * 2] = p1 / (p1 + p2); egate[row * 2 + 1] = p2 / (p1 + p2); tsl[row * 2] = (int)q1; tsl[row * 2 + 1] = (int)q2; }
    }
    __syncthreads();
    if (tid < NE) lbase[tid] = __hip_atomic_fetch_add(gcnt + 64 * tid, lcnt[tid], __ATOMIC_RELAXED, __HIP_MEMORY_SCOPE_AGENT);
    __syncthreads();
    if (lane == 0) for (int row = gw; row < M; row += ngw) { tsl[row * 2] += (int)lbase[eidx[row * 2]]; tsl[row * 2 + 1] += (int)lbase[eidx[row * 2 + 1]]; }
}
__device__ __forceinline__ void moe_offsets(const P& p, int (&offs)[NE + 1]) {
    const unsigned* gcnt = WSP(unsigned, OFF_CTL) + CW_GCNT; int o = 0;
#pragma unroll
    for (int e = 0; e < NE; ++e) { offs[e] = o; o += (int)((__hip_atomic_load(gcnt + 64 * e, __ATOMIC_RELAXED, __HIP_MEMORY_SCOPE_AGENT) + 255u) & ~255u); }
    offs[NE] = o;
}
__device__ __forceinline__ void op_moe_scatter(const P& p, const int tid) {
    const int lane = tid & 63, gw = blockIdx.x * (OPT_THREADS / 64) + (tid >> 6), ngw = gridDim.x * (OPT_THREADS / 64);
    int offs[NE + 1]; moe_offsets(p, offs);
    int* eidx = WSP(int, OFF_EIDX); float* egate = WSP(float, OFF_EGATE); int* tsl = WSP(int, OFF_TOKSLOT); float* gates = WSP(float, OFF_GATES);
    for (int pr = gw; pr < 2 * M; pr += ngw) {
        const int e = eidx[pr]; int ob = offs[0];
#pragma unroll
        for (int k = 1; k < NE; ++k) ob = (e == k) ? offs[k] : ob;
        const int srow = ob + tsl[pr];
        const U4* src = (const U4*)(WSP(bf16_t, OFF_XB) + (size_t)(pr >> 1) * D); U4* dst = (U4*)(WSP(bf16_t, OFF_XS) + (size_t)srow * D);
        const U4 a = src[lane], b = src[lane + 64]; dst[lane] = a; dst[lane + 64] = b;
        if (lane == 0) { gates[srow] = egate[pr]; }
        asm volatile("s_waitcnt vmcnt(0)" ::: "memory");
        if (lane == 0) tsl[pr] = srow;
    }
}
struct MoeOrder {
    int ts[NE + 1]; int nN, G, c;
    __device__ __forceinline__ void init(const int (&offs)[NE + 1], int nN_, int G_, int c_) {
#pragma unroll
        for (int e = 0; e <= NE; ++e) ts[e] = offs[e] >> 8;
        nN = nN_; G = G_; c = c_; }
    __device__ __forceinline__ bool next(int i, pg8::Unit& u) const {
        const int L = i * G + c; if (L >= ts[NE] * nN) return false;
        const int tau = L / nN, pn = L - tau * nN; int e = 0;
#pragma unroll
        for (int k = 1; k < NE; ++k) e += (tau >= ts[k]) ? 1 : 0;
        u.pm = tau; u.pn = e * nN + pn; return true; }
    __device__ __forceinline__ void a_ready(const pg8::Unit&) const {}
    __device__ __forceinline__ void done(const pg8::Unit&) const {}
};
struct EpiSwigluMoe {
    static constexpr bool PERM = true, AFTER_DRAIN = false;
    bf16_t* Hout; int ldh, nN;
    __device__ __forceinline__ void operator()(const f32x4 (&acc)[2][2][4][2], const pg8::Unit& u, int wr, int wc, int fr, int fq) const {
        const int rowb = u.pm * 256 + wr * 64 + fr; const int col = (u.pn % nN) * 128 + wc * 32 + 8 * fq;
#pragma unroll
        for (int ai = 0; ai < 2; ++ai)
#pragma unroll
            for (int m = 0; m < 4; ++m) { f32x4 h0, h1;
#pragma unroll
                for (int j = 0; j < 4; ++j) { const float a0 = acc[ai][0][m][0][j], a1 = acc[ai][0][m][1][j];
                    h0[j] = a0 * acc[ai][1][m][0][j] * __builtin_amdgcn_rcpf(1.0f + __expf(-a0)); h1[j] = a1 * acc[ai][1][m][1][j] * __builtin_amdgcn_rcpf(1.0f + __expf(-a1)); }
                *(U4*)(Hout + (size_t)(rowb + ai * 128 + m * 16) * ldh + col) = pack8(h0, h1); }
    }
};
struct EpiMoeDown {
    static constexpr bool PERM = true, AFTER_DRAIN = false;
    bf16_t* Y; const float* gates;
    __device__ __forceinline__ void operator()(const f32x4 (&acc)[2][2][4][2], const pg8::Unit& u, int wr, int wc, int fr, int fq) const {
        const int rowb = u.pm * 256 + wr * 64 + fr; const int col = (u.pn & 3) * 256 + wc * 32 + 8 * fq;
#pragma unroll
        for (int ai = 0; ai < 2; ++ai)
#pragma unroll
            for (int m = 0; m < 4; ++m) { const int row = rowb + ai * 128 + m * 16; const float gt = gates[row];
#pragma unroll
                for (int bj = 0; bj < 2; ++bj) *(U4*)(Y + (size_t)row * D + col + bj * 128) = pack8(acc[ai][bj][m][0] * gt, acc[ai][bj][m][1] * gt); }
    }
};
__device__ __forceinline__ void op_moe_up(const P& p, LAS unsigned char* lds, const int tid) {
    static_assert(D / 256 == 4, "EpiMoeDown: four column tiles");
    int offs[NE + 1]; moe_offsets(p, offs);
    pg8::Gemm g{WSP(bf16_t, OFF_XS), WSP(bf16_t, OFF_W_M13), ROWS_PAD, 2 * DFE, D};
    MoeOrder S; S.init(offs, 2 * DFE / 256, (int)gridDim.x, (int)blockIdx.x); EpiSwigluMoe E{WSP(bf16_t, OFF_HE), DFE, 2 * DFE / 256};
    pg8::gemm_phase<EpiSwigluMoe, MoeOrder, true, true>(lds, g, S, E, tid);
}
__device__ __forceinline__ void op_moe_down(const P& p, LAS unsigned char* lds, const int tid) {
    int offs[NE + 1]; moe_offsets(p, offs);
    pg8::Gemm g{WSP(bf16_t, OFF_HE), WSP(bf16_t, OFF_W_M2), ROWS_PAD, D, DFE};
    MoeOrder S; S.init(offs, D / 256, (int)gridDim.x, (int)blockIdx.x); EpiMoeDown E{WSP(bf16_t, OFF_XS), WSP(float, OFF_GATES)};
    pg8::gemm_phase<EpiMoeDown, MoeOrder, true, true>(lds, g, S, E, tid);
}
__device__ __forceinline__ void op_ln_moe(const P& p, const float* g, const float* bta, const int tid) {
    const int lane = tid & 63, gw = blockIdx.x * (OPT_THREADS / 64) + (tid >> 6), ngw = gridDim.x * (OPT_THREADS / 64);
    f32x4 gv[4], bv[4];
#pragma unroll
    for (int j = 0; j < 4; ++j) { gv[j] = ((const f32x4*)g)[lane + 64 * j]; bv[j] = ((const f32x4*)bta)[lane + 64 * j]; }
    const int* tsl = WSP(int, OFF_TOKSLOT);
    for (int row = gw; row < M; row += ngw) {
        f32x4* xr = (f32x4*)(p.out + (size_t)row * D) + lane; f32x4 v[4]; float s = 0.f;
        const unsigned long long* y0 = (const unsigned long long*)(WSP(bf16_t, OFF_XS) + (size_t)tsl[row * 2] * D) + lane;
        const unsigned long long* y1 = (const unsigned long long*)(WSP(bf16_t, OFF_XS) + (size_t)tsl[row * 2 + 1] * D) + lane;
#pragma unroll
        for (int j = 0; j < 4; ++j) { const unsigned long long a = y0[64 * j], b = y1[64 * j]; const unsigned al = (unsigned)a, ah = (unsigned)(a >> 32), bl = (unsigned)b, bh = (unsigned)(b >> 32);
            f32x4 f; f[0] = bf_lo(al) + bf_lo(bl); f[1] = bf_hi(al) + bf_hi(bl); f[2] = bf_lo(ah) + bf_lo(bh); f[3] = bf_hi(ah) + bf_hi(bh);
            v[j] = xr[64 * j] * ALPHA + f; s += (v[j][0] + v[j][1]) + (v[j][2] + v[j][3]); }
        const float mean = wave_sum(s) * (1.f / D); float s2 = 0.f;
#pragma unroll
        for (int j = 0; j < 4; ++j) { v[j] = v[j] - mean; s2 += (v[j][0] * v[j][0] + v[j][1] * v[j][1]) + (v[j][2] * v[j][2] + v[j][3] * v[j][3]); }
        const float rstd = 1.f / sqrtf(wave_sum(s2) * (1.f / D) + EPS);
#pragma unroll
        for (int j = 0; j < 4; ++j) xr[64 * j] = v[j] * rstd * gv[j] + bv[j];
    }
}

typedef pg8::bf16x8 bf16x8;
typedef float f32x16 __attribute__((ext_vector_type(16)));
typedef short s16x4 __attribute__((ext_vector_type(4)));
typedef unsigned v4u __attribute__((ext_vector_type(4)));
constexpr int AT_KBUF = 64 * 208, AT_VSTR = 144, AT_VBUF = 64 * AT_VSTR;
constexpr int AT_K0 = 0, AT_V0 = 2 * AT_KBUF, AT_BIAS = AT_V0 + 2 * AT_VBUF, AT_WS = AT_BIAS + 512, AT_WSB = 3072, AT_OST = AT_WS + 8 * AT_WSB, AT_OSTB = 32 * 272, AT_MISC = AT_OST + 8 * AT_OSTB;
static_assert(AT_MISC + 256 <= LDS_BYTES, "attention LDS map");
constexpr int CW_QHEAD = 8192;
constexpr int N_ATT_UNITS = NB * 6 * (S / 256) * 2 + NB * (S / 64);
constexpr float AT_THR = 4.0f, AT_NEG = -1.0e30f;
enum { AM_MLA = 0, AM_FOX = 1, AM_SEL = 2, AM_WIN = 3, AM_CMP = 4 };

__device__ __forceinline__ float xhalf_max(float v) { auto rr = __builtin_amdgcn_permlane32_swap(__float_as_uint(v), __float_as_uint(v), false, false); return fmaxf(__uint_as_float(rr[0]), __uint_as_float(rr[1])); }
__device__ __forceinline__ float xhalf_sum(float v) { auto rr = __builtin_amdgcn_permlane32_swap(__float_as_uint(v), __float_as_uint(v), false, false); return __uint_as_float(rr[0]) + __uint_as_float(rr[1]); }
__device__ __forceinline__ s16x4 vtr(LAS const unsigned char* p) { typedef short v4i16_t __attribute__((ext_vector_type(4))); return __builtin_bit_cast(s16x4, __builtin_amdgcn_ds_read_tr16_b64_v4i16((LAS v4i16_t*)p)); }
__device__ __forceinline__ int crow_c(int r) { return (r & 3) + 8 * (r >> 2); }

template <int DK> struct TileRegs { v4u k0, k1, v0; float bias; };
template <int DK, bool BIAS> __device__ __forceinline__ void tile_load(TileRegs<DK>& R, const bf16_t* Kg, int kpitch, const bf16_t* Vg, int vpitch, const float* Bg, int tile, int tid) {
    constexpr int CPR = DK / 8;
    { const int key = tid / CPR, part = tid % CPR; R.k0 = *(const v4u*)(Kg + (size_t)(tile * 64 + key) * kpitch + part * 8); }
    if (DK == 96) { if (tid < 256) { const int c2 = tid + 512, key = c2 / CPR, part = c2 % CPR; R.k1 = *(const v4u*)(Kg + (size_t)(tile * 64 + key) * kpitch + part * 8); } }
    R.v0 = *(const v4u*)(Vg + (size_t)(tile * 64 + (tid >> 3)) * vpitch + (tid & 7) * 8);
    if (BIAS) { if (tid < 64) R.bias = Bg[tile * 64 + tid]; }
}
template <int DK, bool BIAS> __device__ __forceinline__ void tile_store(const TileRegs<DK>& R, LAS unsigned char* lds, int buf, int tid) {
    constexpr int CPR = DK / 8, KSTR = DK * 2 + 16;
    { const int key = tid / CPR, part = tid % CPR; *(LAS v4u*)(lds + AT_K0 + buf * AT_KBUF + key * KSTR + part * 16) = R.k0; }
    if (DK == 96) { if (tid < 256) { const int c2 = tid + 512, key = c2 / CPR, part = c2 % CPR; *(LAS v4u*)(lds + AT_K0 + buf * AT_KBUF + key * KSTR + part * 16) = R.k1; } }
    *(LAS v4u*)(lds + AT_V0 + buf * AT_VBUF + (tid >> 3) * AT_VSTR + (tid & 7) * 16) = R.v0;
    if (BIAS) { if (tid < 64) *(LAS float*)(lds + AT_BIAS + buf * 256 + tid * 4) = R.bias; }
}
template <int DK> __device__ __forceinline__ void tile_scores(LAS const unsigned char* lds, int buf, const bf16x8 (&qr)[DK / 16], f32x16& p0, f32x16& p1, int lane) {
    constexpr int KSTR = DK * 2 + 16;
    LAS const unsigned char* Kb = lds + AT_K0 + buf * AT_KBUF + (lane & 31) * KSTR + (lane >> 5) * 16;
#pragma unroll
    for (int r = 0; r < 16; ++r) { p0[r] = 0.f; p1[r] = 0.f; }
#pragma unroll
    for (int d0 = 0; d0 < DK / 16; ++d0) { const bf16x8 a0 = *(LAS const bf16x8*)(Kb + d0 * 32), a1 = *(LAS const bf16x8*)(Kb + 32 * KSTR + d0 * 32);
        p0 = __builtin_amdgcn_mfma_f32_32x32x16_bf16(a0, qr[d0], p0, 0, 0, 0); p1 = __builtin_amdgcn_mfma_f32_32x32x16_bf16(a1, qr[d0], p1, 0, 0, 0); }
}
template <int MODE> __device__ __forceinline__ void tile_bias_mask(LAS const unsigned char* lds, int buf, f32x16& p0, f32x16& p1, int lane, int kbase, int qpos, float rowf, bool rowsel, bool need_mask) {
    const int hi = lane >> 5;
    if (MODE == AM_FOX) { LAS const float* cb = (LAS const float*)(lds + AT_BIAS + buf * 256) + 4 * hi;
#pragma unroll
        for (int i = 0; i < 4; ++i) { const f32x4 c0 = *(LAS const f32x4*)(cb + 8 * i), c1 = *(LAS const f32x4*)(cb + 32 + 8 * i);
#pragma unroll
            for (int j = 0; j < 4; ++j) { p0[4 * i + j] += rowf - c0[j]; p1[4 * i + j] += rowf - c1[j]; } } }
    if (MODE == AM_SEL || MODE == AM_WIN || MODE == AM_CMP) { const float kf = (float)(kbase + 4 * hi);
#pragma unroll
        for (int r = 0; r < 16; ++r) { p0[r] = fmaf(rowf, kf + (float)crow_c(r), p0[r]); p1[r] = fmaf(rowf, kf + (float)(32 + crow_c(r)), p1[r]); } }
    if (need_mask) { const int k0 = kbase + 4 * hi;
#pragma unroll
        for (int r = 0; r < 16; ++r) { const int ka = k0 + crow_c(r), kb = ka + 32; bool oa = ka <= qpos, ob = kb <= qpos;
            if (MODE == AM_WIN) { oa = oa && (ka >= qpos - 255); ob = ob && (kb >= qpos - 255); }
            if (MODE == AM_SEL) { oa = oa && rowsel; ob = ob && rowsel; }
            p0[r] = oa ? p0[r] : AT_NEG; p1[r] = ob ? p1[r] : AT_NEG; } }
}
__device__ __forceinline__ void tile_softmax_pv(LAS const unsigned char* lds, int buf, f32x16& p0, f32x16& p1, f32x16 (&o)[2], float& m, float& l, LAS float* wsf, int lane) {
    const int r32 = lane & 31, hi = lane >> 5;
    float rm = fmaxf(p0[0], p1[0]);
#pragma unroll
    for (int r = 1; r < 16; ++r) rm = fmaxf(rm, fmaxf(p0[r], p1[r]));
    rm = xhalf_max(rm);
    const bool need = rm > m + AT_THR;
    if (__any(need)) {
        const float mn = need ? rm : m; const float alpha = __builtin_amdgcn_exp2f(m - mn); m = mn; l *= alpha;
        if (hi == 0) wsf[r32] = alpha;
#pragma unroll
        for (int i = 0; i < 4; ++i) { const f32x4 a = *(LAS const f32x4*)(wsf + 8 * i + 4 * hi);
#pragma unroll
            for (int j = 0; j < 4; ++j) { o[0][4 * i + j] *= a[j]; o[1][4 * i + j] *= a[j]; } }
    }
    float rs = 0.f;
#pragma unroll
    for (int r = 0; r < 16; ++r) { p0[r] = __builtin_amdgcn_exp2f(p0[r] - m); p1[r] = __builtin_amdgcn_exp2f(p1[r] - m); rs += p0[r] + p1[r]; }
    l += rs;
    v4u w0, w1, w2, w3;
    w0[0] = pk2(p0[0], p0[1]); w0[1] = pk2(p0[2], p0[3]); w0[2] = pk2(p0[4], p0[5]); w0[3] = pk2(p0[6], p0[7]);
    w1[0] = pk2(p0[8], p0[9]); w1[1] = pk2(p0[10], p0[11]); w1[2] = pk2(p0[12], p0[13]); w1[3] = pk2(p0[14], p0[15]);
    w2[0] = pk2(p1[0], p1[1]); w2[1] = pk2(p1[2], p1[3]); w2[2] = pk2(p1[4], p1[5]); w2[3] = pk2(p1[6], p1[7]);
    w3[0] = pk2(p1[8], p1[9]); w3[1] = pk2(p1[10], p1[11]); w3[2] = pk2(p1[12], p1[13]); w3[3] = pk2(p1[14], p1[15]);
    const bf16x8 pa[4] = {__builtin_bit_cast(bf16x8, w0), __builtin_bit_cast(bf16x8, w1), __builtin_bit_cast(bf16x8, w2), __builtin_bit_cast(bf16x8, w3)};
    LAS const unsigned char* Vb = lds + AT_V0 + buf * AT_VBUF + (4 * hi + ((lane & 15) >> 2)) * AT_VSTR + (((lane >> 4) & 1) * 16 + (lane & 3) * 4) * 2;
#pragma unroll
    for (int d0 = 0; d0 < 2; ++d0)
#pragma unroll
        for (int ks = 0; ks < 4; ++ks) { const s16x4 lo = vtr(Vb + (16 * ks) * AT_VSTR + d0 * 64), h4 = vtr(Vb + (16 * ks + 8) * AT_VSTR + d0 * 64);
            const bf16x8 vf = {lo[0], lo[1], lo[2], lo[3], h4[0], h4[1], h4[2], h4[3]};
            o[d0] = __builtin_amdgcn_mfma_f32_32x32x16_bf16(pa[ks], vf, o[d0], 0, 0, 0); }
}
template <bool ADD> __device__ __forceinline__ void rows_scale(f32x16 (&o)[2], f32x16 (&acc)[2], float f, LAS float* wsf, int lane) {
    const int r32 = lane & 31, hi = lane >> 5;
    if (hi == 0) wsf[r32] = f;
#pragma unroll
    for (int i = 0; i < 4; ++i) { const f32x4 a = *(LAS const f32x4*)(wsf + 8 * i + 4 * hi);
#pragma unroll
        for (int j = 0; j < 4; ++j) { if (ADD) { acc[0][4 * i + j] += a[j] * o[0][4 * i + j]; acc[1][4 * i + j] += a[j] * o[1][4 * i + j]; } else { o[0][4 * i + j] *= a[j]; o[1][4 * i + j] *= a[j]; } } }
}
__device__ __forceinline__ void out_store(const f32x16 (&o)[2], LAS unsigned char* stg, bf16_t* dst0, int lane, int mode_nsa) {
    const int r32 = lane & 31, hi = lane >> 5;
#pragma unroll
    for (int r = 0; r < 16; ++r) { const int orow = crow_c(r) + 4 * hi;
        *(LAS bf16_t*)(stg + orow * 144 + r32 * 2) = (bf16_t)(pk2(o[0][r], 0.f) & 0xffffu); *(LAS bf16_t*)(stg + orow * 144 + 64 + r32 * 2) = (bf16_t)(pk2(o[1][r], 0.f) & 0xffffu); }
#pragma unroll
    for (int i = 0; i < 4; ++i) { const int row = i * 8 + (lane >> 3), ch = lane & 7; const v4u v = *(LAS const v4u*)(stg + row * 144 + ch * 16);
        const size_t off = mode_nsa ? ((size_t)(row >> 2) * MIXW + (row & 3) * 64) : (size_t)row * MIXW;
        *(v4u*)(dst0 + off + ch * 8) = v; }
}

template <bool FIRST> __device__ __forceinline__ void rows_accum_lds(const f32x16 (&o)[2], float f, LAS float* wsf, LAS float* img, int lane) {
    const int r32 = lane & 31, hi = lane >> 5;
    if (hi == 0) wsf[r32] = f;
#pragma unroll
    for (int i = 0; i < 4; ++i) { const f32x4 a = *(LAS const f32x4*)(wsf + 8 * i + 4 * hi);
#pragma unroll
        for (int j = 0; j < 4; ++j) { LAS float* q = img + (8 * i + 4 * hi + j) * 68 + r32;
            if (FIRST) { q[0] = a[j] * o[0][4 * i + j]; q[32] = a[j] * o[1][4 * i + j]; } else { q[0] += a[j] * o[0][4 * i + j]; q[32] += a[j] * o[1][4 * i + j]; } } }
}
__device__ __forceinline__ void out_store_img(LAS const float* img, bf16_t* dst0, int lane) {
#pragma unroll
    for (int i = 0; i < 4; ++i) { const int row = i * 8 + (lane >> 3), ch = lane & 7; const f32x4 a = *(LAS const f32x4*)(img + row * 68 + ch * 8), b = *(LAS const f32x4*)(img + row * 68 + ch * 8 + 4);
        *(U4*)(dst0 + (size_t)(row >> 2) * MIXW + (row & 3) * 64 + ch * 8) = pack8(a, b); }
}

template <int DK, int MODE> __device__ __forceinline__ void attn_unit_causal(const P& p, LAS unsigned char* lds, int b, int h, int qb, const int tid) {
    const int lane = tid & 63, wave = __builtin_amdgcn_readfirstlane(tid >> 6), r32 = lane & 31, hi = lane >> 5;
    constexpr bool BIAS = (MODE == AM_FOX);
    const int qpitch = (MODE == AM_MLA) ? 576 : 384, hoff = (MODE == AM_MLA) ? h * 96 : h * 64;
    const bf16_t* Qg = WSP(bf16_t, MODE == AM_MLA ? OFF_QM : OFF_FQ) + (size_t)b * S * qpitch + hoff;
    const bf16_t* Kg = WSP(bf16_t, MODE == AM_MLA ? OFF_KM : OFF_FK) + (size_t)b * S * qpitch + hoff;
    const bf16_t* Vg = WSP(bf16_t, MODE == AM_MLA ? OFF_VM : OFF_FV) + (size_t)b * S * 384 + h * 64;
    const float* Bg = WSP(float, OFF_FC) + ((size_t)b * 6 + h) * S;
    const int q0w = qb * 256 + wave * 32, qpos = q0w + r32;
    bf16x8 qr[DK / 16];
#pragma unroll
    for (int d0 = 0; d0 < DK / 16; ++d0) qr[d0] = *(const bf16x8*)(Qg + (size_t)qpos * qpitch + d0 * 16 + hi * 8);
    const float rowf = BIAS ? Bg[qpos] : 0.f;
    LAS float* wsf = (LAS float*)(lds + AT_WS + wave * AT_WSB);
    f32x16 o[2]; float m = AT_NEG, l = 0.f;
#pragma unroll
    for (int r = 0; r < 16; ++r) { o[0][r] = 0.f; o[1][r] = 0.f; }
    const int nt = 4 * (qb + 1);
    TileRegs<DK> R; tile_load<DK, BIAS>(R, Kg, qpitch, Vg, 384, Bg, 0, tid); tile_store<DK, BIAS>(R, lds, 0, tid);
    __syncthreads();
    for (int t = 0; t < nt; ++t) {
        const int buf = t & 1;
        if (t + 1 < nt) tile_load<DK, BIAS>(R, Kg, qpitch, Vg, 384, Bg, t + 1, tid);
        if (t * 64 <= q0w + 31) {
            f32x16 p0, p1; tile_scores<DK>(lds, buf, qr, p0, p1, lane);
            tile_bias_mask<MODE>(lds, buf, p0, p1, lane, t * 64, qpos, rowf, true, t * 64 + 63 > q0w);
            tile_softmax_pv(lds, buf, p0, p1, o, m, l, wsf, lane);
        }
        if (t + 1 < nt) tile_store<DK, BIAS>(R, lds, buf ^ 1, tid);
        __syncthreads();
    }
    const float inv = 1.0f / xhalf_sum(l);
    rows_scale<false>(o, o, inv, wsf, lane);
    out_store(o, lds + AT_OST + wave * AT_OSTB, WSP(bf16_t, OFF_MIX) + (size_t)(b * S + q0w) * MIXW + (MODE == AM_MLA ? 0 : 384) + h * 64, lane, 0);
}

template <int MODE> __device__ __forceinline__ void nsa_branch_tiles(const P& p, LAS unsigned char* lds, const bf16_t* Kg, const bf16_t* Vg, unsigned tmask, const bf16x8 (&qr)[4], f32x16 (&o)[2], float& m, float& l,
                                                                     LAS float* wsf, int lane, int tid, int qpos, float rowf, unsigned selmask) {
    TileRegs<64> R; unsigned rem = tmask; int cur = __builtin_ctz(rem); rem &= rem - 1u; int buf = 0;
    tile_load<64, false>(R, Kg, 64, Vg, 64, nullptr, cur, tid); tile_store<64, false>(R, lds, 0, tid);
    __syncthreads();
    for (;;) {
        const int nxt = rem ? __builtin_ctz(rem) : -1; rem &= rem - 1u;
        if (nxt >= 0) tile_load<64, false>(R, Kg, 64, Vg, 64, nullptr, nxt, tid);
        { f32x16 p0, p1; tile_scores<64>(lds, buf, qr, p0, p1, lane);
          tile_bias_mask<MODE>(lds, buf, p0, p1, lane, cur * 64, qpos, rowf, ((selmask >> cur) & 1u) != 0u, true);
          tile_softmax_pv(lds, buf, p0, p1, o, m, l, wsf, lane); }
        if (nxt >= 0) tile_store<64, false>(R, lds, buf ^ 1, tid);
        __syncthreads();
        if (nxt < 0) break;
        cur = nxt; buf ^= 1;
    }
}
__device__ __forceinline__ void attn_unit_nsa(const P& p, LAS unsigned char* lds, int b, int tb, const int tid) {
    static_assert(S == 2048, "NSA unit: 32 selection blocks, 128 compressed keys");
    const int lane = tid & 63, wave = __builtin_amdgcn_readfirstlane(tid >> 6), r32 = lane & 31, hi = lane >> 5;
    const int tok0 = tb * 64 + wave * 8, t = tok0 + (r32 >> 2), hd = r32 & 3;
    const size_t rowg = (size_t)b * S + t;
    const float sl2 = LOG2E * (hd == 0 ? 0.25f : hd == 1 ? 0.0625f : hd == 2 ? 0.015625f : 0.00390625f);
    bf16x8 qr[4];
#pragma unroll
    for (int d0 = 0; d0 < 4; ++d0) qr[d0] = *(const bf16x8*)(WSP(bf16_t, OFF_NQ) + rowg * 256 + hd * 64 + d0 * 16 + hi * 8);
    const float* ng = WSP(float, OFF_NG) + rowg * 16 + hd * 3;
    const float g0 = 1.0f / (1.0f + __expf(-ng[0])), g1 = 1.0f / (1.0f + __expf(-ng[1])), g2 = 1.0f / (1.0f + __expf(-ng[2]));
    LAS float* wsf = (LAS float*)(lds + AT_WS + wave * AT_WSB); LAS float* Gs = wsf + 32; LAS float* Lx = wsf + 32 + 256; LAS unsigned* msk = (LAS unsigned*)(wsf + 32 + 256 + 8 * 33);
    LAS unsigned* umask = (LAS unsigned*)(lds + AT_MISC + 64);
    LAS float* img = (LAS float*)(lds + AT_OST + wave * AT_OSTB);
    f32x16 o[2];
#pragma unroll
    for (int r = 0; r < 16; ++r) { o[0][r] = 0.f; o[1][r] = 0.f; }
    const int nmax = t >= 31 ? (t - 31) >> 4 : -1;
    const bool two = tb >= 16;
    const bf16_t* KCg = WSP(bf16_t, OFF_KCC) + (size_t)b * CMPP * 64; const bf16_t* VCg = WSP(bf16_t, OFF_VCC) + (size_t)b * CMPP * 64;
    { TileRegs<64> R; tile_load<64, false>(R, KCg, 64, VCg, 64, nullptr, 0, tid); tile_store<64, false>(R, lds, 0, tid);
      if (two) { tile_load<64, false>(R, KCg, 64, VCg, 64, nullptr, 1, tid); tile_store<64, false>(R, lds, 1, tid); } }
    for (int i = lane; i < 256 + 8 * 33; i += 64) Gs[i] = 0.f;
    __syncthreads();
    float mc = AT_NEG, lc = 0.f;
    { f32x16 p0, p1; tile_scores<64>(lds, 0, qr, p0, p1, lane); tile_bias_mask<AM_CMP>(lds, 0, p0, p1, lane, 0, nmax, 16.f * sl2, true, true); tile_softmax_pv(lds, 0, p0, p1, o, mc, lc, wsf, lane); }
    if (two) { f32x16 p0, p1; tile_scores<64>(lds, 1, qr, p0, p1, lane); tile_bias_mask<AM_CMP>(lds, 1, p0, p1, lane, 64, nmax, 16.f * sl2, true, true); tile_softmax_pv(lds, 1, p0, p1, o, mc, lc, wsf, lane); }
    const float lct = xhalf_sum(lc); const float invc = (t >= 31) ? 1.0f / lct : 0.f;
    rows_accum_lds<true>(o, g0 * invc, wsf, img, lane);
#pragma unroll
    for (int tau = 0; tau < 2; ++tau) {
        if (tau == 1 && !two) break;
        f32x16 p0, p1; tile_scores<64>(lds, tau, qr, p0, p1, lane); tile_bias_mask<AM_CMP>(lds, tau, p0, p1, lane, 64 * tau, nmax, 16.f * sl2, true, true);
#pragma unroll
        for (int half = 0; half < 2; ++half)
#pragma unroll
            for (int i = 0; i < 4; ++i) { float e[4];
#pragma unroll
                for (int j = 0; j < 4; ++j) e[j] = __builtin_amdgcn_exp2f((half ? p1[4 * i + j] : p0[4 * i + j]) - mc) * invc;
                float gsum = (e[0] + e[1]) + (e[2] + e[3]), last = e[3];
                gsum += __shfl_xor(gsum, 1); gsum += __shfl_xor(gsum, 2); last += __shfl_xor(last, 1); last += __shfl_xor(last, 2);
                const int j = 16 * tau + 8 * half + 2 * i + hi;
                if (hd == 0) { Gs[(r32 >> 2) * 32 + j] = gsum; Lx[(r32 >> 2) * 33 + j + 1] = last; } }
    }
    { const int tl = lane >> 3, jq = lane & 7, tt = tok0 + tl, cur = tt >> 6; float mine[4]; int rank[4] = {0, 0, 0, 0};
#pragma unroll
      for (int c = 0; c < 4; ++c) { const int j = 4 * jq + c; float v = Gs[tl * 32 + j] + Lx[tl * 33 + j];
          v = (j == 0 || j == cur || j == cur - 1) ? 1.0e4f : (j > cur ? -1.0f : v); mine[c] = v; }
#pragma nounroll
      for (int k = 0; k < 32; ++k) { float u = Gs[tl * 32 + k] + Lx[tl * 33 + k]; u = (k == 0 || k == cur || k == cur - 1) ? 1.0e4f : (k > cur ? -1.0f : u);
#pragma unroll
          for (int c = 0; c < 4; ++c) rank[c] += (u > mine[c] || (u == mine[c] && k < 4 * jq + c)) ? 1 : 0; }
      unsigned bits = 0u;
#pragma unroll
      for (int c = 0; c < 4; ++c) bits |= (rank[c] < 8 ? 1u : 0u) << (4 * jq + c);
      bits |= __shfl_xor(bits, 1); bits |= __shfl_xor(bits, 2); bits |= __shfl_xor(bits, 4);
      if (jq == 0) msk[tl] = bits;
      unsigned ub = bits; ub |= __shfl_xor(ub, 8); ub |= __shfl_xor(ub, 16); ub |= __shfl_xor(ub, 32);
      if (lane == 0) umask[wave] = ub; }
    const unsigned selmask = msk[r32 >> 2];
    __syncthreads();
    unsigned U = 0u;
#pragma unroll
    for (int w = 0; w < 8; ++w) U |= umask[w];
    U &= (tb == 31) ? 0xffffffffu : ((2u << tb) - 1u);
    U = __builtin_amdgcn_readfirstlane(U);
    { float ms = AT_NEG, ls = 0.f;
#pragma unroll
      for (int r = 0; r < 16; ++r) { o[0][r] = 0.f; o[1][r] = 0.f; }
      nsa_branch_tiles<AM_SEL>(p, lds, WSP(bf16_t, OFF_KS) + (size_t)b * S * 64, WSP(bf16_t, OFF_VS) + (size_t)b * S * 64, U, qr, o, ms, ls, wsf, lane, tid, t, sl2, selmask);
      rows_accum_lds<false>(o, g1 / xhalf_sum(ls), wsf, img, lane); }
    { float mw = AT_NEG, lw = 0.f;
#pragma unroll
      for (int r = 0; r < 16; ++r) { o[0][r] = 0.f; o[1][r] = 0.f; }
      const int lo = tb >= 4 ? tb - 4 : 0; const unsigned W = ((tb == 31) ? 0xffffffffu : ((2u << tb) - 1u)) & ~((1u << lo) - 1u);
      nsa_branch_tiles<AM_WIN>(p, lds, WSP(bf16_t, OFF_KW) + (size_t)b * S * 64, WSP(bf16_t, OFF_VW) + (size_t)b * S * 64, W, qr, o, mw, lw, wsf, lane, tid, t, sl2, 0xffffffffu);
      rows_accum_lds<false>(o, g2 / xhalf_sum(lw), wsf, img, lane); }
    out_store_img(img, WSP(bf16_t, OFF_MIX) + (size_t)(b * S + tok0) * MIXW + 768, lane);
}

__device__ __forceinline__ int att_unit_cost(int id) {
    const int type = id >> 16, qb = id & 31;
    if (type == 0) return 4 * (qb + 1) * 20; if (type == 1) return 4 * (qb + 1) * 16;
    return ((qb >= 16 ? 4 : 2) + (qb + 1) + (qb < 4 ? qb + 1 : 5)) * 16 + 24;
}
__device__ __forceinline__ int att_unit_id(int i) {
    if (i < NB * 6 * 8) { const int qb = i & 7, h = (i >> 3) % 6, b = i / 48; return (0 << 16) | (b << 8) | (h << 5) | qb; }
    i -= NB * 6 * 8;
    if (i < NB * 6 * 8) { const int qb = i & 7, h = (i >> 3) % 6, b = i / 48; return (1 << 16) | (b << 8) | (h << 5) | qb; }
    i -= NB * 6 * 8; return (2 << 16) | ((i >> 5) << 8) | (i & 31);
}
__device__ __forceinline__ void build_att_list(const P& p, int tid) {
    int* list = WSP(int, OFF_ATTLIST);
    for (int i = tid; i < N_ATT_UNITS; i += OPT_THREADS) { const int id = att_unit_id(i), c = att_unit_cost(id); int rank = 0;
        for (int k = 0; k < N_ATT_UNITS; ++k) { const int ck = att_unit_cost(att_unit_id(k)); rank += (ck > c || (ck == c && k < i)) ? 1 : 0; }
        list[rank] = id; }
}
__device__ __forceinline__ void op_attn(const P& p, int layer, LAS unsigned char* lds, const int tid0) {
    const int* list = WSP(int, OFF_ATTLIST); unsigned* qhead = WSP(unsigned, OFF_CTL) + CW_QHEAD + 64 * layer; LAS int* slot = (LAS int*)(lds + AT_MISC);
    for (;;) {
        if (tid0 == 0) *slot = (int)__hip_atomic_fetch_add(qhead, 1u, __ATOMIC_RELAXED, __HIP_MEMORY_SCOPE_AGENT);
        __syncthreads();
        const int idx = __builtin_amdgcn_readfirstlane(*slot);
        __syncthreads();
        if (idx >= N_ATT_UNITS) break;
        const int id = __builtin_amdgcn_readfirstlane(list[idx]); const int type = id >> 16, b = (id >> 8) & 255, h = (id >> 5) & 7, qb = id & 31;
        int tidv = tid0; asm volatile("" : "+v"(tidv));
        if (type == 0) attn_unit_causal<96, AM_MLA>(p, lds, b, h, qb, tidv);
        else if (type == 1) attn_unit_causal<64, AM_FOX>(p, lds, b, h, qb, tidv);
        else attn_unit_nsa(p, lds, b, qb, tidv);
        __syncthreads();
    }
}

__device__ __forceinline__ void op_fox_scan(const P& p, int layer, int tid) {
    static_assert(S == 2048, "op_fox_scan: 32 steps per lane");
    const int lane = tid & 63, gw = (int)(gridDim.x * 8 - 1) - (int)(blockIdx.x * 8 + (tid >> 6));
    if (gw >= NB * 6) return;
    const int b = gw / 6, h = gw % 6; const float bias = p.b_forget[layer * 6 + h];
    const float* fl = WSP(float, OFF_FL) + ((size_t)b * S + 32 * lane) * 8 + h; float* fc = WSP(float, OFF_FC) + ((size_t)b * 6 + h) * S + 32 * lane;
    float ls[32]; float run = 0.f;
#pragma unroll
    for (int i = 0; i < 32; ++i) { const float xv = fl[i * 8] + bias; ls[i] = fminf(xv, 0.f) - log1pf(__expf(-fabsf(xv))); run += ls[i]; }
    float inc = run;
#pragma unroll
    for (int o = 1; o < 64; o <<= 1) { const float v = __shfl_up(inc, o); if (lane >= o) inc += v; }
    float c = inc - run;
#pragma unroll
    for (int i = 0; i < 32; ++i) { c += ls[i]; fc[i] = c * LOG2E; }
}
__device__ __forceinline__ void op_compress(const P& p, int layer, LAS unsigned char* lds, int tid) {
    const int lane = tid & 63, wave = __builtin_amdgcn_readfirstlane(tid >> 6), r32 = lane & 31, hi = lane >> 5, wc = wave & 3, kh = wave >> 2;
    LAS float* part = (LAS float*)lds;
    LAS bf16_t* hids = (LAS bf16_t*)(lds + 32 * 132 * 4);
    for (int u = blockIdx.x; u < 2 * (NB * CMPP / 32); u += gridDim.x) {
        const int wch = u & 1, rt = u >> 1;
        const bf16_t* A = WSP(bf16_t, wch ? OFF_VCR : OFF_KCR) + (size_t)(32 * rt + r32) * 1024 + kh * 1024 + hi * 8;
        const bf16_t* B = WSP(bf16_t, OFF_W_C1) + ((size_t)(layer * 2 + wch) * 128 + 32 * wc + r32) * 2048 + kh * 1024 + hi * 8;
        f32x16 acc;
#pragma unroll
        for (int r = 0; r < 16; ++r) acc[r] = 0.f;
#pragma unroll 8
        for (int ks = 0; ks < 64; ++ks) { const bf16x8 a = *(const bf16x8*)(A + ks * 16), bb = *(const bf16x8*)(B + ks * 16); acc = __builtin_amdgcn_mfma_f32_32x32x16_bf16(a, bb, acc, 0, 0, 0); }
        if (kh == 1) {
#pragma unroll
            for (int r = 0; r < 16; ++r) part[(crow_c(r) + 4 * hi) * 132 + 32 * wc + r32] = acc[r]; }
        __syncthreads();
        if (kh == 0) { const float cb = WSP(float, OFF_CBIAS)[(layer * 2 + wch) * 128 + 32 * wc + r32];
#pragma unroll
            for (int r = 0; r < 16; ++r) { const int row = crow_c(r) + 4 * hi; const float v = acc[r] + part[row * 132 + 32 * wc + r32] + cb;
                hids[row * 136 + 32 * wc + r32] = (bf16_t)(pk2(v * __builtin_amdgcn_rcpf(1.0f + __expf(-v)), 0.f) & 0xffffu); } }
        __syncthreads();
        if (wave < 2) {
            const bf16_t* W2 = WSP(bf16_t, OFF_W_C2) + ((size_t)(layer * 2 + wch) * 64 + 32 * wave + r32) * 128 + hi * 8;
            f32x16 o2;
#pragma unroll
            for (int r = 0; r < 16; ++r) o2[r] = 0.f;
#pragma unroll
            for (int ks = 0; ks < 8; ++ks) { const bf16x8 a = *(LAS const bf16x8*)(hids + r32 * 136 + ks * 16 + hi * 8), bb = *(const bf16x8*)(W2 + ks * 16); o2 = __builtin_amdgcn_mfma_f32_32x32x16_bf16(a, bb, o2, 0, 0, 0); }
            bf16_t* dst = WSP(bf16_t, wch ? OFF_VCC : OFF_KCC) + (size_t)(32 * rt) * 64 + 32 * wave + r32;
#pragma unroll
            for (int r = 0; r < 16; ++r) dst[(crow_c(r) + 4 * hi) * 64] = (bf16_t)(pk2(o2[r], 0.f) & 0xffffu);
        }
        __syncthreads();
    }
}

#define TIDV(t) int t = threadIdx.x; asm volatile("" : "+v"(t))
template <int LAYER> __device__ __forceinline__ void mega_layer(const P& p, LAS unsigned char* lds, const XcdBarrier& bar) {
    { TIDV(t); op_inproj(p, LAYER, lds, t); } xcd_barrier(bar);
    { TIDV(t); op_compress(p, LAYER, lds, t); op_fox_scan(p, LAYER, t); }
    { TIDV(t); op_mla_qup(p, LAYER, lds, t); }
    { TIDV(t); op_mla_kvup(p, LAYER, lds, t); } xcd_barrier(bar);
    { TIDV(t); op_attn(p, LAYER, lds, t); } xcd_barrier(bar);
    { TIDV(t); op_wout(p, LAYER, lds, t); } xcd_barrier(bar);
    if (LAYER == 0) {
        { TIDV(t); op_ln(p, p.ln1g + LAYER * D, p.ln1b + LAYER * D, t); } xcd_barrier(bar);
        { TIDV(t); op_ffn_up(p, lds, t); } xcd_barrier(bar);
        { TIDV(t); op_ffn_down(p, lds, t); } xcd_barrier(bar);
        { TIDV(t); op_ln(p, p.ln2g + LAYER * D, p.ln2b + LAYER * D, t); } xcd_barrier(bar);
    } else {
        { TIDV(t); op_ln_router(p, p.ln1g + LAYER * D, p.ln1b + LAYER * D, lds, t); } xcd_barrier(bar);
        { TIDV(t); op_moe_scatter(p, t); } xcd_barrier(bar);
        { TIDV(t); op_moe_up(p, lds, t); } xcd_barrier(bar);
        { TIDV(t); op_moe_down(p, lds, t); } xcd_barrier(bar);
        { TIDV(t); op_ln_moe(p, p.ln2g + LAYER * D, p.ln2b + LAYER * D, t); }
    }
}
__global__ void __launch_bounds__(OPT_THREADS, 2) mega(P p) {
    extern __shared__ __attribute__((aligned(16))) unsigned char smem[];
    LAS unsigned char* lds = (LAS unsigned char*)smem;
    volatile LAS unsigned* xbw = (volatile LAS unsigned*)(lds + LDS_BYTES - 64);
    if (threadIdx.x < 4) xbw[threadIdx.x] = 0u;
    __syncthreads();
    XcdBarrier bar = xcd_barrier_post((unsigned*)(p.ws + OFF_CTL), xbw);
    { TIDV(t); op_prologue(p, lds, t); } xcd_barrier(bar);
    mega_layer<0>(p, lds, bar);
    mega_layer<1>(p, lds, bar);
}

extern "C" void kernel_launch(void* const* d_in, const int* in_sizes, int n_in, void* d_out, int out_size, void* d_ws, size_t ws_size, hipStream_t stream) {
    P p{};
    const float** pp = (const float**)&p;
    for (int i = 0; i < 25; ++i) pp[i] = (const float*)d_in[i];
    p.out = (float*)d_out; p.ws = (unsigned char*)d_ws;
    if (ws_size < WS_NEEDED) return;
    static int grid = 0;
    if (!grid) {
        int dev = 0, cus = 0, per_cu = 0;
        (void)hipGetDevice(&dev);
        (void)hipDeviceGetAttribute(&cus, hipDeviceAttributeMultiprocessorCount, dev);
        (void)hipFuncSetAttribute((const void*)mega, hipFuncAttributeMaxDynamicSharedMemorySize, LDS_BYTES);
        (void)hipOccupancyMaxActiveBlocksPerMultiprocessor(&per_cu, (const void*)mega, OPT_THREADS, LDS_BYTES);
        (void)hipGetLastError();
        grid = (per_cu >= 1) ? cus : -1;
    }
    if (grid <= 0) return;
    (void)hipMemsetAsync(d_ws, 0, 65536, stream);
    mega<<<grid, OPT_THREADS, LDS_BYTES, stream>>>(p);
}
#endif
```

```cpp
#ifndef HOST_TEST
#include <hip/hip_runtime.h>
#define HD __host__ __device__ __forceinline__
#else
#include <cmath>
#include <cstdint>
#include <cstring>
#include <cstdio>
#define HD inline
#endif
#include <stdint.h>

#ifndef CFG_D
#define CFG_D 1024
#define CFG_B 16
#define CFG_S 2048
#define CFG_DFF 2816
#define CFG_DFE 1408
#endif
constexpr int D = CFG_D, NB = CFG_B, S = CFG_S, M = NB * S, DFF = CFG_DFF, DFE = CFG_DFE;
constexpr int NE = 8, MIXW = 1024, IN_COLS = 2482, NBLK = S / 64, NCMP = (S - 32) / 16 + 1;
constexpr int CMPP = S / 16;
constexpr int ZC_CQ = 0, ZC_CKV = 384, ZC_KR = 640, ZC_FOX = 672, ZC_FF = 1824, ZC_NQ = 1830, ZC_KC = 2086, ZC_VC = 2150, ZC_KS = 2214, ZC_VS = 2278, ZC_KW = 2342, ZC_VW = 2406, ZC_NG = 2470;
constexpr float LOG2E = 1.4426950408889634f;
constexpr float MLA_QS = 0.10206207261596575f * LOG2E;
constexpr float HD_QS = 0.125f * LOG2E;
constexpr float ALPHA = 1.4142135623730951f;
constexpr float EPS = 1e-5f;
typedef uint16_t bf16_t;
struct alignas(16) U4 { uint32_t x, y, z, w; };

constexpr size_t al256(size_t x) { return (x + 255) & ~(size_t)255; }
constexpr int NPAD_IN = 2560;
constexpr int ROWS_PAD = 2 * M + NE * 256;
constexpr size_t OFF_CTL = 0;
constexpr size_t OFF_SSQ = 65536;
constexpr size_t OFF_ROPE = OFF_SSQ + al256((size_t)M * 20 * 4);
constexpr size_t OFF_CBIAS = OFF_ROPE + al256((size_t)S * 32 * 4);
constexpr size_t OFF_EIDX = OFF_CBIAS + al256(2 * 2 * 128 * 4);
constexpr size_t OFF_EGATE = OFF_EIDX + al256((size_t)M * 2 * 4);
constexpr size_t OFF_TOKSLOT = OFF_EGATE + al256((size_t)M * 2 * 4);
constexpr size_t OFF_GATES = OFF_TOKSLOT + al256((size_t)M * 2 * 4);
constexpr size_t OFF_ATTLIST = OFF_GATES + al256((size_t)ROWS_PAD * 4);
constexpr size_t OFF_W_IN = OFF_ATTLIST + al256(4096 * 4);
constexpr size_t OFF_W_UQ = OFF_W_IN + al256((size_t)2 * NPAD_IN * D * 2);
constexpr size_t OFF_W_UKV = OFF_W_UQ + al256((size_t)2 * 768 * 384 * 2);
constexpr size_t OFF_W_C1 = OFF_W_UKV + al256((size_t)2 * 768 * 256 * 2);
constexpr size_t OFF_W_C2 = OFF_W_C1 + al256((size_t)2 * 2 * 128 * 2048 * 2);
constexpr size_t OFF_W_OUT = OFF_W_C2 + al256((size_t)2 * 2 * 64 * 128 * 2);
constexpr size_t OFF_W_F13 = OFF_W_OUT + al256((size_t)2 * D * MIXW * 2);
constexpr size_t OFF_W_F2 = OFF_W_F13 + al256((size_t)2 * DFF * D * 2);
constexpr size_t OFF_W_M13 = OFF_W_F2 + al256((size_t)D * DFF * 2);
constexpr size_t OFF_W_M2 = OFF_W_M13 + al256((size_t)NE * 2 * DFE * D * 2);
constexpr size_t OFF_BIG = OFF_W_M2 + al256((size_t)NE * D * DFE * 2);
constexpr size_t OFF_XB = OFF_BIG;
constexpr size_t OFF_MIX = OFF_XB + al256((size_t)M * D * 2);
constexpr size_t OFF_ARENA = OFF_MIX + al256((size_t)M * MIXW * 2);
constexpr size_t OFF_CQ = OFF_ARENA;
constexpr size_t OFF_CKV = OFF_CQ + al256((size_t)M * 384 * 2);
constexpr size_t OFF_RQ = OFF_CKV + al256((size_t)M * 256 * 2);
constexpr size_t OFF_RKV = OFF_RQ + al256((size_t)M * 4);
constexpr size_t OFF_QM = OFF_RKV + al256((size_t)M * 4);
constexpr size_t OFF_KM = OFF_QM + al256((size_t)M * 576 * 2);
constexpr size_t OFF_VM = OFF_KM + al256((size_t)M * 576 * 2);
constexpr size_t OFF_FQ = OFF_VM + al256((size_t)M * 384 * 2);
constexpr size_t OFF_FK = OFF_FQ + al256((size_t)M * 384 * 2);
constexpr size_t OFF_FV = OFF_FK + al256((size_t)M * 384 * 2);
constexpr size_t OFF_FL = OFF_FV + al256((size_t)M * 384 * 2);
constexpr size_t OFF_FC = OFF_FL + al256((size_t)M * 8 * 4);
constexpr size_t OFF_NQ = OFF_FC + al256((size_t)NB * 6 * S * 4);
constexpr size_t OFF_KCR = OFF_NQ + al256((size_t)M * 256 * 2);
constexpr size_t OFF_VCR = OFF_KCR + al256((size_t)(M * 64 + 2048) * 2);
constexpr size_t OFF_KS = OFF_VCR + al256((size_t)(M * 64 + 2048) * 2);
constexpr size_t OFF_VS = OFF_KS + al256((size_t)M * 64 * 2);
constexpr size_t OFF_KW = OFF_VS + al256((size_t)M * 64 * 2);
constexpr size_t OFF_VW = OFF_KW + al256((size_t)M * 64 * 2);
constexpr size_t OFF_NG = OFF_VW + al256((size_t)M * 64 * 2);
constexpr size_t OFF_HID = OFF_NG + al256((size_t)M * 16 * 4);
constexpr size_t OFF_KCC = OFF_HID + al256((size_t)2 * NB * CMPP * 128 * 4);
constexpr size_t OFF_VCC = OFF_KCC + al256((size_t)NB * CMPP * 64 * 2);
constexpr size_t OFF_CST = OFF_VCC + al256((size_t)NB * CMPP * 64 * 2);
constexpr size_t OFF_IMP = OFF_CST + al256((size_t)M * 8 * 4);
constexpr size_t OFF_SEL = OFF_IMP + al256((size_t)M * 32 * 4);
constexpr size_t OFF_ATT_END = OFF_SEL + al256((size_t)M * 4);
constexpr size_t OFF_H = OFF_ARENA;
constexpr size_t OFF_H2 = OFF_ARENA;
constexpr size_t OFF_HE = OFF_MIX;
constexpr size_t OFF_XS = OFF_HE + al256((size_t)ROWS_PAD * DFE * 2);
constexpr size_t OFF_MOE_END = OFF_XS + al256((size_t)ROWS_PAD * D * 2);
constexpr size_t cmax(size_t a, size_t b) { return a > b ? a : b; }
constexpr size_t WS_NEEDED = cmax(cmax(OFF_ATT_END, OFF_MOE_END), cmax(OFF_H + (size_t)M * DFF * 2, OFF_H2 + (size_t)M * 2 * DFE * 2));
#if CFG_D == 1024
static_assert(WS_NEEDED <= (size_t)512 * 1024 * 1024, "workspace fits in 4 x the largest tensor");
#endif

struct P {
    const float *x, *w_in, *b_forget, *g_cq, *w_uq, *g_ckv, *w_ukv, *ckp, *ckw1, *ckw2, *cvp, *cvw1, *cvw2, *w_out, *ln1g, *ln1b, *ln2g, *ln2b, *fw1, *fw3, *fw2, *rw, *mw1, *mw3, *mw2;
    float* out; unsigned char* ws;
};
#define WSP(T, off) ((T*)(p.ws + (off)))

HD float u2f(uint32_t u) { return __builtin_bit_cast(float, u); }
HD uint32_t f2u(float f) { return __builtin_bit_cast(uint32_t, f); }
HD float bf2f(bf16_t v) { return u2f((uint32_t)v << 16); }
HD bf16_t f2bf(float f) { uint32_t u = f2u(f); return (bf16_t)((u + 0x7fffu + ((u >> 16) & 1u)) >> 16); }
HD float bflo(uint32_t u) { return u2f(u << 16); }
HD float bfhi(uint32_t u) { return u2f(u & 0xffff0000u); }
HD float sigmoidf_(float x) { return 1.0f / (1.0f + expf(-x)); }
HD float siluf_(float x) { return x / (1.0f + expf(-x)); }
HD float dot8(const U4& a, const float* w) { return bflo(a.x) * w[0] + bfhi(a.x) * w[1] + bflo(a.y) * w[2] + bfhi(a.y) * w[3] + bflo(a.z) * w[4] + bfhi(a.z) * w[5] + bflo(a.w) * w[6] + bfhi(a.w) * w[7]; }
HD void unpack8(const U4& a, float* w) { w[0] = bflo(a.x); w[1] = bfhi(a.x); w[2] = bflo(a.y); w[3] = bfhi(a.y); w[4] = bflo(a.z); w[5] = bfhi(a.z); w[6] = bflo(a.w); w[7] = bfhi(a.w); }
HD void rope_cs(int pos, int i, float& c, float& s) {
    const float fr = exp2f(-(float)i * 0.830482023721841f);
    double a = (double)pos * (double)fr; a -= 6.283185307179586 * floor(a * 0.15915494309189535);
#ifdef HOST_TEST
    c = (float)cos(a); s = (float)sin(a);
#else
    c = __cosf((float)a); s = __sinf((float)a);
#endif
}

template <int RG> HD void dot_rows(const bf16_t* A, long lda, const float* W, long ldw, int K, const float* gk, float (&acc)[RG]) {
#pragma unroll
    for (int r = 0; r < RG; ++r) acc[r] = 0.f;
    for (int k = 0; k < K; k += 8) {
        float w[8];
#pragma unroll
        for (int j = 0; j < 8; ++j) w[j] = W[(long)(k + j) * ldw] * (gk ? gk[k + j] : 1.f);
#pragma unroll
        for (int r = 0; r < RG; ++r) { const U4 a = *(const U4*)(A + r * lda + k); acc[r] += dot8(a, w); }
    }
}
constexpr int RG = 8;

HD void nv_prologue(const P& p, long gtid, long gn) {
    bf16_t* xb = WSP(bf16_t, OFF_XB);
    for (long i = gtid; i < (long)M * D; i += gn) xb[i] = f2bf(p.x[i]);
    bf16_t* kcr = WSP(bf16_t, OFF_KCR); bf16_t* vcr = WSP(bf16_t, OFF_VCR);
    for (long i = gtid; i < 2048; i += gn) { kcr[(long)M * 64 + i] = 0; vcr[(long)M * 64 + i] = 0; }
}

HD void store_z(const P& p, long row, int col, float v) {
    if (col < ZC_CKV) WSP(bf16_t, OFF_CQ)[row * 384 + col] = f2bf(v);
    else if (col < ZC_KR) WSP(bf16_t, OFF_CKV)[row * 256 + (col - ZC_CKV)] = f2bf(v);
    else if (col < ZC_FOX) {   }
    else if (col < ZC_FF) { const int c = col - ZC_FOX, which = c / 384, hd = c % 384;
        if (which == 0) WSP(bf16_t, OFF_FQ)[row * 384 + hd] = f2bf(v * HD_QS);
        else if (which == 1) WSP(bf16_t, OFF_FK)[row * 384 + hd] = f2bf(v);
        else WSP(bf16_t, OFF_FV)[row * 384 + hd] = f2bf(v); }
    else if (col < ZC_NQ) WSP(float, OFF_FL)[row * 8 + (col - ZC_FF)] = v;
    else if (col < ZC_KC) WSP(bf16_t, OFF_NQ)[row * 256 + (col - ZC_NQ)] = f2bf(v * HD_QS);
    else if (col < ZC_VC) WSP(bf16_t, OFF_KCR)[row * 64 + (col - ZC_KC)] = f2bf(v);
    else if (col < ZC_KS) WSP(bf16_t, OFF_VCR)[row * 64 + (col - ZC_VC)] = f2bf(v);
    else if (col < ZC_VS) WSP(bf16_t, OFF_KS)[row * 64 + (col - ZC_KS)] = f2bf(v);
    else if (col < ZC_KW) WSP(bf16_t, OFF_VS)[row * 64 + (col - ZC_VS)] = f2bf(v);
    else if (col < ZC_VW) WSP(bf16_t, OFF_KW)[row * 64 + (col - ZC_KW)] = f2bf(v);
    else if (col < ZC_NG) WSP(bf16_t, OFF_VW)[row * 64 + (col - ZC_VW)] = f2bf(v);
    else WSP(float, OFF_NG)[row * 16 + (col - ZC_NG)] = v;
}

HD void nv_inproj(const P& p, int layer, long gtid, long gn) {
    const bf16_t* xb = WSP(bf16_t, OFF_XB); const float* w = p.w_in + (size_t)layer * D * IN_COLS;
    for (long it = gtid; it < (long)(M / RG) * IN_COLS; it += gn) {
        const long rg = it / IN_COLS; const int col = (int)(it % IN_COLS); const long r0 = rg * RG;
        if (col >= ZC_KR + 16 && col < ZC_FOX) continue;
        float acc[RG]; dot_rows<RG>(xb + r0 * D, D, w + col, IN_COLS, D, nullptr, acc);
        if (col >= ZC_KR && col < ZC_KR + 16) {
            float acc2[RG]; dot_rows<RG>(xb + r0 * D, D, w + col + 16, IN_COLS, D, nullptr, acc2);
            const int i = col - ZC_KR;
#pragma unroll
            for (int r = 0; r < RG; ++r) { const long row = r0 + r; float c, s; rope_cs((int)(row % S), i, c, s);
                const bf16_t o1 = f2bf(acc[r] * c - acc2[r] * s), o2 = f2bf(acc2[r] * c + acc[r] * s);
                bf16_t* km = WSP(bf16_t, OFF_KM) + row * 576;
                for (int h = 0; h < 6; ++h) { km[h * 96 + 64 + i] = o1; km[h * 96 + 80 + i] = o2; } }
        } else {
#pragma unroll
            for (int r = 0; r < RG; ++r) store_z(p, r0 + r, col, acc[r]);
        }
    }
}

HD void nv_post1(const P& p, int layer, long gtid, long gn) {
    for (long row = gtid; row < M; row += gn) {
        const bf16_t* cq = WSP(bf16_t, OFF_CQ) + row * 384; const bf16_t* ckv = WSP(bf16_t, OFF_CKV) + row * 256;
        float s1 = 0.f, s2 = 0.f;
        for (int k = 0; k < 384; ++k) { const float v = bf2f(cq[k]); s1 += v * v; }
        for (int k = 0; k < 256; ++k) { const float v = bf2f(ckv[k]); s2 += v * v; }
        WSP(float, OFF_RQ)[row] = 1.0f / sqrtf(s1 / 384.f + EPS); WSP(float, OFF_RKV)[row] = 1.0f / sqrtf(s2 / 256.f + EPS);
    }
    for (long it = gtid; it < NB * 6; it += gn) {
        const int b = (int)(it / 6), h = (int)(it % 6); const float bias = p.b_forget[layer * 6 + h];
        const float* fl = WSP(float, OFF_FL) + (long)b * S * 8 + h; float* fc = WSP(float, OFF_FC) + ((long)b * 6 + h) * S;
        float c = 0.f;
        for (int t = 0; t < S; ++t) { const float xv = fl[(long)t * 8] + bias;
            const float ls = fminf(xv, 0.f) - log1pf(expf(-fabsf(xv)));
            c += ls; fc[t] = c * LOG2E; }
    }
}

HD void nv_qup(const P& p, int layer, long gtid, long gn) {
    { const bf16_t* cq = WSP(bf16_t, OFF_CQ); const float* w = p.w_uq + (size_t)layer * 384 * 576; const float* g = p.g_cq + layer * 384; const float* rq = WSP(float, OFF_RQ);
      bf16_t* qm = WSP(bf16_t, OFF_QM);
      for (long it = gtid; it < (long)(M / RG) * 480; it += gn) {
          const long rg = it / 480; const int j = (int)(it % 480), h = j / 80, c = j % 80; const long r0 = rg * RG;
          if (c < 64) { float acc[RG]; dot_rows<RG>(cq + r0 * 384, 384, w + h * 96 + c, 576, 384, g, acc);
#pragma unroll
              for (int r = 0; r < RG; ++r) qm[(r0 + r) * 576 + h * 96 + c] = f2bf(acc[r] * rq[r0 + r] * MLA_QS);
          } else { const int i = c - 64; float a1[RG], a2[RG];
              dot_rows<RG>(cq + r0 * 384, 384, w + h * 96 + 64 + i, 576, 384, g, a1); dot_rows<RG>(cq + r0 * 384, 384, w + h * 96 + 80 + i, 576, 384, g, a2);
#pragma unroll
              for (int r = 0; r < RG; ++r) { const long row = r0 + r; float cs, sn; rope_cs((int)(row % S), i, cs, sn); const float x1 = a1[r] * rq[row], x2 = a2[r] * rq[row];
                  qm[row * 576 + h * 96 + 64 + i] = f2bf((x1 * cs - x2 * sn) * MLA_QS); qm[row * 576 + h * 96 + 80 + i] = f2bf((x2 * cs + x1 * sn) * MLA_QS); } }
      } }
}
HD void nv_kvup(const P& p, int layer, long gtid, long gn) {
    { const bf16_t* ckv = WSP(bf16_t, OFF_CKV); const float* w = p.w_ukv + (size_t)layer * 256 * 768; const float* g = p.g_ckv + layer * 256; const float* rkv = WSP(float, OFF_RKV);
      for (long it = gtid; it < (long)(M / RG) * 768; it += gn) {
          const long rg = it / 768; const int col = (int)(it % 768), h = col / 128, c = col % 128; const long r0 = rg * RG;
          float acc[RG]; dot_rows<RG>(ckv + r0 * 256, 256, w + col, 768, 256, g, acc);
#pragma unroll
          for (int r = 0; r < RG; ++r) { const float v = acc[r] * rkv[r0 + r];
              if (c < 64) WSP(bf16_t, OFF_KM)[(r0 + r) * 576 + h * 96 + c] = f2bf(v); else WSP(bf16_t, OFF_VM)[(r0 + r) * 384 + h * 64 + (c - 64)] = f2bf(v); }
      } }
}
HD void nv_cmp1(const P& p, int layer, long gtid, long gn) {
    for (long it = gtid; it < (long)2 * NB * CMPP * 128; it += gn) {
        const int j = (int)(it % 128); const long t2 = it / 128; const int n = (int)(t2 % CMPP); const long t3 = t2 / CMPP; const int b = (int)(t3 % NB), wch = (int)(t3 / NB);
        float* hid = WSP(float, OFF_HID);
        if (n >= NCMP) { hid[it] = 0.f; continue; }
        const bf16_t* T = WSP(bf16_t, wch ? OFF_VCR : OFF_KCR) + ((long)b * S + 16 * n) * 64;
        const float* pe = (wch ? p.cvp : p.ckp) + (size_t)layer * 2048; const float* w1 = (wch ? p.cvw1 : p.ckw1) + (size_t)layer * 2048 * 128 + j;
        float acc = 0.f;
        for (int k = 0; k < 2048; ++k) acc += (bf2f(T[k]) + pe[k]) * w1[(long)k * 128];
        hid[it] = siluf_(acc);
    }
}

HD void nv_cmp2(const P& p, int layer, long gtid, long gn) {
    for (long it = gtid; it < (long)2 * NB * CMPP * 64; it += gn) {
        const int d = (int)(it % 64); const long t2 = it / 64; const int n = (int)(t2 % CMPP); const long t3 = t2 / CMPP; const int b = (int)(t3 % NB), wch = (int)(t3 / NB);
        const float* hid = WSP(float, OFF_HID) + (((long)wch * NB + b) * CMPP + n) * 128; const float* w2 = (wch ? p.cvw2 : p.ckw2) + (size_t)layer * 128 * 64 + d;
        float acc = 0.f;
        for (int j = 0; j < 128; ++j) acc += hid[j] * w2[j * 64];
        WSP(bf16_t, wch ? OFF_VCC : OFF_KCC)[((long)b * CMPP + n) * 64 + d] = f2bf(acc);
    }
}

HD float slope2(int h) { return LOG2E * (h == 0 ? 0.25f : h == 1 ? 0.0625f : h == 2 ? 0.015625f : 0.00390625f); }

template <int DK> HD float qk_dot(const float (&q)[DK], const bf16_t* k) {
    float s = 0.f;
#pragma unroll
    for (int d = 0; d < DK; d += 8) { const U4 a = *(const U4*)(k + d); s += dot8(a, &q[d]); }
    return s;
}
template <int DK> HD void load_q(float (&q)[DK], const bf16_t* src) {
#pragma unroll
    for (int d = 0; d < DK; d += 8) { const U4 a = *(const U4*)(src + d); unpack8(a, &q[d]); }
}
HD void sm_step(float sc, const bf16_t* v, float& m, float& l, float (&o)[64]) {
    if (sc > m) { const float f = exp2f(m - sc); l *= f;
#pragma unroll
        for (int d = 0; d < 64; ++d) o[d] *= f;
        m = sc; }
    const float pp = exp2f(sc - m); l += pp;
#pragma unroll
    for (int d = 0; d < 64; d += 8) { const U4 a = *(const U4*)(v + d); float vv[8]; unpack8(a, vv);
#pragma unroll
        for (int j = 0; j < 8; ++j) o[d + j] += pp * vv[j]; }
}

HD void nv_nsa_a(const P& p, long gtid, long gn) {
    for (long it = gtid; it < (long)M * 4; it += gn) {
        const int t = (int)(it % S); const long t2 = it / S; const int h = (int)(t2 % 4), b = (int)(t2 / 4); const long row = (long)b * S + t;
        float q[64]; load_q<64>(q, WSP(bf16_t, OFF_NQ) + row * 256 + h * 64);
        const int nmax = t >= 31 ? ((t - 31) / 16 < NCMP - 1 ? (t - 31) / 16 : NCMP - 1) : -1; const float sl = slope2(h);
        float m = -INFINITY, l = 0.f;
        for (int n = 0; n <= nmax; ++n) { const float sc = qk_dot<64>(q, WSP(bf16_t, OFF_KCC) + ((long)b * CMPP + n) * 64) - sl * (float)(t - (16 * n + 31));
            if (sc > m) { l *= exp2f(m - sc); m = sc; } l += exp2f(sc - m); }
        float* cst = WSP(float, OFF_CST) + (row * 4 + h) * 2; cst[0] = nmax >= 0 ? m : 0.f; cst[1] = l;
    }
}
HD void nv_nsa_b(const P& p, long gtid, long gn) {
    for (long it = gtid; it < (long)M * NBLK; it += gn) {
        const int j = (int)(it % NBLK); const long row = it / NBLK; const int t = (int)(row % S), b = (int)(row / S), cur = t / 64;
        float imp;
        if (j == 0 || j == cur || j == cur - 1) imp = 1.0e4f;
        else if (64 * j > t) imp = -1.0f;
        else { imp = 0.f;
            for (int h = 0; h < 4; ++h) { float q[64]; load_q<64>(q, WSP(bf16_t, OFF_NQ) + row * 256 + h * 64); const float* cst = WSP(float, OFF_CST) + (row * 4 + h) * 2; const float m = cst[0], l = cst[1], sl = slope2(h);
                float sum = 0.f;
                for (int n = 4 * j - 1; n <= 4 * j + 3; ++n) { if (n < 0 || n >= NCMP || 16 * n + 31 > t) continue;
                    const float sc = qk_dot<64>(q, WSP(bf16_t, OFF_KCC) + ((long)b * CMPP + n) * 64) - sl * (float)(t - (16 * n + 31)); sum += exp2f(sc - m); }
                imp += sum / fmaxf(l, 1e-30f); } }
        WSP(float, OFF_IMP)[row * 32 + j] = imp;
    }
}
HD void nv_nsa_c(const P& p, long gtid, long gn) {
    for (long row = gtid; row < M; row += gn) {
        const float* imp = WSP(float, OFF_IMP) + row * 32; uint32_t mask = 0;
        for (int j = 0; j < NBLK; ++j) { const float v = imp[j]; int rank = 0;
            for (int k = 0; k < NBLK; ++k) { const float u = imp[k]; rank += (u > v || (u == v && k < j)) ? 1 : 0; }
            if (rank < 8) mask |= 1u << j; }
        WSP(uint32_t, OFF_SEL)[row] = mask;
    }
}

HD void nv_attn(const P& p, long gtid, long gn) {
    for (long it = gtid; it < (long)M * 6; it += gn) {
        const int t = (int)(it % S); const long t2 = it / S; const int h = (int)(t2 % 6), b = (int)(t2 / 6); const long row = (long)b * S + t;
        float q[96]; load_q<96>(q, WSP(bf16_t, OFF_QM) + row * 576 + h * 96);
        float o[64]; float m = -INFINITY, l = 0.f;
#pragma unroll
        for (int d = 0; d < 64; ++d) o[d] = 0.f;
        for (int s = 0; s <= t; ++s) { const long sr = (long)b * S + s; const float sc = qk_dot<96>(q, WSP(bf16_t, OFF_KM) + sr * 576 + h * 96); sm_step(sc, WSP(bf16_t, OFF_VM) + sr * 384 + h * 64, m, l, o); }
        const float il = 1.0f / l; bf16_t* dst = WSP(bf16_t, OFF_MIX) + row * MIXW + h * 64;
#pragma unroll
        for (int d = 0; d < 64; ++d) dst[d] = f2bf(o[d] * il);
    }
    for (long it = gtid; it < (long)M * 6; it += gn) {
        const int t = (int)(it % S); const long t2 = it / S; const int h = (int)(t2 % 6), b = (int)(t2 / 6); const long row = (long)b * S + t;
        float q[64]; load_q<64>(q, WSP(bf16_t, OFF_FQ) + row * 384 + h * 64);
        const float* fc = WSP(float, OFF_FC) + ((long)b * 6 + h) * S; const float ct = fc[t];
        float o[64]; float m = -INFINITY, l = 0.f;
#pragma unroll
        for (int d = 0; d < 64; ++d) o[d] = 0.f;
        for (int s = 0; s <= t; ++s) { const long sr = (long)b * S + s; const float sc = qk_dot<64>(q, WSP(bf16_t, OFF_FK) + sr * 384 + h * 64) + (ct - fc[s]); sm_step(sc, WSP(bf16_t, OFF_FV) + sr * 384 + h * 64, m, l, o); }
        const float il = 1.0f / l; bf16_t* dst = WSP(bf16_t, OFF_MIX) + row * MIXW + 384 + h * 64;
#pragma unroll
        for (int d = 0; d < 64; ++d) dst[d] = f2bf(o[d] * il);
    }
    for (long it = gtid; it < (long)M * 4; it += gn) {
        const int t = (int)(it % S); const long t2 = it / S; const int h = (int)(t2 % 4), b = (int)(t2 / 4); const long row = (long)b * S + t; const float sl = slope2(h);
        float q[64]; load_q<64>(q, WSP(bf16_t, OFF_NQ) + row * 256 + h * 64);
        const float* ng = WSP(float, OFF_NG) + row * 16 + h * 3;
        float out[64], o[64];
#pragma unroll
        for (int d = 0; d < 64; ++d) out[d] = 0.f;
        {
            const int nmax = t >= 31 ? ((t - 31) / 16 < NCMP - 1 ? (t - 31) / 16 : NCMP - 1) : -1;
            if (nmax >= 0) { float m = -INFINITY, l = 0.f;
#pragma unroll
                for (int d = 0; d < 64; ++d) o[d] = 0.f;
                for (int n = 0; n <= nmax; ++n) { const long cr = ((long)b * CMPP + n) * 64; const float sc = qk_dot<64>(q, WSP(bf16_t, OFF_KCC) + cr) - sl * (float)(t - (16 * n + 31)); sm_step(sc, WSP(bf16_t, OFF_VCC) + cr, m, l, o); }
                const float g = sigmoidf_(ng[0]) / l;
#pragma unroll
                for (int d = 0; d < 64; ++d) out[d] += g * o[d]; } }
        {
            const uint32_t mask = WSP(uint32_t, OFF_SEL)[row]; float m = -INFINITY, l = 0.f;
#pragma unroll
            for (int d = 0; d < 64; ++d) o[d] = 0.f;
            for (int j = 0; j <= t / 64; ++j) { if (!((mask >> j) & 1u)) continue;
                const int s1 = (64 * j + 63 < t) ? 64 * j + 63 : t;
                for (int s = 64 * j; s <= s1; ++s) { const long sr = ((long)b * S + s) * 64; const float sc = qk_dot<64>(q, WSP(bf16_t, OFF_KS) + sr) - sl * (float)(t - s); sm_step(sc, WSP(bf16_t, OFF_VS) + sr, m, l, o); } }
            const float g = sigmoidf_(ng[1]) / l;
#pragma unroll
            for (int d = 0; d < 64; ++d) out[d] += g * o[d]; }
        {
            float m = -INFINITY, l = 0.f;
#pragma unroll
            for (int d = 0; d < 64; ++d) o[d] = 0.f;
            for (int s = (t >= 255 ? t - 255 : 0); s <= t; ++s) { const long sr = ((long)b * S + s) * 64; const float sc = qk_dot<64>(q, WSP(bf16_t, OFF_KW) + sr) - sl * (float)(t - s); sm_step(sc, WSP(bf16_t, OFF_VW) + sr, m, l, o); }
            const float g = sigmoidf_(ng[2]) / l;
#pragma unroll
            for (int d = 0; d < 64; ++d) out[d] += g * o[d]; }
        bf16_t* dst = WSP(bf16_t, OFF_MIX) + row * MIXW + 768 + h * 64;
#pragma unroll
        for (int d = 0; d < 64; ++d) dst[d] = f2bf(out[d]);
    }
}

HD void nv_wout(const P& p, int layer, long gtid, long gn) {
    const bf16_t* mix = WSP(bf16_t, OFF_MIX); const float* w = p.w_out + (size_t)layer * MIXW * D; const float* base = layer == 0 ? p.x : p.out;
    for (long it = gtid; it < (long)(M / RG) * D; it += gn) {
        const long rg = it / D; const int col = (int)(it % D); const long r0 = rg * RG;
        float acc[RG]; dot_rows<RG>(mix + r0 * MIXW, MIXW, w + col, D, MIXW, nullptr, acc);
#pragma unroll
        for (int r = 0; r < RG; ++r) p.out[(r0 + r) * D + col] = ALPHA * base[(r0 + r) * D + col] + acc[r];
    }
}

HD void nv_ln(const P& p, const float* g, const float* bta, const float* rw, long gtid, long gn) {
    for (long row = gtid; row < M; row += gn) {
        float* xr = p.out + row * D; bf16_t* xb = WSP(bf16_t, OFF_XB) + row * D;
        float s = 0.f; for (int k = 0; k < D; ++k) s += xr[k];
        const float mu = s / D; float q = 0.f; for (int k = 0; k < D; ++k) { const float d = xr[k] - mu; q += d * d; }
        const float rs = 1.0f / sqrtf(q / D + EPS);
        float lg[NE];
#pragma unroll
        for (int e = 0; e < NE; ++e) lg[e] = 0.f;
        for (int k = 0; k < D; ++k) { const float v = (xr[k] - mu) * rs * g[k] + bta[k]; xr[k] = v; xb[k] = f2bf(v);
            if (rw) {
#pragma unroll
                for (int e = 0; e < NE; ++e) lg[e] += v * rw[k * NE + e]; } }
        if (rw) { float mx = lg[0];
#pragma unroll
            for (int e = 1; e < NE; ++e) mx = fmaxf(mx, lg[e]);
            float pr[NE]; float sum = 0.f;
#pragma unroll
            for (int e = 0; e < NE; ++e) { pr[e] = expf(lg[e] - mx); sum += pr[e]; }
            int i1 = 0; float p1 = pr[0] / sum;
#pragma unroll
            for (int e = 1; e < NE; ++e) { const float pe = pr[e] / sum; if (pe > p1) { p1 = pe; i1 = e; } }
            int i2 = -1; float p2 = -1.f;
#pragma unroll
            for (int e = 0; e < NE; ++e) { const float pe = pr[e] / sum; if (e != i1 && pe > p2) { p2 = pe; i2 = e; } }
            WSP(int, OFF_EIDX)[row * 2] = i1; WSP(int, OFF_EIDX)[row * 2 + 1] = i2;
            WSP(float, OFF_EGATE)[row * 2] = p1 / (p1 + p2); WSP(float, OFF_EGATE)[row * 2 + 1] = p2 / (p1 + p2); }
    }
}

HD void nv_ffn_up(const P& p, long gtid, long gn) {
    const bf16_t* xb = WSP(bf16_t, OFF_XB); bf16_t* hb = WSP(bf16_t, OFF_H);
    for (long it = gtid; it < (long)(M / RG) * DFF; it += gn) {
        const long rg = it / DFF; const int j = (int)(it % DFF); const long r0 = rg * RG;
        float a[RG], c[RG]; dot_rows<RG>(xb + r0 * D, D, p.fw1 + j, DFF, D, nullptr, a); dot_rows<RG>(xb + r0 * D, D, p.fw3 + j, DFF, D, nullptr, c);
#pragma unroll
        for (int r = 0; r < RG; ++r) hb[(r0 + r) * DFF + j] = f2bf(siluf_(a[r]) * c[r]);
    }
}
HD void nv_ffn_down(const P& p, long gtid, long gn) {
    const bf16_t* hb = WSP(bf16_t, OFF_H);
    for (long it = gtid; it < (long)(M / RG) * D; it += gn) {
        const long rg = it / D; const int col = (int)(it % D); const long r0 = rg * RG;
        float acc[RG]; dot_rows<RG>(hb + r0 * DFF, DFF, p.fw2 + col, D, DFF, nullptr, acc);
#pragma unroll
        for (int r = 0; r < RG; ++r) p.out[(r0 + r) * D + col] = ALPHA * p.out[(r0 + r) * D + col] + acc[r];
    }
}
HD void nv_moe_up(const P& p, long gtid, long gn) {
    const bf16_t* xb = WSP(bf16_t, OFF_XB); bf16_t* h2 = WSP(bf16_t, OFF_H2);
    for (long it = gtid; it < (long)M * 2 * DFE; it += gn) {
        const int j = (int)(it % DFE); const long rs = it / DFE; const long row = rs / 2; const int e = WSP(int, OFF_EIDX)[rs];
        float a[1], c[1]; dot_rows<1>(xb + row * D, D, p.mw1 + (size_t)e * D * DFE + j, DFE, D, nullptr, a); dot_rows<1>(xb + row * D, D, p.mw3 + (size_t)e * D * DFE + j, DFE, D, nullptr, c);
        h2[rs * DFE + j] = f2bf(siluf_(a[0]) * c[0]);
    }
}
HD void nv_moe_down(const P& p, long gtid, long gn) {
    const bf16_t* h2 = WSP(bf16_t, OFF_H2);
    for (long it = gtid; it < (long)M * D; it += gn) {
        const int col = (int)(it % D); const long row = it / D; float tot = 0.f;
        for (int sl = 0; sl < 2; ++sl) { const int e = WSP(int, OFF_EIDX)[row * 2 + sl]; float acc[1];
            dot_rows<1>(h2 + (row * 2 + sl) * DFE, DFE, p.mw2 + (size_t)e * DFE * D + col, D, DFE, nullptr, acc); tot += WSP(float, OFF_EGATE)[row * 2 + sl] * acc[0]; }
        p.out[it] = ALPHA * p.out[it] + tot;
    }
}

constexpr int N_LAYER_PHASES = 13;
HD void run_phase(const P& p, int ph, int layer, long gtid, long gn) {
    switch (ph) {
        case 0: nv_prologue(p, gtid, gn); break;
        case 1: nv_inproj(p, layer, gtid, gn); break;
        case 2: nv_post1(p, layer, gtid, gn); break;
        case 3: nv_qup(p, layer, gtid, gn); nv_kvup(p, layer, gtid, gn); nv_cmp1(p, layer, gtid, gn); break;
        case 14: nv_cmp1(p, layer, gtid, gn); break;
        case 4: nv_cmp2(p, layer, gtid, gn); break;
        case 5: nv_nsa_a(p, gtid, gn); break;
        case 6: nv_nsa_b(p, gtid, gn); break;
        case 7: nv_nsa_c(p, gtid, gn); break;
        case 8: nv_attn(p, gtid, gn); break;
        case 9: nv_wout(p, layer, gtid, gn); break;
        case 10: nv_ln(p, p.ln1g + layer * D, p.ln1b + layer * D, (layer & 1) ? p.rw : nullptr, gtid, gn); break;
        case 11: if (layer & 1) nv_moe_up(p, gtid, gn); else nv_ffn_up(p, gtid, gn); break;
        case 12: if (layer & 1) nv_moe_down(p, gtid, gn); else nv_ffn_down(p, gtid, gn); break;
        case 13: nv_ln(p, p.ln2g + layer * D, p.ln2b + layer * D, nullptr, gtid, gn); break;
    }
}

#ifndef HOST_TEST
#define XB_TMO      128
#define XB_XCNT(j)  (256  + 64 * (j))
#define XB_XSUB(j)  (1280 + 64 * (j))
#define XB_XGEN(j)  (2304 + 64 * (j))
#define XB_TOP      3328
#define XB_TOPGEN   3392
#define XCD_BAR_WORDS 3456
#define XB_SPIN_CAP (1u << 24)
#define LAS __attribute__((address_space(3)))

__device__ __forceinline__ unsigned xb_ld(unsigned* p)              { return __hip_atomic_load(p, __ATOMIC_RELAXED, __HIP_MEMORY_SCOPE_AGENT); }
__device__ __forceinline__ unsigned xb_add(unsigned* p, unsigned v) { return __hip_atomic_fetch_add(p, v, __ATOMIC_RELAXED, __HIP_MEMORY_SCOPE_AGENT); }
__device__ __forceinline__ unsigned xb_xcc_id() { return (unsigned)__builtin_amdgcn_s_getreg((3 << 11) | 20) & 0xFu; }
#define XB_SPIN(cond, bar) do { unsigned _sp = 0; while (cond) { __builtin_amdgcn_s_sleep(1); \
    if ((++_sp & 255u) == 0u) { if (xb_ld(&(bar)[XB_TMO])) break; if (_sp > XB_SPIN_CAP) { atomicAdd(&(bar)[XB_TMO], 1u); break; } } } } while (0)

struct XcdBarrier {
    unsigned* bar; unsigned x;
    volatile LAS unsigned* st;
};
__device__ __forceinline__ XcdBarrier xcd_barrier_post(unsigned* bar, volatile LAS unsigned* st) {
    XcdBarrier b; b.bar = bar; b.x = xb_xcc_id(); b.st = st;
    if (threadIdx.x == 0) (void)xb_add(&bar[XB_XCNT(b.x)], 1u);
    return b;
}
__device__ __forceinline__ void xcd_barrier_complete(unsigned* bar, unsigned x, unsigned& nloc, unsigned& nx) {
    const unsigned G = gridDim.x * gridDim.y * gridDim.z;
    unsigned sum, cnt, mine, sp = 0u;
    for (;;) {
        sum = 0u; cnt = 0u; mine = 0u;
#pragma unroll
        for (unsigned j = 0; j < 16; ++j) { const unsigned c = xb_ld(&bar[XB_XCNT(j)]); sum += c; cnt += (c > 0u) ? 1u : 0u; mine = (j == x) ? c : mine; }
        if (sum == G) break;
        __builtin_amdgcn_s_sleep(1);
        if ((++sp & 255u) == 0u) { if (xb_ld(&bar[XB_TMO])) break; if (sp > XB_SPIN_CAP) { atomicAdd(&bar[XB_TMO], 1u); break; } }
    }
    nloc = mine > 0u ? mine : 1u; nx = cnt > 0u ? cnt : 1u;
}
__device__ __forceinline__ void xcd_barrier(const XcdBarrier& b) {
    asm volatile("s_waitcnt vmcnt(0)" ::: "memory");
    __syncthreads();
    if (threadIdx.x == 0) {
        unsigned* bar = b.bar;
        __builtin_amdgcn_s_waitcnt(0);
        unsigned nloc = b.st[0], nx = b.st[1];
        if (nloc == 0u) { xcd_barrier_complete(bar, b.x, nloc, nx); b.st[0] = nloc; b.st[1] = nx; }
        const unsigned old = xb_add(&bar[XB_XSUB(b.x)], 1u);
        const unsigned gen = old / nloc;
        if (old + 1u == (gen + 1u) * nloc) {
            __builtin_amdgcn_fence(__ATOMIC_RELEASE, "agent");
            asm volatile("s_waitcnt vmcnt(0)" ::: "memory");
            const unsigned og = xb_add(&bar[XB_TOP], 1u);
            const unsigned tg = og / nx;
            if (og + 1u == (tg + 1u) * nx) xb_add(&bar[XB_TOPGEN], 1u);
            else XB_SPIN(xb_ld(&bar[XB_TOPGEN]) == tg, bar);
            __builtin_amdgcn_fence(__ATOMIC_ACQUIRE, "agent");
            xb_add(&bar[XB_XGEN(b.x)], 1u);
            asm volatile("s_waitcnt vmcnt(0)" ::: "memory");
        } else {
            XB_SPIN(xb_ld(&bar[XB_XGEN(b.x)]) == gen, bar);
            __builtin_amdgcn_fence(__ATOMIC_ACQUIRE, "agent");
            asm volatile("s_waitcnt vmcnt(0)" ::: "memory");
        }
    }
    __syncthreads();
}


namespace pg8 {
#define PG8_LAS __attribute__((address_space(3)))
typedef unsigned short bf16_t;
typedef short bf16x8 __attribute__((ext_vector_type(8)));
typedef float f32x4 __attribute__((ext_vector_type(4)));
typedef unsigned u32x4 __attribute__((ext_vector_type(4)));
constexpr int BM = 256, BK = 64, HALF = 128, HTB = HALF * BK * 2  , STAGE_BYTES = 8 * HTB, NXCD = 8, WGM = 8;

__host__ __device__ __forceinline__ int lds_byte(int r, int c) { const int st = (r >> 4) * 2 + (c >> 5), rr = r & 15, cc = c & 31, ob = rr * 64 + cc * 2; return st * 1024 + (ob ^ (((ob >> 9) & 1) << 5)); }
__host__ __device__ __forceinline__ void stage_rc(int b, int& R, int& C) { const int st = b / 1024, sb = b % 1024, swz = sb ^ (((sb >> 9) & 1) << 5); R = (st >> 1) * 16 + swz / 64; C = (st & 1) * 32 + (swz % 64) / 2; }
__host__ __device__ __forceinline__ int perm32(int rho) { const int n = rho >> 4, i = rho & 15; return 8 * (i >> 2) + 4 * n + (i & 3); }

struct Unit { int pm, pn; };
struct Gemm { const bf16_t* A; const bf16_t* Bt; int M, N, K; };

struct StaticOrder {
    int nM, nN, nwg, G, c;
    __host__ __device__ void init(int M, int N, int G_, int c_) { nM = M / BM; nN = N / BM; nwg = nM * nN; G = G_; c = c_; }
    __host__ __device__ bool next(int i, Unit& u) const {
        const long L = (long)i * G + c; if (L >= nwg) return false;
        int wgid = (int)L; { const int q = nwg / NXCD, r = nwg % NXCD, xcd = wgid % NXCD, off = wgid / NXCD; wgid = (xcd < r ? xcd * (q + 1) : r * (q + 1) + (xcd - r) * q) + off; }
        const int nig = WGM * nN, gid = wgid / nig, fm = gid * WGM, gsz = (nM - fm) < WGM ? (nM - fm) : WGM;
        u.pm = fm + ((wgid % nig) % gsz); u.pn = (wgid % nig) / gsz; return true;
    }
    __device__ __forceinline__ void a_ready(const Unit&) const {}
    __device__ __forceinline__ void done(const Unit&) const {}
};

__device__ __forceinline__ unsigned cvt_pk_bf16(float lo, float hi) { unsigned r; asm volatile("v_cvt_pk_bf16_f32 %0, %1, %2" : "=v"(r) : "v"(lo), "v"(hi)); return r; }
typedef float f32x2 __attribute__((ext_vector_type(2)));
template <class Epi, class Sched, bool ALIGN_EPI = false, bool SP2 = false>
__device__ __forceinline__ void gemm_phase(PG8_LAS unsigned char* lds, const Gemm g, const Sched& S, const Epi& E, const int tid) {
    const int  wid = __builtin_amdgcn_readfirstlane(tid >> 6), lane = tid & 63, wr = wid >> 2, wc = wid & 3, fr = lane & 15, fq = lane >> 4;
    const int K = g.K, nt = K / BK;
    unsigned voffA[2], voffB[2];
#pragma unroll
    for (int i = 0; i < 2; ++i) { int R, C; stage_rc(tid * 16 + i * 8192, R, C); const int Rb = Epi::PERM ? ((R & ~31) + perm32(R & 31)) : R;
        voffA[i] = (unsigned)(R * K + C) * 2u; voffB[i] = (unsigned)(Rb * K + C) * 2u; }
    const size_t kstep = (size_t)(BK * 2);
    const size_t hstep = (size_t)HALF * K * 2;
    const size_t tstep = 2 * hstep;
    const unsigned ldsw = (unsigned)wid * 1024u;
    const int aoff = lds_byte(wr * 64 + fr, fq * 8), boff = lds_byte(wc * 32 + fr, fq * 8);
#define PG8_SA(b, h) (((b) * 2 + (h)) * HTB)
#define PG8_SB(b, h) ((4 + (b) * 2 + (h)) * HTB)
#define PG8_STAGE(bufoff, gbase, voff) do { _Pragma("unroll") for (int _i = 0; _i < 2; ++_i) \
        __builtin_amdgcn_global_load_lds((const unsigned*)((const char*)(gbase) + (voff)[_i]), (PG8_LAS unsigned*)(lds + (bufoff) + ldsw + _i * 8192), 16, 0, 0); } while (0)
#define PG8_LDA(dst, b, h) do { _Pragma("unroll") for (int m = 0; m < 4; ++m) _Pragma("unroll") for (int k = 0; k < 2; ++k) dst[m][k] = *(const PG8_LAS bf16x8*)(lds + PG8_SA(b, h) + aoff + m * 2048 + k * 1024); } while (0)
#define PG8_LDB(dst, b, h) do { _Pragma("unroll") for (int n = 0; n < 2; ++n) _Pragma("unroll") for (int k = 0; k < 2; ++k) dst[n][k] = *(const PG8_LAS bf16x8*)(lds + PG8_SB(b, h) + boff + n * 2048 + k * 1024); } while (0)
#define PG8_MMA(ai, bj, At, Bt) do { __builtin_amdgcn_s_setprio(1); _Pragma("unroll") for (int m = 0; m < 4; ++m) _Pragma("unroll") for (int n = 0; n < 2; ++n) _Pragma("unroll") for (int k = 0; k < 2; ++k) \
        acc[ai][bj][m][n] = __builtin_amdgcn_mfma_f32_16x16x32_bf16(Bt[n][k], At[m][k], acc[ai][bj][m][n], 0, 0, 0); __builtin_amdgcn_s_setprio(0); } while (0)
#define PG8_WAIT_V(n) asm volatile("s_waitcnt vmcnt(" #n ")" ::: "memory")
#define PG8_WAIT_L(n) asm volatile("s_waitcnt lgkmcnt(" #n ")" ::: "memory")
#define PG8_BAR __builtin_amdgcn_s_barrier()
#define PG8_SCHED __builtin_amdgcn_sched_barrier(0)
    Unit cur, nxt; int ui = 0;
    if (!S.next(0, cur)) return;
    f32x4 acc[2][2][4][2];
#pragma unroll
    for (int a = 0; a < 2; ++a)
#pragma unroll
        for (int b = 0; b < 2; ++b)
#pragma unroll
            for (int m = 0; m < 4; ++m)
#pragma unroll
                for (int n = 0; n < 2; ++n) acc[a][b][m][n] = (f32x4){0.f, 0.f, 0.f, 0.f};
    bf16x8 At[4][2], B0[2][2], B1[2][2];
    const char* cA = (const char*)g.A + (size_t)cur.pm * tstep; const char* cB = (const char*)g.Bt + (size_t)cur.pn * tstep;
    S.a_ready(cur);
    if constexpr (SP2) {
        PG8_STAGE(PG8_SB(0, 0), cB, voffB); PG8_STAGE(PG8_SB(0, 1), cB + hstep, voffB); PG8_STAGE(PG8_SA(0, 0), cA, voffA); PG8_STAGE(PG8_SA(0, 1), cA + hstep, voffA);
        if (wr == 1) PG8_BAR;
        PG8_WAIT_V(2); PG8_BAR;
        PG8_STAGE(PG8_SB(1, 0), cB + kstep, voffB); PG8_STAGE(PG8_SA(1, 0), cA + kstep, voffA); PG8_STAGE(PG8_SB(1, 1), cB + hstep + kstep, voffB);
        PG8_WAIT_V(6); PG8_BAR;
    } else {
        PG8_STAGE(PG8_SB(0, 0), cB, voffB); PG8_STAGE(PG8_SA(0, 0), cA, voffA); PG8_STAGE(PG8_SB(0, 1), cB + hstep, voffB); PG8_STAGE(PG8_SA(0, 1), cA + hstep, voffA);
        if (wr == 1) PG8_BAR;
        PG8_WAIT_V(4); PG8_BAR;
        PG8_STAGE(PG8_SB(1, 0), cB + kstep, voffB); PG8_STAGE(PG8_SA(1, 0), cA + kstep, voffA); PG8_STAGE(PG8_SB(1, 1), cB + hstep + kstep, voffB);
        PG8_WAIT_V(6); PG8_BAR;
    }
    for (;;) {
        const bool has_next = S.next(ui + 1, nxt);
        const char* nA = has_next ? (const char*)g.A + (size_t)nxt.pm * tstep : cA; const char* nB = has_next ? (const char*)g.Bt + (size_t)nxt.pn * tstep : cB;
#pragma nounroll
        for (int t = 0; t < nt; t += 2) {
            const bool last = (t == nt - 2);
            const char* a1 = cA + (size_t)(t + 1) * kstep;
            const char* a2 = last ? nA : cA + (size_t)(t + 2) * kstep; const char* b2 = last ? nB : cB + (size_t)(t + 2) * kstep;
            const char* a3 = a2 + kstep; const char* b3 = b2 + kstep;
            if (last && has_next) S.a_ready(nxt);
            if constexpr (SP2) {
            PG8_LDB(B0, 0, 0); PG8_LDB(B1, 0, 1); PG8_SCHED; PG8_LDA(At, 0, 0); PG8_STAGE(PG8_SA(1, 1), a1 + hstep, voffA);
            PG8_WAIT_V(8); PG8_WAIT_L(0); PG8_BAR; PG8_MMA(0, 0, At, B0); PG8_MMA(0, 1, At, B1); PG8_BAR; PG8_SCHED;
            PG8_LDA(At, 0, 1); PG8_STAGE(PG8_SB(0, 0), b2, voffB); PG8_STAGE(PG8_SB(0, 1), b2 + hstep, voffB); PG8_STAGE(PG8_SA(0, 0), a2, voffA);
            PG8_WAIT_V(8); PG8_WAIT_L(0); PG8_BAR; PG8_MMA(1, 0, At, B0); PG8_MMA(1, 1, At, B1); PG8_BAR; PG8_SCHED;
            PG8_LDB(B0, 1, 0); PG8_LDB(B1, 1, 1); PG8_SCHED; PG8_LDA(At, 1, 0); PG8_STAGE(PG8_SA(0, 1), a2 + hstep, voffA);
            PG8_WAIT_V(8); PG8_WAIT_L(0); PG8_BAR; PG8_MMA(0, 0, At, B0); PG8_MMA(0, 1, At, B1); PG8_BAR; PG8_SCHED;
            PG8_LDA(At, 1, 1); PG8_STAGE(PG8_SB(1, 0), b3, voffB); PG8_STAGE(PG8_SB(1, 1), b3 + hstep, voffB); PG8_STAGE(PG8_SA(1, 0), a3, voffA);
            PG8_WAIT_V(8); PG8_WAIT_L(0); PG8_BAR; PG8_MMA(1, 0, At, B0); PG8_MMA(1, 1, At, B1); PG8_BAR; PG8_SCHED;
            } else {
            PG8_LDB(B0, 0, 0); PG8_SCHED; PG8_LDA(At, 0, 0); PG8_STAGE(PG8_SA(1, 1), a1 + hstep, voffA);
            PG8_WAIT_L(8); PG8_BAR; PG8_WAIT_L(0); PG8_MMA(0, 0, At, B0); PG8_BAR; PG8_SCHED;
            PG8_LDB(B1, 0, 1); PG8_STAGE(PG8_SB(0, 0), b2, voffB);
            PG8_BAR; PG8_WAIT_L(0); PG8_MMA(0, 1, At, B1); PG8_BAR;
            PG8_LDA(At, 0, 1); PG8_STAGE(PG8_SA(0, 0), a2, voffA);
            PG8_BAR; PG8_WAIT_L(0); PG8_MMA(1, 0, At, B0); PG8_BAR; PG8_SCHED;
            PG8_STAGE(PG8_SB(0, 1), b2 + hstep, voffB);
            PG8_WAIT_V(6); PG8_BAR; PG8_MMA(1, 1, At, B1); PG8_BAR;
            PG8_LDB(B0, 1, 0); PG8_SCHED; PG8_LDA(At, 1, 0); PG8_STAGE(PG8_SA(0, 1), a2 + hstep, voffA);
            PG8_WAIT_L(8); PG8_BAR; PG8_WAIT_L(0); PG8_MMA(0, 0, At, B0); PG8_BAR; PG8_SCHED;
            PG8_LDB(B1, 1, 1); PG8_STAGE(PG8_SB(1, 0), b3, voffB);
            PG8_BAR; PG8_WAIT_L(0); PG8_MMA(0, 1, At, B1); PG8_BAR;
            PG8_LDA(At, 1, 1); PG8_STAGE(PG8_SA(1, 0), a3, voffA);
            PG8_BAR; PG8_WAIT_L(0); PG8_MMA(1, 0, At, B0); PG8_BAR; PG8_SCHED;
            PG8_STAGE(PG8_SB(1, 1), b3 + hstep, voffB);
            PG8_WAIT_V(6); PG8_BAR; PG8_MMA(1, 1, At, B1); PG8_BAR;
            }
        }
        if constexpr (ALIGN_EPI) { if (wr == 0) PG8_BAR; }
        if constexpr (!Epi::AFTER_DRAIN) { E(acc, cur, wr, wc, fr, fq); S.done(cur); }
        if (!has_next) break;
#pragma unroll
        for (int a = 0; a < 2; ++a)
#pragma unroll
            for (int b = 0; b < 2; ++b)
#pragma unroll
                for (int m = 0; m < 4; ++m)
#pragma unroll
                    for (int n = 0; n < 2; ++n) acc[a][b][m][n] = (f32x4){0.f, 0.f, 0.f, 0.f};
        cur = nxt; cA = nA; cB = nB; ++ui;
        if constexpr (ALIGN_EPI) { if (wr == 1) PG8_BAR; }
    }
    PG8_WAIT_V(0);
    if constexpr (!ALIGN_EPI) { if (wr == 0) PG8_BAR; }
    PG8_BAR;
    if constexpr (Epi::AFTER_DRAIN) { E.fused(acc, cur, wr, wc, fr, fq, lds, wid, lane); S.done(cur); }
#undef PG8_SA
#undef PG8_SB
#undef PG8_STAGE
#undef PG8_LDA
#undef PG8_LDB
#undef PG8_MMA
#undef PG8_WAIT_V
#undef PG8_WAIT_L
#undef PG8_BAR
#undef PG8_SCHED
}
}

#define OPT_THREADS 512
constexpr int LDS_BYTES = 147456;
typedef pg8::f32x4 f32x4;
#define GLB __attribute__((address_space(1)))

typedef float f32x2_t __attribute__((ext_vector_type(2))); typedef __bf16 bf16x2_t __attribute__((ext_vector_type(2)));
__device__ __forceinline__ unsigned pk2(float lo, float hi) { f32x2_t v = {lo, hi}; bf16x2_t b = __builtin_convertvector(v, bf16x2_t); return __builtin_bit_cast(unsigned, b); }
__device__ __forceinline__ U4 pack8(const f32x4& a, const f32x4& b) { U4 w; w.x = pk2(a[0], a[1]); w.y = pk2(a[2], a[3]); w.z = pk2(b[0], b[1]); w.w = pk2(b[2], b[3]); return w; }
__device__ __forceinline__ void atomic_addf(float* p, float v) { __hip_atomic_fetch_add(p, v, __ATOMIC_RELAXED, __HIP_MEMORY_SCOPE_AGENT); }

template <int MODE> __device__ __forceinline__ int wsrc_col(int n, int nsrc, int& which) {
    which = 0;
    if (MODE == 0) return n < nsrc ? n : -1;
    if (MODE == 1) { if (n >= 640 && n < 672) { const int c = n - 640; return 640 + ((c >> 2) & 1) * 16 + 4 * (c >> 3) + (c & 3); }
        if (n < 1824) return n; if (n < 2080) return n + 6; if (n < 2464) return n + 6; if (n < 2470) return n - 2464 + 1824; if (n < 2472) return -1; if (n < 2484) return n - 2472 + 2470; return -1; }
    if (MODE == 3) { if (n >= nsrc) return -1; const int h = n / 96, cc = n % 96; if (cc < 64) return n; const int c = cc - 64; return h * 96 + 64 + ((c >> 2) & 1) * 16 + 4 * (c >> 3) + (c & 3); }
    const int t = n >> 8, r = n & 255; which = r >> 7; return t * 128 + (r & 127);
}
template <int MODE> __device__ __forceinline__ void wconv(const float* W, const float* W2, int ldw, int K, int Nd, int nsrc, const float* gk, bf16_t* Bt, LAS float* scr, int gw, int ngw, int rot, int lane) {
    const int nkb = K / 64, nitems = nkb * (Nd / 32);
    for (int it = (gw + rot) % ngw; it < nitems; it += ngw) {
        const int kb = it % nkb, nb = it / nkb, k0 = 64 * kb, n0 = 32 * nb;
        int which; const int sc = wsrc_col<MODE>(n0 + (lane & 31), nsrc, which); const float* Ws = (MODE == 2 && which) ? W2 : W;
#pragma unroll 8
        for (int i = 0; i < 32; ++i) { const int kk = 2 * i + (lane >> 5); float v = 0.f; if (sc >= 0) { v = Ws[(size_t)(k0 + kk) * ldw + sc]; if (gk) v *= gk[k0 + kk]; } scr[kk * 33 + (lane & 31)] = v; }
        asm volatile("s_waitcnt lgkmcnt(0)" ::: "memory");
        const int c = lane & 7;
#pragma unroll
        for (int j = 0; j < 4; ++j) { const int n = (lane >> 3) + 8 * j; const LAS float* s = scr + (8 * c) * 33 + n;
            U4 o; o.x = pk2(s[0 * 33], s[1 * 33]); o.y = pk2(s[2 * 33], s[3 * 33]); o.z = pk2(s[4 * 33], s[5 * 33]); o.w = pk2(s[6 * 33], s[7 * 33]);
            *(U4*)(Bt + (size_t)(n0 + n) * K + k0 + 8 * c) = o; }
        asm volatile("s_waitcnt lgkmcnt(0)" ::: "memory");
    }
}
__device__ __forceinline__ void build_att_list(const P& p, int gw, int ngw, int lane);
__device__ __forceinline__ void op_prologue(const P& p, LAS unsigned char* lds, const int tid) {
    const int lane = tid & 63, wave = tid >> 6, gw = blockIdx.x * 8 + wave, ngw = gridDim.x * 8;
    const long gtid = (long)blockIdx.x * OPT_THREADS + tid, gn = (long)gridDim.x * OPT_THREADS;
    { const f32x4* x4 = (const f32x4*)p.x; U4* xb = WSP(U4, OFF_XB);
      for (long i = gtid; i < (long)M * D / 8; i += gn) { const f32x4 a = x4[2 * i], b = x4[2 * i + 1]; xb[i] = pack8(a, b); } }
    for (long i = gtid; i < 2048; i += gn) { WSP(bf16_t, OFF_KCR)[(long)M * 64 + i] = 0; WSP(bf16_t, OFF_VCR)[(long)M * 64 + i] = 0; }
    for (long i = gtid; i < (long)S * 16; i += gn) { float c, s; rope_cs((int)(i >> 4), (int)(i & 15), c, s); WSP(float, OFF_ROPE)[2 * i] = c; WSP(float, OFF_ROPE)[2 * i + 1] = s; }
    if (blockIdx.x < 8) {
        const int jh = blockIdx.x & 1, wch = (blockIdx.x >> 1) & 1, layer = blockIdx.x >> 2;
        const float* pe = (wch ? p.cvp : p.ckp) + (size_t)layer * 2048 + wave * 256; const float* w1 = (wch ? p.cvw1 : p.ckw1) + (size_t)layer * 2048 * 128 + (size_t)wave * 256 * 128 + jh * 64 + lane;
        float acc = 0.f;
#pragma unroll 8
        for (int k = 0; k < 256; ++k) acc += pe[k] * w1[(size_t)k * 128];
        LAS float* red = (LAS float*)lds; red[wave * 64 + lane] = acc;
        __syncthreads();
        if (tid < 64) { float s = 0.f;
#pragma unroll
            for (int w = 0; w < 8; ++w) s += red[w * 64 + tid];
            WSP(float, OFF_CBIAS)[(layer * 2 + wch) * 128 + jh * 64 + tid] = s; }
        __syncthreads();
    }
    build_att_list(p, gw, ngw, lane);
    LAS float* scr = (LAS float*)(lds + wave * 16384);
    for (int l = 0; l < 2; ++l) {
        wconv<1>(p.w_in + (size_t)l * D * IN_COLS, nullptr, IN_COLS, D, NPAD_IN, IN_COLS, nullptr, WSP(bf16_t, OFF_W_IN) + (size_t)l * NPAD_IN * D, scr, gw, ngw, 0, lane);
        wconv<3>(p.w_uq + (size_t)l * 384 * 576, nullptr, 576, 384, 768, 576, p.g_cq + l * 384, WSP(bf16_t, OFF_W_UQ) + (size_t)l * 768 * 384, scr, gw, ngw, 300, lane);
        wconv<0>(p.w_ukv + (size_t)l * 256 * 768, nullptr, 768, 256, 768, 768, p.g_ckv + l * 256, WSP(bf16_t, OFF_W_UKV) + (size_t)l * 768 * 256, scr, gw, ngw, 600, lane);
        wconv<0>(p.ckw1 + (size_t)l * 2048 * 128, nullptr, 128, 2048, 128, 128, nullptr, WSP(bf16_t, OFF_W_C1) + (size_t)(l * 2 + 0) * 128 * 2048, scr, gw, ngw, 900, lane);
        wconv<0>(p.cvw1 + (size_t)l * 2048 * 128, nullptr, 128, 2048, 128, 128, nullptr, WSP(bf16_t, OFF_W_C1) + (size_t)(l * 2 + 1) * 128 * 2048, scr, gw, ngw, 1000, lane);
        wconv<0>(p.ckw2 + (size_t)l * 128 * 64, nullptr, 64, 128, 64, 64, nullptr, WSP(bf16_t, OFF_W_C2) + (size_t)(l * 2 + 0) * 64 * 128, scr, gw, ngw, 1100, lane);
        wconv<0>(p.cvw2 + (size_t)l * 128 * 64, nullptr, 64, 128, 64, 64, nullptr, WSP(bf16_t, OFF_W_C2) + (size_t)(l * 2 + 1) * 64 * 128, scr, gw, ngw, 1104, lane);
        wconv<0>(p.w_out + (size_t)l * MIXW * D, nullptr, D, MIXW, D, D, nullptr, WSP(bf16_t, OFF_W_OUT) + (size_t)l * D * MIXW, scr, gw, ngw, 1200, lane);
    }
    wconv<2>(p.fw1, p.fw3, DFF, D, 2 * DFF, DFF, nullptr, WSP(bf16_t, OFF_W_F13), scr, gw, ngw, 0, lane);
    wconv<0>(p.fw2, nullptr, D, DFF, D, D, nullptr, WSP(bf16_t, OFF_W_F2), scr, gw, ngw, 400, lane);
    for (int e = 0; e < NE; ++e) {
        wconv<2>(p.mw1 + (size_t)e * D * DFE, p.mw3 + (size_t)e * D * DFE, DFE, D, 2 * DFE, DFE, nullptr, WSP(bf16_t, OFF_W_M13) + (size_t)e * 2 * DFE * D, scr, gw, ngw, e * 200, lane);
        wconv<0>(p.mw2 + (size_t)e * DFE * D, nullptr, D, DFE, D, D, nullptr, WSP(bf16_t, OFF_W_M2) + (size_t)e * D * DFE, scr, gw, ngw, e * 200 + 100, lane);
    }
}

struct EpiInproj {
    static constexpr bool PERM = true, AFTER_DRAIN = false;
    P p; int layer;
    __device__ __forceinline__ void operator()(const f32x4 (&acc)[2][2][4][2], const pg8::Unit& u, int wr, int wc, int fr, int fq) const {
        const int rowb = u.pm * 256 + wr * 64 + fr;
#pragma unroll
        for (int bj = 0; bj < 2; ++bj) {
            const int sb = u.pn * 256 + bj * 128 + wc * 32;
            if (sb >= 2496) continue;
            if (sb == 640) {
                const float* rt = WSP(float, OFF_ROPE);
#pragma unroll
                for (int ai = 0; ai < 2; ++ai)
#pragma unroll
                    for (int m = 0; m < 4; ++m) { const int row = rowb + ai * 128 + m * 16; const int pos = row % S;
                        const f32x4 v0 = acc[ai][bj][m][0], v1 = acc[ai][bj][m][1];
                        const f32x4* cs = (const f32x4*)(rt + (unsigned)(pos * 16 + 4 * fq) * 2u); const f32x4 c01 = cs[0], c23 = cs[1]; f32x4 o0, o1;
                        o0[0] = v0[0] * c01[0] - v1[0] * c01[1]; o0[1] = v0[1] * c01[2] - v1[1] * c01[3]; o0[2] = v0[2] * c23[0] - v1[2] * c23[1]; o0[3] = v0[3] * c23[2] - v1[3] * c23[3];
                        o1[0] = v1[0] * c01[0] + v0[0] * c01[1]; o1[1] = v1[1] * c01[2] + v0[1] * c01[3]; o1[2] = v1[2] * c23[0] + v0[2] * c23[1]; o1[3] = v1[3] * c23[2] + v0[3] * c23[3];
                        const U4 w = pack8(o0, o1); bf16_t* km = WSP(bf16_t, OFF_KM) + (size_t)row * 576 + 64 + 8 * fq;
#pragma unroll
                        for (int h = 0; h < 6; ++h) *(U4*)(km + h * 96) = w; }
            } else if (sb == 2464) {
#pragma unroll
                for (int ai = 0; ai < 2; ++ai)
#pragma unroll
                    for (int m = 0; m < 4; ++m) { const int row = rowb + ai * 128 + m * 16; const f32x4 v0 = acc[ai][bj][m][0], v1 = acc[ai][bj][m][1];
                        if (fq == 0) { f32x4* d = (f32x4*)(WSP(float, OFF_FL) + (size_t)row * 8); d[0] = v0; d[1] = v1; }
                        else if (fq < 3) { f32x4* d = (f32x4*)(WSP(float, OFF_NG) + (size_t)row * 16 + 8 * (fq - 1)); d[0] = v0; d[1] = v1; } }
            } else {
                bf16_t* dst; int pitch; float sc = 1.f; float* ssq = nullptr;
                if (sb < 384) { dst = WSP(bf16_t, OFF_CQ) + sb; pitch = 384; ssq = WSP(float, OFF_SSQ) + (sb >> 5); }
                else if (sb < 640) { dst = WSP(bf16_t, OFF_CKV) + (sb - 384); pitch = 256; ssq = WSP(float, OFF_SSQ) + (sb >> 5); }
                else if (sb < 1824) { const int c = sb - 672, which = c / 384, hd = c % 384; pitch = 384; dst = WSP(bf16_t, which == 0 ? OFF_FQ : which == 1 ? OFF_FK : OFF_FV) + hd; if (which == 0) sc = HD_QS; }
                else if (sb < 2080) { dst = WSP(bf16_t, OFF_NQ) + (sb - 1824); pitch = 256; sc = HD_QS; }
                else { const int c = sb - 2080, idx = c >> 6; pitch = 64;
                    dst = WSP(bf16_t, idx == 0 ? OFF_KCR : idx == 1 ? OFF_VCR : idx == 2 ? OFF_KS : idx == 3 ? OFF_VS : idx == 4 ? OFF_KW : OFF_VW) + (c & 63); }
#pragma unroll
                for (int ai = 0; ai < 2; ++ai)
#pragma unroll
                    for (int m = 0; m < 4; ++m) { const int row = rowb + ai * 128 + m * 16; const f32x4 v0 = acc[ai][bj][m][0] * sc, v1 = acc[ai][bj][m][1] * sc;
                        if (ssq) { float s = (v0[0] * v0[0] + v0[1] * v0[1]) + (v0[2] * v0[2] + v0[3] * v0[3]) + (v1[0] * v1[0] + v1[1] * v1[1]) + (v1[2] * v1[2] + v1[3] * v1[3]);
                            s += __shfl_xor(s, 16); s += __shfl_xor(s, 32); if (fq == 0) ssq[(size_t)row * 20] = s; }
                        *(U4*)(dst + (size_t)row * pitch + 8 * fq) = pack8(v0, v1); }
            }
        }
    }
};

__device__ __forceinline__ void op_inproj(const P& p, int layer, LAS unsigned char* lds, const int tid) {
    pg8::Gemm g{WSP(bf16_t, OFF_XB), WSP(bf16_t, OFF_W_IN) + (size_t)layer * NPAD_IN * D, M, NPAD_IN, D};
    pg8::StaticOrder S; S.init(M, NPAD_IN, (int)gridDim.x, (int)blockIdx.x);
    EpiInproj E{p, layer};
    pg8::gemm_phase<EpiInproj, pg8::StaticOrder, true, true>(lds, g, S, E, tid);
}

struct EpiQup {
    static constexpr bool PERM = true, AFTER_DRAIN = false;
    P p; int layer;
    __device__ __forceinline__ void operator()(const f32x4 (&acc)[2][2][4][2], const pg8::Unit& u, int wr, int wc, int fr, int fq) const {
        const int rowb = u.pm * 256 + wr * 64 + fr; const float* ssq = WSP(float, OFF_SSQ); const float* rt = WSP(float, OFF_ROPE); bf16_t* qm = WSP(bf16_t, OFF_QM);
#pragma unroll
        for (int bj = 0; bj < 2; ++bj) {
            const int sb = u.pn * 256 + bj * 128 + wc * 32;
            if (sb >= 576) continue;
            const int h = sb / 96, part = (sb % 96) / 32; const unsigned cofs = (unsigned)(h * 96 + part * 32 + 8 * fq);
            if (part == 2) {
#pragma unroll
                for (int ai = 0; ai < 2; ++ai)
#pragma unroll
                    for (int m = 0; m < 4; ++m) { const int row = rowb + ai * 128 + m * 16; const f32x4* sq = (const f32x4*)(ssq + (unsigned)row * 20u); const f32x4 s0 = sq[0], s1 = sq[1], s2 = sq[2]; const float r = MLA_QS * __builtin_amdgcn_rsqf((((s0[0] + s0[1]) + (s0[2] + s0[3])) + ((s1[0] + s1[1]) + (s1[2] + s1[3])) + ((s2[0] + s2[1]) + (s2[2] + s2[3]))) * (1.0f / 384.f) + EPS);
                        const f32x4 v0 = acc[ai][bj][m][0] * r, v1 = acc[ai][bj][m][1] * r; const int pos = row % S;
                        const f32x4* cs = (const f32x4*)(rt + (unsigned)(pos * 16 + 4 * fq) * 2u); const f32x4 c01 = cs[0], c23 = cs[1]; f32x4 o0, o1;
                        o0[0] = v0[0] * c01[0] - v1[0] * c01[1]; o0[1] = v0[1] * c01[2] - v1[1] * c01[3]; o0[2] = v0[2] * c23[0] - v1[2] * c23[1]; o0[3] = v0[3] * c23[2] - v1[3] * c23[3];
                        o1[0] = v1[0] * c01[0] + v0[0] * c01[1]; o1[1] = v1[1] * c01[2] + v0[1] * c01[3]; o1[2] = v1[2] * c23[0] + v0[2] * c23[1]; o1[3] = v1[3] * c23[2] + v0[3] * c23[3];
                        *(U4*)(qm + ((unsigned)row * 576u + cofs)) = pack8(o0, o1);
                        asm volatile("" ::: "memory"); }
            } else {
#pragma unroll
                for (int ai = 0; ai < 2; ++ai)
#pragma unroll
                    for (int m = 0; m < 4; ++m) { const int row = rowb + ai * 128 + m * 16; const f32x4* sq = (const f32x4*)(ssq + (unsigned)row * 20u); const f32x4 s0 = sq[0], s1 = sq[1], s2 = sq[2]; const float r = MLA_QS * __builtin_amdgcn_rsqf((((s0[0] + s0[1]) + (s0[2] + s0[3])) + ((s1[0] + s1[1]) + (s1[2] + s1[3])) + ((s2[0] + s2[1]) + (s2[2] + s2[3]))) * (1.0f / 384.f) + EPS);
                        *(U4*)(qm + ((unsigned)row * 576u + cofs)) = pack8(acc[ai][bj][m][0] * r, acc[ai][bj][m][1] * r);
                        asm volatile("" ::: "memory"); }
            }
        }
    }
};
struct EpiKVup {
    static constexpr bool PERM = true, AFTER_DRAIN = false;
    P p; int layer;
    __device__ __forceinline__ void operator()(const f32x4 (&acc)[2][2][4][2], const pg8::Unit& u, int wr, int wc, int fr, int fq) const {
        const int rowb = u.pm * 256 + wr * 64 + fr; const float* ssq = WSP(float, OFF_SSQ) + 12;
        bf16_t* km = WSP(bf16_t, OFF_KM); bf16_t* vm = WSP(bf16_t, OFF_VM);
        const int sb0 = u.pn * 256 + wc * 32;
#pragma unroll
        for (int ai = 0; ai < 2; ++ai)
#pragma unroll
            for (int m = 0; m < 4; ++m) { const int row = rowb + ai * 128 + m * 16; const f32x4* sq = (const f32x4*)(ssq + (unsigned)row * 20u); const f32x4 s0 = sq[0], s1 = sq[1]; const float r = __builtin_amdgcn_rsqf((((s0[0] + s0[1]) + (s0[2] + s0[3])) + ((s1[0] + s1[1]) + (s1[2] + s1[3]))) * (1.0f / 256.f) + EPS);
#pragma unroll
                for (int bj = 0; bj < 2; ++bj) { const int sb = sb0 + bj * 128, h = sb >> 7, cc = sb & 127;
                    const U4 w = pack8(acc[ai][bj][m][0] * r, acc[ai][bj][m][1] * r);
                    if (cc < 64) *(U4*)(km + (unsigned)(row * 576 + h * 96 + cc + 8 * fq)) = w; else *(U4*)(vm + (unsigned)(row * 384 + h * 64 + (cc - 64) + 8 * fq)) = w; }
                asm volatile("" ::: "memory"); }
    }
};
struct EpiResid {
    static constexpr bool PERM = true, AFTER_DRAIN = false;
    const float* base; float* out;
    __device__ __forceinline__ void operator()(const f32x4 (&acc)[2][2][4][2], const pg8::Unit& u, int wr, int wc, int fr, int fq) const {
        const int rowb = u.pm * 256 + wr * 64 + fr;
#pragma unroll
        for (int ai = 0; ai < 2; ++ai)
#pragma unroll
            for (int m = 0; m < 4; ++m) { const size_t ro = (size_t)(rowb + ai * 128 + m * 16) * D;
#pragma unroll
                for (int bj = 0; bj < 2; ++bj) { const size_t o = ro + u.pn * 256 + bj * 128 + wc * 32 + 8 * fq;
                    const f32x4 b0 = *(const f32x4*)(base + o), b1 = *(const f32x4*)(base + o + 4);
                    *(f32x4*)(out + o) = b0 * ALPHA + acc[ai][bj][m][0]; *(f32x4*)(out + o + 4) = b1 * ALPHA + acc[ai][bj][m][1]; } }
    }
};
struct EpiSwiglu {
    static constexpr bool PERM = true, AFTER_DRAIN = false;
    bf16_t* Hout; int ldh;
    __device__ __forceinline__ void operator()(const f32x4 (&acc)[2][2][4][2], const pg8::Unit& u, int wr, int wc, int fr, int fq) const {
        const int rowb = u.pm * 256 + wr * 64 + fr; const int col = u.pn * 128 + wc * 32 + 8 * fq;
#pragma unroll
        for (int ai = 0; ai < 2; ++ai)
#pragma unroll
            for (int m = 0; m < 4; ++m) { f32x4 h0, h1;
#pragma unroll
                for (int j = 0; j < 4; ++j) { const float a0 = acc[ai][0][m][0][j], a1 = acc[ai][0][m][1][j];
                    h0[j] = a0 * acc[ai][1][m][0][j] * __builtin_amdgcn_rcpf(1.0f + __expf(-a0)); h1[j] = a1 * acc[ai][1][m][1][j] * __builtin_amdgcn_rcpf(1.0f + __expf(-a1)); }
                *(U4*)(Hout + (size_t)(rowb + ai * 128 + m * 16) * ldh + col) = pack8(h0, h1); }
    }
};

__device__ __forceinline__ void op_mla_qup(const P& p, int layer, LAS unsigned char* lds, const int tid) {
    { pg8::Gemm g{WSP(bf16_t, OFF_CQ), WSP(bf16_t, OFF_W_UQ) + (size_t)layer * 768 * 384, M, 768, 384};
      pg8::StaticOrder S; S.init(M, 768, (int)gridDim.x, (int)blockIdx.x); EpiQup E{p, layer};
      pg8::gemm_phase<EpiQup, pg8::StaticOrder, true, true>(lds, g, S, E, tid); }
}
__device__ __forceinline__ void op_mla_kvup(const P& p, int layer, LAS unsigned char* lds, const int tid) {
    { pg8::Gemm g{WSP(bf16_t, OFF_CKV), WSP(bf16_t, OFF_W_UKV) + (size_t)layer * 768 * 256, M, 768, 256};
      pg8::StaticOrder S; S.init(M, 768, (int)gridDim.x, (int)((blockIdx.x + gridDim.x / 2) % gridDim.x)); EpiKVup E{p, layer};
      pg8::gemm_phase<EpiKVup, pg8::StaticOrder, true, true>(lds, g, S, E, tid); }
}
__device__ __forceinline__ void op_wout(const P& p, int layer, LAS unsigned char* lds, const int tid) {
    pg8::Gemm g{WSP(bf16_t, OFF_MIX), WSP(bf16_t, OFF_W_OUT) + (size_t)layer * D * MIXW, M, D, MIXW};
    pg8::StaticOrder S; S.init(M, D, (int)gridDim.x, (int)blockIdx.x); EpiResid E{layer == 0 ? p.x : p.out, p.out};
    pg8::gemm_phase<EpiResid, pg8::StaticOrder, true, true>(lds, g, S, E, tid);
}
__device__ __forceinline__ void op_ffn_up(const P& p, LAS unsigned char* lds, const int tid) {
    pg8::Gemm g{WSP(bf16_t, OFF_XB), WSP(bf16_t, OFF_W_F13), M, 2 * DFF, D};
    pg8::StaticOrder S; S.init(M, 2 * DFF, (int)gridDim.x, (int)blockIdx.x); EpiSwiglu E{WSP(bf16_t, OFF_H), DFF};
    pg8::gemm_phase<EpiSwiglu, pg8::StaticOrder, true, true>(lds, g, S, E, tid);
}
__device__ __forceinline__ void op_ffn_down(const P& p, LAS unsigned char* lds, const int tid) {
    pg8::Gemm g{WSP(bf16_t, OFF_H), WSP(bf16_t, OFF_W_F2), M, D, DFF};
    pg8::StaticOrder S; S.init(M, D, (int)gridDim.x, (int)blockIdx.x); EpiResid E{p.out, p.out};
    pg8::gemm_phase<EpiResid, pg8::StaticOrder, true, true>(lds, g, S, E, tid);
}
__device__ __forceinline__ float wave_sum(float v) {
#pragma unroll
    for (int o = 1; o < 64; o <<= 1) v += __shfl_xor(v, o);
    return v;
}
__device__ __forceinline__ void op_ln(const P& p, const float* g, const float* bta, const int tid) {
    static_assert(D == 1024, "op_ln: 16 floats per lane");
    const int lane = tid & 63, gw = blockIdx.x * (OPT_THREADS / 64) + (tid >> 6), ngw = gridDim.x * (OPT_THREADS / 64);
    f32x4 gv[4], bv[4];
#pragma unroll
    for (int j = 0; j < 4; ++j) { gv[j] = ((const f32x4*)g)[lane + 64 * j]; bv[j] = ((const f32x4*)bta)[lane + 64 * j]; }
    for (int row = gw; row < M; row += ngw) {
        f32x4* xr = (f32x4*)(p.out + (size_t)row * D) + lane; f32x4 v[4]; float s = 0.f;
#pragma unroll
        for (int j = 0; j < 4; ++j) { v[j] = xr[64 * j]; s += (v[j][0] + v[j][1]) + (v[j][2] + v[j][3]); }
        const float mean = wave_sum(s) * (1.f / D); float s2 = 0.f;
#pragma unroll
        for (int j = 0; j < 4; ++j) { v[j] = v[j] - mean; s2 += (v[j][0] * v[j][0] + v[j][1] * v[j][1]) + (v[j][2] * v[j][2] + v[j][3] * v[j][3]); }
        const float rstd = 1.f / sqrtf(wave_sum(s2) * (1.f / D) + EPS);
        unsigned long long* o8 = (unsigned long long*)(WSP(bf16_t, OFF_XB) + (size_t)row * D) + lane;
#pragma unroll
        for (int j = 0; j < 4; ++j) { const f32x4 y = v[j] * rstd * gv[j] + bv[j]; xr[64 * j] = y; o8[64 * j] = (unsigned long long)pk2(y[0], y[1]) | ((unsigned long long)pk2(y[2], y[3]) << 32); }
    }
}

constexpr int CW_GCNT = 4096;
__device__ __forceinline__ float bf_lo(unsigned u) { return __uint_as_float(u << 16); }
__device__ __forceinline__ float bf_hi(unsigned u) { return __uint_as_float(u & 0xffff0000u); }
__device__ __forceinline__ void op_ln_router(const P& p, const float* g, const float* bta, LAS unsigned char* lds, const int tid) {
    static_assert(D == 1024, "op_ln_router: 16 floats per lane");
    const int lane = tid & 63, gw = blockIdx.x * (OPT_THREADS / 64) + (tid >> 6), ngw = gridDim.x * (OPT_THREADS / 64);
    LAS unsigned* lcnt = (LAS unsigned*)lds; LAS unsigned* lbase = lcnt + 8;
    if (tid < 16) lcnt[tid] = 0u;
    __syncthreads();
    f32x4 gv[4], bv[4];
#pragma unroll
    for (int j = 0; j < 4; ++j) { gv[j] = ((const f32x4*)g)[lane + 64 * j]; bv[j] = ((const f32x4*)bta)[lane + 64 * j]; }
    unsigned* gcnt = WSP(unsigned, OFF_CTL) + CW_GCNT; int* eidx = WSP(int, OFF_EIDX); float* egate = WSP(float, OFF_EGATE); int* tsl = WSP(int, OFF_TOKSLOT);
    for (int row = gw; row < M; row += ngw) {
        f32x4* xr = (f32x4*)(p.out + (size_t)row * D) + lane; f32x4 v[4]; float s = 0.f;
#pragma unroll
        for (int j = 0; j < 4; ++j) { v[j] = xr[64 * j]; s += (v[j][0] + v[j][1]) + (v[j][2] + v[j][3]); }
        const float mean = wave_sum(s) * (1.f / D); float s2 = 0.f;
#pragma unroll
        for (int j = 0; j < 4; ++j) { v[j] = v[j] - mean; s2 += (v[j][0] * v[j][0] + v[j][1] * v[j][1]) + (v[j][2] * v[j][2] + v[j][3] * v[j][3]); }
        const float rstd = 1.f / sqrtf(wave_sum(s2) * (1.f / D) + EPS);
        unsigned long long* o8 = (unsigned long long*)(WSP(bf16_t, OFF_XB) + (size_t)row * D) + lane;
        float lg[NE];
#pragma unroll
        for (int e = 0; e < NE; ++e) lg[e] = 0.f;
#pragma unroll
        for (int j = 0; j < 4; ++j) { const f32x4 y = v[j] * rstd * gv[j] + bv[j]; xr[64 * j] = y; o8[64 * j] = (unsigned long long)pk2(y[0], y[1]) | ((unsigned long long)pk2(y[2], y[3]) << 32);
            const f32x4* rw4 = (const f32x4*)(p.rw + (size_t)(4 * lane + 256 * j) * NE);
#pragma unroll
            for (int c = 0; c < 4; ++c) { const f32x4 r0 = rw4[2 * c], r1 = rw4[2 * c + 1];
                lg[0] += y[c] * r0[0]; lg[1] += y[c] * r0[1]; lg[2] += y[c] * r0[2]; lg[3] += y[c] * r0[3]; lg[4] += y[c] * r1[0]; lg[5] += y[c] * r1[1]; lg[6] += y[c] * r1[2]; lg[7] += y[c] * r1[3]; } }
#pragma unroll
        for (int e = 0; e < NE; ++e) lg[e] = wave_sum(lg[e]);
        float mx = lg[0];
#pragma unroll
        for (int e = 1; e < NE; ++e) mx = fmaxf(mx, lg[e]);
        float pr[NE]; float sum = 0.f;
#pragma unroll
        for (int e = 0; e < NE; ++e) { pr[e] = expf(lg[e] - mx); sum += pr[e]; }
        int i1 = 0; float p1 = pr[0] / sum;
#pragma unroll
        for (int e = 1; e < NE; ++e) { const float pe = pr[e] / sum; if (pe > p1) { p1 = pe; i1 = e; } }
        int i2 = -1; float p2 = -1.f;
#pragma unroll
        for (int e = 0; e < NE; ++e) { const float pe = pr[e] / sum; if (e != i1 && pe > p2) { p2 = pe; i2 = e; } }
        if (lane == 0) {
            const unsigned q1 = __hip_atomic_fetch_add(lcnt + i1, 1u, __ATOMIC_RELAXED, __HIP_MEMORY_SCOPE_WORKGROUP), q2 = __hip_atomic_fetch_add(lcnt + i2, 1u, __ATOMIC_RELAXED, __HIP_MEMORY_SCOPE_WORKGROUP);
            eidx[row * 2] = i1; eidx[row * 2 + 1] = i2; egate[row * 2] = p1 / (p1 + p2); egate[row * 2 + 1] = p2 / (p1 + p2); tsl[row * 2] = (int)q1; tsl[row * 2 + 1] = (int)q2; }
    }
    __syncthreads();
    if (tid < NE) lbase[tid] = __hip_atomic_fetch_add(gcnt + 64 * tid, lcnt[tid], __ATOMIC_RELAXED, __HIP_MEMORY_SCOPE_AGENT);
    __syncthreads();
    if (lane == 0) for (int row = gw; row < M; row += ngw) { tsl[row * 2] += (int)lbase[eidx[row * 2]]; tsl[row * 2 + 1] += (int)lbase[eidx[row * 2 + 1]]; }
}
__device__ __forceinline__ void moe_offsets(const P& p, int (&offs)[NE + 1]) {
    const unsigned* gcnt = WSP(unsigned, OFF_CTL) + CW_GCNT; int o = 0;
#pragma unroll
    for (int e = 0; e < NE; ++e) { offs[e] = o; o += (int)((__hip_atomic_load(gcnt + 64 * e, __ATOMIC_RELAXED, __HIP_MEMORY_SCOPE_AGENT) + 255u) & ~255u); }
    offs[NE] = o;
}
__device__ __forceinline__ void op_moe_scatter(const P& p, const int tid) {
    const int lane = tid & 63, gw = blockIdx.x * (OPT_THREADS / 64) + (tid >> 6), ngw = gridDim.x * (OPT_THREADS / 64);
    int offs[NE + 1]; moe_offsets(p, offs);
    int* eidx = WSP(int, OFF_EIDX); float* egate = WSP(float, OFF_EGATE); int* tsl = WSP(int, OFF_TOKSLOT); float* gates = WSP(float, OFF_GATES);
    for (int pr = gw; pr < 2 * M; pr += ngw) {
        const int e = eidx[pr]; int ob = offs[0];
#pragma unroll
        for (int k = 1; k < NE; ++k) ob = (e == k) ? offs[k] : ob;
        const int srow = ob + tsl[pr];
        const U4* src = (const U4*)(WSP(bf16_t, OFF_XB) + (size_t)(pr >> 1) * D); U4* dst = (U4*)(WSP(bf16_t, OFF_XS) + (size_t)srow * D);
        const U4 a = src[lane], b = src[lane + 64]; dst[lane] = a; dst[lane + 64] = b;
        if (lane == 0) { gates[srow] = egate[pr]; }
        asm volatile("s_waitcnt vmcnt(0)" ::: "memory");
        if (lane == 0) tsl[pr] = srow;
    }
}
struct MoeOrder {
    int ts[NE + 1]; int nN, G, c;
    __device__ __forceinline__ void init(const int (&offs)[NE + 1], int nN_, int G_, int c_) {
#pragma unroll
        for (int e = 0; e <= NE; ++e) ts[e] = offs[e] >> 8;
        nN = nN_; G = G_; c = c_; }
    __device__ __forceinline__ bool next(int i, pg8::Unit& u) const {
        const int L = i * G + c; if (L >= ts[NE] * nN) return false;
        const int tau = L / nN, pn = L - tau * nN; int e = 0;
#pragma unroll
        for (int k = 1; k < NE; ++k) e += (tau >= ts[k]) ? 1 : 0;
        u.pm = tau; u.pn = e * nN + pn; return true; }
    __device__ __forceinline__ void a_ready(const pg8::Unit&) const {}
    __device__ __forceinline__ void done(const pg8::Unit&) const {}
};
struct EpiSwigluMoe {
    static constexpr bool PERM = true, AFTER_DRAIN = false;
    bf16_t* Hout; int ldh, nN;
    __device__ __forceinline__ void operator()(const f32x4 (&acc)[2][2][4][2], const pg8::Unit& u, int wr, int wc, int fr, int fq) const {
        const int rowb = u.pm * 256 + wr * 64 + fr; const int col = (u.pn % nN) * 128 + wc * 32 + 8 * fq;
#pragma unroll
        for (int ai = 0; ai < 2; ++ai)
#pragma unroll
            for (int m = 0; m < 4; ++m) { f32x4 h0, h1;
#pragma unroll
                for (int j = 0; j < 4; ++j) { const float a0 = acc[ai][0][m][0][j], a1 = acc[ai][0][m][1][j];
                    h0[j] = a0 * acc[ai][1][m][0][j] * __builtin_amdgcn_rcpf(1.0f + __expf(-a0)); h1[j] = a1 * acc[ai][1][m][1][j] * __builtin_amdgcn_rcpf(1.0f + __expf(-a1)); }
                *(U4*)(Hout + (size_t)(rowb + ai * 128 + m * 16) * ldh + col) = pack8(h0, h1); }
    }
};
struct EpiMoeDown {
    static constexpr bool PERM = true, AFTER_DRAIN = false;
    bf16_t* Y; const float* gates;
    __device__ __forceinline__ void operator()(const f32x4 (&acc)[2][2][4][2], const pg8::Unit& u, int wr, int wc, int fr, int fq) const {
        const int rowb = u.pm * 256 + wr * 64 + fr; const int col = (u.pn & 3) * 256 + wc * 32 + 8 * fq;
#pragma unroll
        for (int ai = 0; ai < 2; ++ai)
#pragma unroll
            for (int m = 0; m < 4; ++m) { const int row = rowb + ai * 128 + m * 16; const float gt = gates[row];
#pragma unroll
                for (int bj = 0; bj < 2; ++bj) *(U4*)(Y + (size_t)row * D + col + bj * 128) = pack8(acc[ai][bj][m][0] * gt, acc[ai][bj][m][1] * gt); }
    }
};
__device__ __forceinline__ void op_moe_up(const P& p, LAS unsigned char* lds, const int tid) {
    static_assert(D / 256 == 4, "EpiMoeDown: four column tiles");
    int offs[NE + 1]; moe_offsets(p, offs);
    pg8::Gemm g{WSP(bf16_t, OFF_XS), WSP(bf16_t, OFF_W_M13), ROWS_PAD, 2 * DFE, D};
    MoeOrder S; S.init(offs, 2 * DFE / 256, (int)gridDim.x, (int)blockIdx.x); EpiSwigluMoe E{WSP(bf16_t, OFF_HE), DFE, 2 * DFE / 256};
    pg8::gemm_phase<EpiSwigluMoe, MoeOrder, true, true>(lds, g, S, E, tid);
}
__device__ __forceinline__ void op_moe_down(const P& p, LAS unsigned char* lds, const int tid) {
    int offs[NE + 1]; moe_offsets(p, offs);
    pg8::Gemm g{WSP(bf16_t, OFF_HE), WSP(bf16_t, OFF_W_M2), ROWS_PAD, D, DFE};
    MoeOrder S; S.init(offs, D / 256, (int)gridDim.x, (int)blockIdx.x); EpiMoeDown E{WSP(bf16_t, OFF_XS), WSP(float, OFF_GATES)};
    pg8::gemm_phase<EpiMoeDown, MoeOrder, true, true>(lds, g, S, E, tid);
}
__device__ __forceinline__ void op_ln_moe(const P& p, const float* g, const float* bta, const int tid) {
    const int lane = tid & 63, gw = blockIdx.x * (OPT_THREADS / 64) + (tid >> 6), ngw = gridDim.x * (OPT_THREADS / 64);
    f32x4 gv[4], bv[4];
#pragma unroll
    for (int j = 0; j < 4; ++j) { gv[j] = ((const f32x4*)g)[lane + 64 * j]; bv[j] = ((const f32x4*)bta)[lane + 64 * j]; }
    const int* tsl = WSP(int, OFF_TOKSLOT);
    for (int row = gw; row < M; row += ngw) {
        f32x4* xr = (f32x4*)(p.out + (size_t)row * D) + lane; f32x4 v[4]; float s = 0.f;
        const unsigned long long* y0 = (const unsigned long long*)(WSP(bf16_t, OFF_XS) + (size_t)tsl[row * 2] * D) + lane;
        const unsigned long long* y1 = (const unsigned long long*)(WSP(bf16_t, OFF_XS) + (size_t)tsl[row * 2 + 1] * D) + lane;
#pragma unroll
        for (int j = 0; j < 4; ++j) { const unsigned long long a = y0[64 * j], b = y1[64 * j]; const unsigned al = (unsigned)a, ah = (unsigned)(a >> 32), bl = (unsigned)b, bh = (unsigned)(b >> 32);
            f32x4 f; f[0] = bf_lo(al) + bf_lo(bl); f[1] = bf_hi(al) + bf_hi(bl); f[2] = bf_lo(ah) + bf_lo(bh); f[3] = bf_hi(ah) + bf_hi(bh);
            v[j] = xr[64 * j] * ALPHA + f; s += (v[j][0] + v[j][1]) + (v[j][2] + v[j][3]); }
        const float mean = wave_sum(s) * (1.f / D); float s2 = 0.f;
#pragma unroll
        for (int j = 0; j < 4; ++j) { v[j] = v[j] - mean; s2 += (v[j][0] * v[j][0] + v[j][1] * v[j][1]) + (v[j][2] * v[j][2] + v[j][3] * v[j][3]); }
        const float rstd = 1.f / sqrtf(wave_sum(s2) * (1.f / D) + EPS);
#pragma unroll
        for (int j = 0; j < 4; ++j) xr[64 * j] = v[j] * rstd * gv[j] + bv[j];
    }
}

typedef pg8::bf16x8 bf16x8;
typedef float f32x16 __attribute__((ext_vector_type(16)));
typedef short s16x4 __attribute__((ext_vector_type(4)));
typedef unsigned v4u __attribute__((ext_vector_type(4)));
constexpr int AT_KBUF = 64 * 208, AT_VSTR = 144, AT_VBUF = 64 * AT_VSTR;
constexpr int AT_K0 = 0, AT_V0 = 2 * AT_KBUF, AT_BIAS = AT_V0 + 2 * AT_VBUF, AT_WS = AT_BIAS + 512, AT_WSB = 3072, AT_OST = AT_WS + 8 * AT_WSB, AT_OSTB = 32 * 272, AT_MISC = AT_OST + 8 * AT_OSTB;
static_assert(AT_MISC + 256 <= LDS_BYTES, "attention LDS map");
constexpr int CW_QHEAD = 8192;
constexpr int N_ATT_UNITS = NB * 6 * (S / 256) * 2 + NB * (S / 64);
constexpr float AT_THR = 4.0f, AT_NEG = -1.0e30f;
enum { AM_MLA = 0, AM_FOX = 1, AM_SEL = 2, AM_WIN = 3, AM_CMP = 4 };

__device__ __forceinline__ float xhalf_max(float v) { auto rr = __builtin_amdgcn_permlane32_swap(__float_as_uint(v), __float_as_uint(v), false, false); return fmaxf(__uint_as_float(rr[0]), __uint_as_float(rr[1])); }
__device__ __forceinline__ float xhalf_sum(float v) { auto rr = __builtin_amdgcn_permlane32_swap(__float_as_uint(v), __float_as_uint(v), false, false); return __uint_as_float(rr[0]) + __uint_as_float(rr[1]); }
__device__ __forceinline__ s16x4 vtr(LAS const unsigned char* p) { typedef short v4i16_t __attribute__((ext_vector_type(4))); return __builtin_bit_cast(s16x4, __builtin_amdgcn_ds_read_tr16_b64_v4i16((LAS v4i16_t*)p)); }
__device__ __forceinline__ int crow_c(int r) { return (r & 3) + 8 * (r >> 2); }

template <int DK> struct TileRegs { v4u k0, k1, v0; float bias; };
template <int DK, bool BIAS> __device__ __forceinline__ void tile_load(TileRegs<DK>& R, const bf16_t* Kg, int kpitch, const bf16_t* Vg, int vpitch, const float* Bg, int tile, int tid) {
    constexpr int CPR = DK / 8;
    { const int key = tid / CPR, part = tid % CPR; R.k0 = *(const v4u*)(Kg + (size_t)(tile * 64 + key) * kpitch + part * 8); }
    if (DK == 96) { if (tid < 256) { const int c2 = tid + 512, key = c2 / CPR, part = c2 % CPR; R.k1 = *(const v4u*)(Kg + (size_t)(tile * 64 + key) * kpitch + part * 8); } }
    R.v0 = *(const v4u*)(Vg + (size_t)(tile * 64 + (tid >> 3)) * vpitch + (tid & 7) * 8);
    if (BIAS) { if (tid < 64) R.bias = Bg[tile * 64 + tid]; }
}
template <int DK, bool BIAS> __device__ __forceinline__ void tile_store(const TileRegs<DK>& R, LAS unsigned char* lds, int buf, int tid) {
    constexpr int CPR = DK / 8, KSTR = DK * 2 + 16;
    { const int key = tid / CPR, part = tid % CPR; *(LAS v4u*)(lds + AT_K0 + buf * AT_KBUF + key * KSTR + part * 16) = R.k0; }
    if (DK == 96) { if (tid < 256) { const int c2 = tid + 512, key = c2 / CPR, part = c2 % CPR; *(LAS v4u*)(lds + AT_K0 + buf * AT_KBUF + key * KSTR + part * 16) = R.k1; } }
    *(LAS v4u*)(lds + AT_V0 + buf * AT_VBUF + (tid >> 3) * AT_VSTR + (tid & 7) * 16) = R.v0;
    if (BIAS) { if (tid < 64) *(LAS float*)(lds + AT_BIAS + buf * 256 + tid * 4) = R.bias; }
}
template <int DK> __device__ __forceinline__ void tile_scores(LAS const unsigned char* lds, int buf, const bf16x8 (&qr)[DK / 16], f32x16& p0, f32x16& p1, int lane) {
    constexpr int KSTR = DK * 2 + 16;
    LAS const unsigned char* Kb = lds + AT_K0 + buf * AT_KBUF + (lane & 31) * KSTR + (lane >> 5) * 16;
#pragma unroll
    for (int r = 0; r < 16; ++r) { p0[r] = 0.f; p1[r] = 0.f; }
#pragma unroll
    for (int d0 = 0; d0 < DK / 16; ++d0) { const bf16x8 a0 = *(LAS const bf16x8*)(Kb + d0 * 32), a1 = *(LAS const bf16x8*)(Kb + 32 * KSTR + d0 * 32);
        p0 = __builtin_amdgcn_mfma_f32_32x32x16_bf16(a0, qr[d0], p0, 0, 0, 0); p1 = __builtin_amdgcn_mfma_f32_32x32x16_bf16(a1, qr[d0], p1, 0, 0, 0); }
}
template <int MODE> __device__ __forceinline__ void tile_bias_mask(LAS const unsigned char* lds, int buf, f32x16& p0, f32x16& p1, int lane, int kbase, int qpos, float rowf, bool rowsel, bool need_mask) {
    const int hi = lane >> 5;
    if (MODE == AM_FOX) { LAS const float* cb = (LAS const float*)(lds + AT_BIAS + buf * 256) + 4 * hi;
#pragma unroll
        for (int i = 0; i < 4; ++i) { const f32x4 c0 = *(LAS const f32x4*)(cb + 8 * i), c1 = *(LAS const f32x4*)(cb + 32 + 8 * i);
#pragma unroll
            for (int j = 0; j < 4; ++j) { p0[4 * i + j] += rowf - c0[j]; p1[4 * i + j] += rowf - c1[j]; } } }
    if (MODE == AM_SEL || MODE == AM_WIN || MODE == AM_CMP) { const float kf = (float)(kbase + 4 * hi);
#pragma unroll
        for (int r = 0; r < 16; ++r) { p0[r] = fmaf(rowf, kf + (float)crow_c(r), p0[r]); p1[r] = fmaf(rowf, kf + (float)(32 + crow_c(r)), p1[r]); } }
    if (need_mask) { const int k0 = kbase + 4 * hi;
#pragma unroll
        for (int r = 0; r < 16; ++r) { const int ka = k0 + crow_c(r), kb = ka + 32; bool oa = ka <= qpos, ob = kb <= qpos;
            if (MODE == AM_WIN) { oa = oa && (ka >= qpos - 255); ob = ob && (kb >= qpos - 255); }
            if (MODE == AM_SEL) { oa = oa && rowsel; ob = ob && rowsel; }
            p0[r] = oa ? p0[r] : AT_NEG; p1[r] = ob ? p1[r] : AT_NEG; } }
}
__device__ __forceinline__ void tile_softmax_pv(LAS const unsigned char* lds, int buf, f32x16& p0, f32x16& p1, f32x16 (&o)[2], float& m, float& l, LAS float* wsf, int lane) {
    const int r32 = lane & 31, hi = lane >> 5;
    float rm = fmaxf(p0[0], p1[0]);
#pragma unroll
    for (int r = 1; r < 16; ++r) rm = fmaxf(rm, fmaxf(p0[r], p1[r]));
    rm = xhalf_max(rm);
    const bool need = rm > m + AT_THR;
    if (__any(need)) {
        const float mn = need ? rm : m; const float alpha = __builtin_amdgcn_exp2f(m - mn); m = mn; l *= alpha;
        if (hi == 0) wsf[r32] = alpha;
#pragma unroll
        for (int i = 0; i < 4; ++i) { const f32x4 a = *(LAS const f32x4*)(wsf + 8 * i + 4 * hi);
#pragma unroll
            for (int j = 0; j < 4; ++j) { o[0][4 * i + j] *= a[j]; o[1][4 * i + j] *= a[j]; } }
    }
    float rs = 0.f;
#pragma unroll
    for (int r = 0; r < 16; ++r) { p0[r] = __builtin_amdgcn_exp2f(p0[r] - m); p1[r] = __builtin_amdgcn_exp2f(p1[r] - m); rs += p0[r] + p1[r]; }
    l += rs;
    v4u w0, w1, w2, w3;
    w0[0] = pk2(p0[0], p0[1]); w0[1] = pk2(p0[2], p0[3]); w0[2] = pk2(p0[4], p0[5]); w0[3] = pk2(p0[6], p0[7]);
    w1[0] = pk2(p0[8], p0[9]); w1[1] = pk2(p0[10], p0[11]); w1[2] = pk2(p0[12], p0[13]); w1[3] = pk2(p0[14], p0[15]);
    w2[0] = pk2(p1[0], p1[1]); w2[1] = pk2(p1[2], p1[3]); w2[2] = pk2(p1[4], p1[5]); w2[3] = pk2(p1[6], p1[7]);
    w3[0] = pk2(p1[8], p1[9]); w3[1] = pk2(p1[10], p1[11]); w3[2] = pk2(p1[12], p1[13]); w3[3] = pk2(p1[14], p1[15]);
    const bf16x8 pa[4] = {__builtin_bit_cast(bf16x8, w0), __builtin_bit_cast(bf16x8, w1), __builtin_bit_cast(bf16x8, w2), __builtin_bit_cast(bf16x8, w3)};
    LAS const unsigned char* Vb = lds + AT_V0 + buf * AT_VBUF + (4 * hi + ((lane & 15) >> 2)) * AT_VSTR + (((lane >> 4) & 1) * 16 + (lane & 3) * 4) * 2;
#pragma unroll
    for (int d0 = 0; d0 < 2; ++d0)
#pragma unroll
        for (int ks = 0; ks < 4; ++ks) { const s16x4 lo = vtr(Vb + (16 * ks) * AT_VSTR + d0 * 64), h4 = vtr(Vb + (16 * ks + 8) * AT_VSTR + d0 * 64);
            const bf16x8 vf = {lo[0], lo[1], lo[2], lo[3], h4[0], h4[1], h4[2], h4[3]};
            o[d0] = __builtin_amdgcn_mfma_f32_32x32x16_bf16(pa[ks], vf, o[d0], 0, 0, 0); }
}
template <bool ADD> __device__ __forceinline__ void rows_scale(f32x16 (&o)[2], f32x16 (&acc)[2], float f, LAS float* wsf, int lane) {
    const int r32 = lane & 31, hi = lane >> 5;
    if (hi == 0) wsf[r32] = f;
#pragma unroll
    for (int i = 0; i < 4; ++i) { const f32x4 a = *(LAS const f32x4*)(wsf + 8 * i + 4 * hi);
#pragma unroll
        for (int j = 0; j < 4; ++j) { if (ADD) { acc[0][4 * i + j] += a[j] * o[0][4 * i + j]; acc[1][4 * i + j] += a[j] * o[1][4 * i + j]; } else { o[0][4 * i + j] *= a[j]; o[1][4 * i + j] *= a[j]; } } }
}
__device__ __forceinline__ void out_store(const f32x16 (&o)[2], LAS unsigned char* stg, bf16_t* dst0, int lane, int mode_nsa) {
    const int r32 = lane & 31, hi = lane >> 5;
#pragma unroll
    for (int r = 0; r < 16; ++r) { const int orow = crow_c(r) + 4 * hi;
        *(LAS bf16_t*)(stg + orow * 144 + r32 * 2) = (bf16_t)(pk2(o[0][r], 0.f) & 0xffffu); *(LAS bf16_t*)(stg + orow * 144 + 64 + r32 * 2) = (bf16_t)(pk2(o[1][r], 0.f) & 0xffffu); }
#pragma unroll
    for (int i = 0; i < 4; ++i) { const int row = i * 8 + (lane >> 3), ch = lane & 7; const v4u v = *(LAS const v4u*)(stg + row * 144 + ch * 16);
        const size_t off = mode_nsa ? ((size_t)(row >> 2) * MIXW + (row & 3) * 64) : (size_t)row * MIXW;
        *(v4u*)(dst0 + off + ch * 8) = v; }
}

template <bool FIRST> __device__ __forceinline__ void rows_accum_lds(const f32x16 (&o)[2], float f, LAS float* wsf, LAS float* img, int lane) {
    const int r32 = lane & 31, hi = lane >> 5;
    if (hi == 0) wsf[r32] = f;
#pragma unroll
    for (int i = 0; i < 4; ++i) { const f32x4 a = *(LAS const f32x4*)(wsf + 8 * i + 4 * hi);
#pragma unroll
        for (int j = 0; j < 4; ++j) { LAS float* q = img + (8 * i + 4 * hi + j) * 68 + r32;
            if (FIRST) { q[0] = a[j] * o[0][4 * i + j]; q[32] = a[j] * o[1][4 * i + j]; } else { q[0] += a[j] * o[0][4 * i + j]; q[32] += a[j] * o[1][4 * i + j]; } } }
}
__device__ __forceinline__ void out_store_img(LAS const float* img, bf16_t* dst0, int lane) {
#pragma unroll
    for (int i = 0; i < 4; ++i) { const int row = i * 8 + (lane >> 3), ch = lane & 7; const f32x4 a = *(LAS const f32x4*)(img + row * 68 + ch * 8), b = *(LAS const f32x4*)(img + row * 68 + ch * 8 + 4);
        *(U4*)(dst0 + (size_t)(row >> 2) * MIXW + (row & 3) * 64 + ch * 8) = pack8(a, b); }
}

template <int DK, int MODE> __device__ __forceinline__ void attn_unit_causal(const P& p, LAS unsigned char* lds, int b, int h, int qb, const int tid) {
    const int lane = tid & 63, wave = __builtin_amdgcn_readfirstlane(tid >> 6), r32 = lane & 31, hi = lane >> 5;
    constexpr bool BIAS = (MODE == AM_FOX);
    const int qpitch = (MODE == AM_MLA) ? 576 : 384, hoff = (MODE == AM_MLA) ? h * 96 : h * 64;
    const bf16_t* Qg = WSP(bf16_t, MODE == AM_MLA ? OFF_QM : OFF_FQ) + (size_t)b * S * qpitch + hoff;
    const bf16_t* Kg = WSP(bf16_t, MODE == AM_MLA ? OFF_KM : OFF_FK) + (size_t)b * S * qpitch + hoff;
    const bf16_t* Vg = WSP(bf16_t, MODE == AM_MLA ? OFF_VM : OFF_FV) + (size_t)b * S * 384 + h * 64;
    const float* Bg = WSP(float, OFF_FC) + ((size_t)b * 6 + h) * S;
    const int q0w = qb * 256 + wave * 32, qpos = q0w + r32;
    bf16x8 qr[DK / 16];
#pragma unroll
    for (int d0 = 0; d0 < DK / 16; ++d0) qr[d0] = *(const bf16x8*)(Qg + (size_t)qpos * qpitch + d0 * 16 + hi * 8);
    const float rowf = BIAS ? Bg[qpos] : 0.f;
    LAS float* wsf = (LAS float*)(lds + AT_WS + wave * AT_WSB);
    f32x16 o[2]; float m = AT_NEG, l = 0.f;
#pragma unroll
    for (int r = 0; r < 16; ++r) { o[0][r] = 0.f; o[1][r] = 0.f; }
    const int nt = 4 * (qb + 1);
    TileRegs<DK> R; tile_load<DK, BIAS>(R, Kg, qpitch, Vg, 384, Bg, 0, tid); tile_store<DK, BIAS>(R, lds, 0, tid);
    __syncthreads();
    for (int t = 0; t < nt; ++t) {
        const int buf = t & 1;
        if (t + 1 < nt) tile_load<DK, BIAS>(R, Kg, qpitch, Vg, 384, Bg, t + 1, tid);
        if (t * 64 <= q0w + 31) {
            f32x16 p0, p1; tile_scores<DK>(lds, buf, qr, p0, p1, lane);
            tile_bias_mask<MODE>(lds, buf, p0, p1, lane, t * 64, qpos, rowf, true, t * 64 + 63 > q0w);
            tile_softmax_pv(lds, buf, p0, p1, o, m, l, wsf, lane);
        }
        if (t + 1 < nt) tile_store<DK, BIAS>(R, lds, buf ^ 1, tid);
        __syncthreads();
    }
    const float inv = 1.0f / xhalf_sum(l);
    rows_scale<false>(o, o, inv, wsf, lane);
    out_store(o, lds + AT_OST + wave * AT_OSTB, WSP(bf16_t, OFF_MIX) + (size_t)(b * S + q0w) * MIXW + (MODE == AM_MLA ? 0 : 384) + h * 64, lane, 0);
}

template <int MODE> __device__ __forceinline__ void nsa_branch_tiles(const P& p, LAS unsigned char* lds, const bf16_t* Kg, const bf16_t* Vg, unsigned tmask, const bf16x8 (&qr)[4], f32x16 (&o)[2], float& m, float& l,
                                                                     LAS float* wsf, int lane, int tid, int qpos, float rowf, unsigned selmask) {
    TileRegs<64> R; unsigned rem = tmask; int cur = __builtin_ctz(rem); rem &= rem - 1u; int buf = 0;
    tile_load<64, false>(R, Kg, 64, Vg, 64, nullptr, cur, tid); tile_store<64, false>(R, lds, 0, tid);
    __syncthreads();
    for (;;) {
        const int nxt = rem ? __builtin_ctz(rem) : -1; rem &= rem - 1u;
        if (nxt >= 0) tile_load<64, false>(R, Kg, 64, Vg, 64, nullptr, nxt, tid);
        { f32x16 p0, p1; tile_scores<64>(lds, buf, qr, p0, p1, lane);
          tile_bias_mask<MODE>(lds, buf, p0, p1, lane, cur * 64, qpos, rowf, ((selmask >> cur) & 1u) != 0u, true);
          tile_softmax_pv(lds, buf, p0, p1, o, m, l, wsf, lane); }
        if (nxt >= 0) tile_store<64, false>(R, lds, buf ^ 1, tid);
        __syncthreads();
        if (nxt < 0) break;
        cur = nxt; buf ^= 1;
    }
}
__device__ __forceinline__ void attn_unit_nsa(const P& p, LAS unsigned char* lds, int b, int tb, const int tid) {
    static_assert(S == 2048, "NSA unit: 32 selection blocks, 128 compressed keys");
    const int lane = tid & 63, wave = __builtin_amdgcn_readfirstlane(tid >> 6), r32 = lane & 31, hi = lane >> 5;
    const int tok0 = tb * 64 + wave * 8, t = tok0 + (r32 >> 2), hd = r32 & 3;
    const size_t rowg = (size_t)b * S + t;
    const float sl2 = LOG2E * (hd == 0 ? 0.25f : hd == 1 ? 0.0625f : hd == 2 ? 0.015625f : 0.00390625f);
    bf16x8 qr[4];
#pragma unroll
    for (int d0 = 0; d0 < 4; ++d0) qr[d0] = *(const bf16x8*)(WSP(bf16_t, OFF_NQ) + rowg * 256 + hd * 64 + d0 * 16 + hi * 8);
    const float* ng = WSP(float, OFF_NG) + rowg * 16 + hd * 3;
    const float g0 = 1.0f / (1.0f + __expf(-ng[0])), g1 = 1.0f / (1.0f + __expf(-ng[1])), g2 = 1.0f / (1.0f + __expf(-ng[2]));
    LAS float* wsf = (LAS float*)(lds + AT_WS + wave * AT_WSB); LAS float* Gs = wsf + 32; LAS float* Lx = wsf + 32 + 256; LAS unsigned* msk = (LAS unsigned*)(wsf + 32 + 256 + 8 * 33);
    LAS unsigned* umask = (LAS unsigned*)(lds + AT_MISC + 64);
    LAS float* img = (LAS float*)(lds + AT_OST + wave * AT_OSTB);
    f32x16 o[2];
#pragma unroll
    for (int r = 0; r < 16; ++r) { o[0][r] = 0.f; o[1][r] = 0.f; }
    const int nmax = t >= 31 ? (t - 31) >> 4 : -1;
    const bool two = tb >= 16;
    const bf16_t* KCg = WSP(bf16_t, OFF_KCC) + (size_t)b * CMPP * 64; const bf16_t* VCg = WSP(bf16_t, OFF_VCC) + (size_t)b * CMPP * 64;
    { TileRegs<64> R; tile_load<64, false>(R, KCg, 64, VCg, 64, nullptr, 0, tid); tile_store<64, false>(R, lds, 0, tid);
      if (two) { tile_load<64, false>(R, KCg, 64, VCg, 64, nullptr, 1, tid); tile_store<64, false>(R, lds, 1, tid); } }
    for (int i = lane; i < 256 + 8 * 33; i += 64) Gs[i] = 0.f;
    __syncthreads();
    float mc = AT_NEG, lc = 0.f;
    { f32x16 p0, p1; tile_scores<64>(lds, 0, qr, p0, p1, lane); tile_bias_mask<AM_CMP>(lds, 0, p0, p1, lane, 0, nmax, 16.f * sl2, true, true); tile_softmax_pv(lds, 0, p0, p1, o, mc, lc, wsf, lane); }
    if (two) { f32x16 p0, p1; tile_scores<64>(lds, 1, qr, p0, p1, lane); tile_bias_mask<AM_CMP>(lds, 1, p0, p1, lane, 64, nmax, 16.f * sl2, true, true); tile_softmax_pv(lds, 1, p0, p1, o, mc, lc, wsf, lane); }
    const float lct = xhalf_sum(lc); const float invc = (t >= 31) ? 1.0f / lct : 0.f;
    rows_accum_lds<true>(o, g0 * invc, wsf, img, lane);
#pragma unroll
    for (int tau = 0; tau < 2; ++tau) {
        if (tau == 1 && !two) break;
        f32x16 p0, p1; tile_scores<64>(lds, tau, qr, p0, p1, lane); tile_bias_mask<AM_CMP>(lds, tau, p0, p1, lane, 64 * tau, nmax, 16.f * sl2, true, true);
#pragma unroll
        for (int half = 0; half < 2; ++half)
#pragma unroll
            for (int i = 0; i < 4; ++i) { float e[4];
#pragma unroll
                for (int j = 0; j < 4; ++j) e[j] = __builtin_amdgcn_exp2f((half ? p1[4 * i + j] : p0[4 * i + j]) - mc) * invc;
                float gsum = (e[0] + e[1]) + (e[2] + e[3]), last = e[3];
                gsum += __shfl_xor(gsum, 1); gsum += __shfl_xor(gsum, 2); last += __shfl_xor(last, 1); last += __shfl_xor(last, 2);
                const int j = 16 * tau + 8 * half + 2 * i + hi;
                if (hd == 0) { Gs[(r32 >> 2) * 32 + j] = gsum; Lx[(r32 >> 2) * 33 + j + 1] = last; } }
    }
    { const int tl = lane >> 3, jq = lane & 7, tt = tok0 + tl, cur = tt >> 6; float mine[4]; int rank[4] = {0, 0, 0, 0};
#pragma unroll
      for (int c = 0; c < 4; ++c) { const int j = 4 * jq + c; float v = Gs[tl * 32 + j] + Lx[tl * 33 + j];
          v = (j == 0 || j == cur || j == cur - 1) ? 1.0e4f : (j > cur ? -1.0f : v); mine[c] = v; }
#pragma nounroll
      for (int k = 0; k < 32; ++k) { float u = Gs[tl * 32 + k] + Lx[tl * 33 + k]; u = (k == 0 || k == cur || k == cur - 1) ? 1.0e4f : (k > cur ? -1.0f : u);
#pragma unroll
          for (int c = 0; c < 4; ++c) rank[c] += (u > mine[c] || (u == mine[c] && k < 4 * jq + c)) ? 1 : 0; }
      unsigned bits = 0u;
#pragma unroll
      for (int c = 0; c < 4; ++c) bits |= (rank[c] < 8 ? 1u : 0u) << (4 * jq + c);
      bits |= __shfl_xor(bits, 1); bits |= __shfl_xor(bits, 2); bits |= __shfl_xor(bits, 4);
      if (jq == 0) msk[tl] = bits;
      unsigned ub = bits; ub |= __shfl_xor(ub, 8); ub |= __shfl_xor(ub, 16); ub |= __shfl_xor(ub, 32);
      if (lane == 0) umask[wave] = ub; }
    const unsigned selmask = msk[r32 >> 2];
    __syncthreads();
    unsigned U = 0u;
#pragma unroll
    for (int w = 0; w < 8; ++w) U |= umask[w];
    U &= (tb == 31) ? 0xffffffffu : ((2u << tb) - 1u);
    U = __builtin_amdgcn_readfirstlane(U);
    { float ms = AT_NEG, ls = 0.f;
#pragma unroll
      for (int r = 0; r < 16; ++r) { o[0][r] = 0.f; o[1][r] = 0.f; }
      nsa_branch_tiles<AM_SEL>(p, lds, WSP(bf16_t, OFF_KS) + (size_t)b * S * 64, WSP(bf16_t, OFF_VS) + (size_t)b * S * 64, U, qr, o, ms, ls, wsf, lane, tid, t, sl2, selmask);
      rows_accum_lds<false>(o, g1 / xhalf_sum(ls), wsf, img, lane); }
    { float mw = AT_NEG, lw = 0.f;
#pragma unroll
      for (int r = 0; r < 16; ++r) { o[0][r] = 0.f; o[1][r] = 0.f; }
      const int lo = tb >= 4 ? tb - 4 : 0; const unsigned W = ((tb == 31) ? 0xffffffffu : ((2u << tb) - 1u)) & ~((1u << lo) - 1u);
      nsa_branch_tiles<AM_WIN>(p, lds, WSP(bf16_t, OFF_KW) + (size_t)b * S * 64, WSP(bf16_t, OFF_VW) + (size_t)b * S * 64, W, qr, o, mw, lw, wsf, lane, tid, t, sl2, 0xffffffffu);
      rows_accum_lds<false>(o, g2 / xhalf_sum(lw), wsf, img, lane); }
    out_store_img(img, WSP(bf16_t, OFF_MIX) + (size_t)(b * S + tok0) * MIXW + 768, lane);
}

__device__ __forceinline__ int att_unit_cost(int id) {
    const int type = id >> 16, qb = id & 31;
    if (type == 0) return 4 * (qb + 1) * 20; if (type == 1) return 4 * (qb + 1) * 16;
    return ((qb >= 16 ? 4 : 2) + (qb + 1) + (qb < 4 ? qb + 1 : 5)) * 16 + 24;
}
__device__ __forceinline__ int att_unit_id(int i) {
    if (i < NB * 6 * 8) { const int qb = i & 7, h = (i >> 3) % 6, b = i / 48; return (0 << 16) | (b << 8) | (h << 5) | qb; }
    i -= NB * 6 * 8;
    if (i < NB * 6 * 8) { const int qb = i & 7, h = (i >> 3) % 6, b = i / 48; return (1 << 16) | (b << 8) | (h << 5) | qb; }
    i -= NB * 6 * 8; return (2 << 16) | ((i >> 5) << 8) | (i & 31);
}
__device__ __forceinline__ void build_att_list(const P& p, int gw, int ngw, int lane) {
    int* list = WSP(int, OFF_ATTLIST);
    for (int i = gw; i < N_ATT_UNITS; i += ngw) { const int id = att_unit_id(i), c = att_unit_cost(id); int rank = 0;
        for (int k = lane; k < N_ATT_UNITS; k += 64) { const int ck = att_unit_cost(att_unit_id(k)); rank += (ck > c || (ck == c && k < i)) ? 1 : 0; }
#pragma unroll
        for (int o = 1; o < 64; o <<= 1) rank += __shfl_xor(rank, o);
        if (lane == 0) list[rank] = id; }
}
__device__ __forceinline__ void op_attn(const P& p, int layer, LAS unsigned char* lds, const int tid0) {
    const int* list = WSP(int, OFF_ATTLIST); unsigned* qhead = WSP(unsigned, OFF_CTL) + CW_QHEAD + 64 * layer; LAS int* slot = (LAS int*)(lds + AT_MISC);
    for (;;) {
        if (tid0 == 0) *slot = (int)__hip_atomic_fetch_add(qhead, 1u, __ATOMIC_RELAXED, __HIP_MEMORY_SCOPE_AGENT);
        __syncthreads();
        const int idx = __builtin_amdgcn_readfirstlane(*slot);
        __syncthreads();
        if (idx >= N_ATT_UNITS) break;
        const int id = __builtin_amdgcn_readfirstlane(list[idx]); const int type = id >> 16, b = (id >> 8) & 255, h = (id >> 5) & 7, qb = id & 31;
        int tidv = tid0; asm volatile("" : "+v"(tidv));
        if (type == 0) attn_unit_causal<96, AM_MLA>(p, lds, b, h, qb, tidv);
        else if (type == 1) attn_unit_causal<64, AM_FOX>(p, lds, b, h, qb, tidv);
        else attn_unit_nsa(p, lds, b, qb, tidv);
        __syncthreads();
    }
}

__device__ __forceinline__ void op_fox_scan(const P& p, int layer, int tid) {
    static_assert(S == 2048, "op_fox_scan: 32 steps per lane");
    const int lane = tid & 63, gw = (int)(gridDim.x * 8 - 1) - (int)(blockIdx.x * 8 + (tid >> 6));
    if (gw >= NB * 6) return;
    const int b = gw / 6, h = gw % 6; const float bias = p.b_forget[layer * 6 + h];
    const float* fl = WSP(float, OFF_FL) + ((size_t)b * S + 32 * lane) * 8 + h; float* fc = WSP(float, OFF_FC) + ((size_t)b * 6 + h) * S + 32 * lane;
    float ls[32]; float run = 0.f;
#pragma unroll
    for (int i = 0; i < 32; ++i) { const float xv = fl[i * 8] + bias; ls[i] = fminf(xv, 0.f) - log1pf(__expf(-fabsf(xv))); run += ls[i]; }
    float inc = run;
#pragma unroll
    for (int o = 1; o < 64; o <<= 1) { const float v = __shfl_up(inc, o); if (lane >= o) inc += v; }
    float c = inc - run;
#pragma unroll
    for (int i = 0; i < 32; ++i) { c += ls[i]; fc[i] = c * LOG2E; }
}
__device__ __forceinline__ void op_compress(const P& p, int layer, LAS unsigned char* lds, int tid) {
    const int lane = tid & 63, wave = __builtin_amdgcn_readfirstlane(tid >> 6), r32 = lane & 31, hi = lane >> 5, wc = wave & 3, kh = wave >> 2;
    LAS float* part = (LAS float*)lds;
    LAS bf16_t* hids = (LAS bf16_t*)(lds + 32 * 132 * 4);
    for (int u = blockIdx.x; u < 2 * (NB * CMPP / 32); u += gridDim.x) {
        const int wch = u & 1, rt = u >> 1;
        const bf16_t* A = WSP(bf16_t, wch ? OFF_VCR : OFF_KCR) + (size_t)(32 * rt + r32) * 1024 + kh * 1024 + hi * 8;
        const bf16_t* B = WSP(bf16_t, OFF_W_C1) + ((size_t)(layer * 2 + wch) * 128 + 32 * wc + r32) * 2048 + kh * 1024 + hi * 8;
        f32x16 acc;
#pragma unroll
        for (int r = 0; r < 16; ++r) acc[r] = 0.f;
#pragma unroll 8
        for (int ks = 0; ks < 64; ++ks) { const bf16x8 a = *(const bf16x8*)(A + ks * 16), bb = *(const bf16x8*)(B + ks * 16); acc = __builtin_amdgcn_mfma_f32_32x32x16_bf16(a, bb, acc, 0, 0, 0); }
        if (kh == 1) {
#pragma unroll
            for (int r = 0; r < 16; ++r) part[(crow_c(r) + 4 * hi) * 132 + 32 * wc + r32] = acc[r]; }
        __syncthreads();
        if (kh == 0) { const float cb = WSP(float, OFF_CBIAS)[(layer * 2 + wch) * 128 + 32 * wc + r32];
#pragma unroll
            for (int r = 0; r < 16; ++r) { const int row = crow_c(r) + 4 * hi; const float v = acc[r] + part[row * 132 + 32 * wc + r32] + cb;
                hids[row * 136 + 32 * wc + r32] = (bf16_t)(pk2(v * __builtin_amdgcn_rcpf(1.0f + __expf(-v)), 0.f) & 0xffffu); } }
        __syncthreads();
        if (wave < 2) {
            const bf16_t* W2 = WSP(bf16_t, OFF_W_C2) + ((size_t)(layer * 2 + wch) * 64 + 32 * wave + r32) * 128 + hi * 8;
            f32x16 o2;
#pragma unroll
            for (int r = 0; r < 16; ++r) o2[r] = 0.f;
#pragma unroll
            for (int ks = 0; ks < 8; ++ks) { const bf16x8 a = *(LAS const bf16x8*)(hids + r32 * 136 + ks * 16 + hi * 8), bb = *(const bf16x8*)(W2 + ks * 16); o2 = __builtin_amdgcn_mfma_f32_32x32x16_bf16(a, bb, o2, 0, 0, 0); }
            bf16_t* dst = WSP(bf16_t, wch ? OFF_VCC : OFF_KCC) + (size_t)(32 * rt) * 64 + 32 * wave + r32;
#pragma unroll
            for (int r = 0; r < 16; ++r) dst[(crow_c(r) + 4 * hi) * 64] = (bf16_t)(pk2(o2[r], 0.f) & 0xffffu);
        }
        __syncthreads();
    }
}

#define TIDV(t) int t = threadIdx.x; asm volatile("" : "+v"(t))
template <int LAYER> __device__ __forceinline__ void mega_layer(const P& p, LAS unsigned char* lds, const XcdBarrier& bar) {
    { TIDV(t); op_inproj(p, LAYER, lds, t); } xcd_barrier(bar);
    { TIDV(t); op_compress(p, LAYER, lds, t); op_fox_scan(p, LAYER, t); }
    { TIDV(t); op_mla_qup(p, LAYER, lds, t); }
    { TIDV(t); op_mla_kvup(p, LAYER, lds, t); } xcd_barrier(bar);
    { TIDV(t); op_attn(p, LAYER, lds, t); } xcd_barrier(bar);
    { TIDV(t); op_wout(p, LAYER, lds, t); } xcd_barrier(bar);
    if (LAYER == 0) {
        { TIDV(t); op_ln(p, p.ln1g + LAYER * D, p.ln1b + LAYER * D, t); } xcd_barrier(bar);
        { TIDV(t); op_ffn_up(p, lds, t); } xcd_barrier(bar);
        { TIDV(t); op_ffn_down(p, lds, t); } xcd_barrier(bar);
        { TIDV(t); op_ln(p, p.ln2g + LAYER * D, p.ln2b + LAYER * D, t); } xcd_barrier(bar);
    } else {
        { TIDV(t); op_ln_router(p, p.ln1g + LAYER * D, p.ln1b + LAYER * D, lds, t); } xcd_barrier(bar);
        { TIDV(t); op_moe_scatter(p, t); } xcd_barrier(bar);
        { TIDV(t); op_moe_up(p, lds, t); } xcd_barrier(bar);
        { TIDV(t); op_moe_down(p, lds, t); } xcd_barrier(bar);
        { TIDV(t); op_ln_moe(p, p.ln2g + LAYER * D, p.ln2b + LAYER * D, t); }
    }
}
__global__ void __launch_bounds__(OPT_THREADS, 2) mega(P p) {
    extern __shared__ __attribute__((aligned(16))) unsigned char smem[];
    LAS unsigned char* lds = (LAS unsigned char*)smem;
    volatile LAS unsigned* xbw = (volatile LAS unsigned*)(lds + LDS_BYTES - 64);
    if (threadIdx.x < 4) xbw[threadIdx.x] = 0u;
    __syncthreads();
    XcdBarrier bar = xcd_barrier_post((unsigned*)(p.ws + OFF_CTL), xbw);
    { TIDV(t); op_prologue(p, lds, t); } xcd_barrier(bar);
    mega_layer<0>(p, lds, bar);
    mega_layer<1>(p, lds, bar);
}

extern "C" void kernel_launch(void* const* d_in, const int* in_sizes, int n_in, void* d_out, int out_size, void* d_ws, size_t ws_size, hipStream_t stream) {
    P p{};
    const float** pp = (const float**)&p;
    for (int i = 0; i < 25; ++i) pp[i] = (const float*)d_in[i];
    p.out = (float*)d_out; p.ws = (unsigned char*)d_ws;
    if (ws_size < WS_NEEDED) return;
    static int grid = 0;
    if (!grid) {
        int dev = 0, cus = 0, per_cu = 0;
        (void)hipGetDevice(&dev);
        (void)hipDeviceGetAttribute(&cus, hipDeviceAttributeMultiprocessorCount, dev);
        (void)hipFuncSetAttribute((const void*)mega, hipFuncAttributeMaxDynamicSharedMemorySize, LDS_BYTES);
        (void)hipOccupancyMaxActiveBlocksPerMultiprocessor(&per_cu, (const void*)mega, OPT_THREADS, LDS_BYTES);
        (void)hipGetLastError();
        grid = (per_cu >= 1) ? cus : -1;
    }
    if (grid <= 0) return;
    (void)hipMemsetAsync(d_ws, 0, 65536, stream);
    mega<<<grid, OPT_THREADS, LDS_BYTES, stream>>>(p);
}
#endif
```

```cpp
#ifndef HOST_TEST
#include <hip/hip_runtime.h>
#define HD __host__ __device__ __forceinline__
#else
#include <cmath>
#include <cstdint>
#include <cstring>
#include <cstdio>
#define HD inline
#endif
#include <stdint.h>

#ifndef CFG_D
#define CFG_D 1024
#define CFG_B 16
#define CFG_S 2048
#define CFG_DFF 2816
#define CFG_DFE 1408
#endif
constexpr int D = CFG_D, NB = CFG_B, S = CFG_S, M = NB * S, DFF = CFG_DFF, DFE = CFG_DFE;
constexpr int NE = 8, MIXW = 1024, IN_COLS = 2482, NBLK = S / 64, NCMP = (S - 32) / 16 + 1;
constexpr int CMPP = S / 16;
constexpr int ZC_CQ = 0, ZC_CKV = 384, ZC_KR = 640, ZC_FOX = 672, ZC_FF = 1824, ZC_NQ = 1830, ZC_KC = 2086, ZC_VC = 2150, ZC_KS = 2214, ZC_VS = 2278, ZC_KW = 2342, ZC_VW = 2406, ZC_NG = 2470;
constexpr float LOG2E = 1.4426950408889634f;
constexpr float MLA_QS = 0.10206207261596575f * LOG2E;
constexpr float HD_QS = 0.125f * LOG2E;
constexpr float ALPHA = 1.4142135623730951f;
constexpr float EPS = 1e-5f;
typedef uint16_t bf16_t;
struct alignas(16) U4 { uint32_t x, y, z, w; };

constexpr size_t al256(size_t x) { return (x + 255) & ~(size_t)255; }
constexpr int NPAD_IN = 2560;
constexpr int ROWS_PAD = 2 * M + NE * 256;
constexpr size_t OFF_CTL = 0;
constexpr size_t OFF_SSQ = 65536;
constexpr size_t OFF_ROPE = OFF_SSQ + al256((size_t)M * 20 * 4);
constexpr size_t OFF_CBIAS = OFF_ROPE + al256((size_t)S * 32 * 4);
constexpr size_t OFF_EIDX = OFF_CBIAS + al256(2 * 2 * 128 * 4);
constexpr size_t OFF_EGATE = OFF_EIDX + al256((size_t)M * 2 * 4);
constexpr size_t OFF_TOKSLOT = OFF_EGATE + al256((size_t)M * 2 * 4);
constexpr size_t OFF_GATES = OFF_TOKSLOT + al256((size_t)M * 2 * 4);
constexpr size_t OFF_ATTLIST = OFF_GATES + al256((size_t)ROWS_PAD * 4);
constexpr size_t OFF_W_IN = OFF_ATTLIST + al256(4096 * 4);
constexpr size_t OFF_W_UQ = OFF_W_IN + al256((size_t)2 * NPAD_IN * D * 2);
constexpr size_t OFF_W_UKV = OFF_W_UQ + al256((size_t)2 * 768 * 384 * 2);
constexpr size_t OFF_W_C1 = OFF_W_UKV + al256((size_t)2 * 768 * 256 * 2);
constexpr size_t OFF_W_C2 = OFF_W_C1 + al256((size_t)2 * 2 * 128 * 2048 * 2);
constexpr size_t OFF_W_OUT = OFF_W_C2 + al256((size_t)2 * 2 * 64 * 128 * 2);
constexpr size_t OFF_W_F13 = OFF_W_OUT + al256((size_t)2 * D * MIXW * 2);
constexpr size_t OFF_W_F2 = OFF_W_F13 + al256((size_t)2 * DFF * D * 2);
constexpr size_t OFF_W_M13 = OFF_W_F2 + al256((size_t)D * DFF * 2);
constexpr size_t OFF_W_M2 = OFF_W_M13 + al256((size_t)NE * 2 * DFE * D * 2);
constexpr size_t OFF_BIG = OFF_W_M2 + al256((size_t)NE * D * DFE * 2);
constexpr size_t OFF_XB = OFF_BIG;
constexpr size_t OFF_MIX = OFF_XB + al256((size_t)M * D * 2);
constexpr size_t OFF_ARENA = OFF_MIX + al256((size_t)M * MIXW * 2);
constexpr size_t OFF_CQ = OFF_ARENA;
constexpr size_t OFF_CKV = OFF_CQ + al256((size_t)M * 384 * 2);
constexpr size_t OFF_RQ = OFF_CKV + al256((size_t)M * 256 * 2);
constexpr size_t OFF_RKV = OFF_RQ + al256((size_t)M * 4);
constexpr size_t OFF_QM = OFF_RKV + al256((size_t)M * 4);
constexpr size_t OFF_KM = OFF_QM + al256((size_t)M * 576 * 2);
constexpr size_t OFF_VM = OFF_KM + al256((size_t)M * 576 * 2);
constexpr size_t OFF_FQ = OFF_VM + al256((size_t)M * 384 * 2);
constexpr size_t OFF_FK = OFF_FQ + al256((size_t)M * 384 * 2);
constexpr size_t OFF_FV = OFF_FK + al256((size_t)M * 384 * 2);
constexpr size_t OFF_FL = OFF_FV + al256((size_t)M * 384 * 2);
constexpr size_t OFF_FC = OFF_FL + al256((size_t)M * 8 * 4);
constexpr size_t OFF_NQ = OFF_FC + al256((size_t)NB * 6 * S * 4);
constexpr size_t OFF_KCR = OFF_NQ + al256((size_t)M * 256 * 2);
constexpr size_t OFF_VCR = OFF_KCR + al256((size_t)(M * 64 + 2048) * 2);
constexpr size_t OFF_KS = OFF_VCR + al256((size_t)(M * 64 + 2048) * 2);
constexpr size_t OFF_VS = OFF_KS + al256((size_t)M * 64 * 2);
constexpr size_t OFF_KW = OFF_VS + al256((size_t)M * 64 * 2);
constexpr size_t OFF_VW = OFF_KW + al256((size_t)M * 64 * 2);
constexpr size_t OFF_NG = OFF_VW + al256((size_t)M * 64 * 2);
constexpr size_t OFF_HID = OFF_NG + al256((size_t)M * 16 * 4);
constexpr size_t OFF_KCC = OFF_HID + al256((size_t)2 * NB * CMPP * 128 * 4);
constexpr size_t OFF_VCC = OFF_KCC + al256((size_t)NB * CMPP * 64 * 2);
constexpr size_t OFF_CST = OFF_VCC + al256((size_t)NB * CMPP * 64 * 2);
constexpr size_t OFF_IMP = OFF_CST + al256((size_t)M * 8 * 4);
constexpr size_t OFF_SEL = OFF_IMP + al256((size_t)M * 32 * 4);
constexpr size_t OFF_ATT_END = OFF_SEL + al256((size_t)M * 4);
constexpr size_t OFF_H = OFF_ARENA;
constexpr size_t OFF_H2 = OFF_ARENA;
constexpr size_t OFF_HE = OFF_MIX;
constexpr size_t OFF_XS = OFF_HE + al256((size_t)ROWS_PAD * DFE * 2);
constexpr size_t OFF_MOE_END = OFF_XS + al256((size_t)ROWS_PAD * D * 2);
constexpr size_t cmax(size_t a, size_t b) { return a > b ? a : b; }
constexpr size_t WS_NEEDED = cmax(cmax(OFF_ATT_END, OFF_MOE_END), cmax(OFF_H + (size_t)M * DFF * 2, OFF_H2 + (size_t)M * 2 * DFE * 2));
#if CFG_D == 1024
static_assert(WS_NEEDED <= (size_t)512 * 1024 * 1024, "workspace fits in 4 x the largest tensor");
#endif

struct P {
    const float *x, *w_in, *b_forget, *g_cq, *w_uq, *g_ckv, *w_ukv, *ckp, *ckw1, *ckw2, *cvp, *cvw1, *cvw2, *w_out, *ln1g, *ln1b, *ln2g, *ln2b, *fw1, *fw3, *fw2, *rw, *mw1, *mw3, *mw2;
    float* out; unsigned char* ws;
};
#define WSP(T, off) ((T*)(p.ws + (off)))

HD float u2f(uint32_t u) { return __builtin_bit_cast(float, u); }
HD uint32_t f2u(float f) { return __builtin_bit_cast(uint32_t, f); }
HD float bf2f(bf16_t v) { return u2f((uint32_t)v << 16); }
HD bf16_t f2bf(float f) { uint32_t u = f2u(f); return (bf16_t)((u + 0x7fffu + ((u >> 16) & 1u)) >> 16); }
HD float bflo(uint32_t u) { return u2f(u << 16); }
HD float bfhi(uint32_t u) { return u2f(u & 0xffff0000u); }
HD float sigmoidf_(float x) { return 1.0f / (1.0f + expf(-x)); }
HD float siluf_(float x) { return x / (1.0f + expf(-x)); }
HD float dot8(const U4& a, const float* w) { return bflo(a.x) * w[0] + bfhi(a.x) * w[1] + bflo(a.y) * w[2] + bfhi(a.y) * w[3] + bflo(a.z) * w[4] + bfhi(a.z) * w[5] + bflo(a.w) * w[6] + bfhi(a.w) * w[7]; }
HD void unpack8(const U4& a, float* w) { w[0] = bflo(a.x); w[1] = bfhi(a.x); w[2] = bflo(a.y); w[3] = bfhi(a.y); w[4] = bflo(a.z); w[5] = bfhi(a.z); w[6] = bflo(a.w); w[7] = bfhi(a.w); }
HD void rope_cs(int pos, int i, float& c, float& s) {
    const float fr = exp2f(-(float)i * 0.830482023721841f);
    double a = (double)pos * (double)fr; a -= 6.283185307179586 * floor(a * 0.15915494309189535);
#ifdef HOST_TEST
    c = (float)cos(a); s = (float)sin(a);
#else
    c = __cosf((float)a); s = __sinf((float)a);
#endif
}

template <int RG> HD void dot_rows(const bf16_t* A, long lda, const float* W, long ldw, int K, const float* gk, float (&acc)[RG]) {
#pragma unroll
    for (int r = 0; r < RG; ++r) acc[r] = 0.f;
    for (int k = 0; k < K; k += 8) {
        float w[8];
#pragma unroll
        for (int j = 0; j < 8; ++j) w[j] = W[(long)(k + j) * ldw] * (gk ? gk[k + j] : 1.f);
#pragma unroll
        for (int r = 0; r < RG; ++r) { const U4 a = *(const U4*)(A + r * lda + k); acc[r] += dot8(a, w); }
    }
}
constexpr int RG = 8;

HD void nv_prologue(const P& p, long gtid, long gn) {
    bf16_t* xb = WSP(bf16_t, OFF_XB);
    for (long i = gtid; i < (long)M * D; i += gn) xb[i] = f2bf(p.x[i]);
    bf16_t* kcr = WSP(bf16_t, OFF_KCR); bf16_t* vcr = WSP(bf16_t, OFF_VCR);
    for (long i = gtid; i < 2048; i += gn) { kcr[(long)M * 64 + i] = 0; vcr[(long)M * 64 + i] = 0; }
}

HD void store_z(const P& p, long row, int col, float v) {
    if (col < ZC_CKV) WSP(bf16_t, OFF_CQ)[row * 384 + col] = f2bf(v);
    else if (col < ZC_KR) WSP(bf16_t, OFF_CKV)[row * 256 + (col - ZC_CKV)] = f2bf(v);
    else if (col < ZC_FOX) {   }
    else if (col < ZC_FF) { const int c = col - ZC_FOX, which = c / 384, hd = c % 384;
        if (which == 0) WSP(bf16_t, OFF_FQ)[row * 384 + hd] = f2bf(v * HD_QS);
        else if (which == 1) WSP(bf16_t, OFF_FK)[row * 384 + hd] = f2bf(v);
        else WSP(bf16_t, OFF_FV)[row * 384 + hd] = f2bf(v); }
    else if (col < ZC_NQ) WSP(float, OFF_FL)[row * 8 + (col - ZC_FF)] = v;
    else if (col < ZC_KC) WSP(bf16_t, OFF_NQ)[row * 256 + (col - ZC_NQ)] = f2bf(v * HD_QS);
    else if (col < ZC_VC) WSP(bf16_t, OFF_KCR)[row * 64 + (col - ZC_KC)] = f2bf(v);
    else if (col < ZC_KS) WSP(bf16_t, OFF_VCR)[row * 64 + (col - ZC_VC)] = f2bf(v);
    else if (col < ZC_VS) WSP(bf16_t, OFF_KS)[row * 64 + (col - ZC_KS)] = f2bf(v);
    else if (col < ZC_KW) WSP(bf16_t, OFF_VS)[row * 64 + (col - ZC_VS)] = f2bf(v);
    else if (col < ZC_VW) WSP(bf16_t, OFF_KW)[row * 64 + (col - ZC_KW)] = f2bf(v);
    else if (col < ZC_NG) WSP(bf16_t, OFF_VW)[row * 64 + (col - ZC_VW)] = f2bf(v);
    else WSP(float, OFF_NG)[row * 16 + (col - ZC_NG)] = v;
}

HD void nv_inproj(const P& p, int layer, long gtid, long gn) {
    const bf16_t* xb = WSP(bf16_t, OFF_XB); const float* w = p.w_in + (size_t)layer * D * IN_COLS;
    for (long it = gtid; it < (long)(M / RG) * IN_COLS; it += gn) {
        const long rg = it / IN_COLS; const int col = (int)(it % IN_COLS); const long r0 = rg * RG;
        if (col >= ZC_KR + 16 && col < ZC_FOX) continue;
        float acc[RG]; dot_rows<RG>(xb + r0 * D, D, w + col, IN_COLS, D, nullptr, acc);
        if (col >= ZC_KR && col < ZC_KR + 16) {
            float acc2[RG]; dot_rows<RG>(xb + r0 * D, D, w + col + 16, IN_COLS, D, nullptr, acc2);
            const int i = col - ZC_KR;
#pragma unroll
            for (int r = 0; r < RG; ++r) { const long row = r0 + r; float c, s; rope_cs((int)(row % S), i, c, s);
                const bf16_t o1 = f2bf(acc[r] * c - acc2[r] * s), o2 = f2bf(acc2[r] * c + acc[r] * s);
                bf16_t* km = WSP(bf16_t, OFF_KM) + row * 576;
                for (int h = 0; h < 6; ++h) { km[h * 96 + 64 + i] = o1; km[h * 96 + 80 + i] = o2; } }
        } else {
#pragma unroll
            for (int r = 0; r < RG; ++r) store_z(p, r0 + r, col, acc[r]);
        }
    }
}

HD void nv_post1(const P& p, int layer, long gtid, long gn) {
    for (long row = gtid; row < M; row += gn) {
        const bf16_t* cq = WSP(bf16_t, OFF_CQ) + row * 384; const bf16_t* ckv = WSP(bf16_t, OFF_CKV) + row * 256;
        float s1 = 0.f, s2 = 0.f;
        for (int k = 0; k < 384; ++k) { const float v = bf2f(cq[k]); s1 += v * v; }
        for (int k = 0; k < 256; ++k) { const float v = bf2f(ckv[k]); s2 += v * v; }
        WSP(float, OFF_RQ)[row] = 1.0f / sqrtf(s1 / 384.f + EPS); WSP(float, OFF_RKV)[row] = 1.0f / sqrtf(s2 / 256.f + EPS);
    }
    for (long it = gtid; it < NB * 6; it += gn) {
        const int b = (int)(it / 6), h = (int)(it % 6); const float bias = p.b_forget[layer * 6 + h];
        const float* fl = WSP(float, OFF_FL) + (long)b * S * 8 + h; float* fc = WSP(float, OFF_FC) + ((long)b * 6 + h) * S;
        float c = 0.f;
        for (int t = 0; t < S; ++t) { const float xv = fl[(long)t * 8] + bias;
            const float ls = fminf(xv, 0.f) - log1pf(expf(-fabsf(xv)));
            c += ls; fc[t] = c * LOG2E; }
    }
}

HD void nv_qup(const P& p, int layer, long gtid, long gn) {
    { const bf16_t* cq = WSP(bf16_t, OFF_CQ); const float* w = p.w_uq + (size_t)layer * 384 * 576; const float* g = p.g_cq + layer * 384; const float* rq = WSP(float, OFF_RQ);
      bf16_t* qm = WSP(bf16_t, OFF_QM);
      for (long it = gtid; it < (long)(M / RG) * 480; it += gn) {
          const long rg = it / 480; const int j = (int)(it % 480), h = j / 80, c = j % 80; const long r0 = rg * RG;
          if (c < 64) { float acc[RG]; dot_rows<RG>(cq + r0 * 384, 384, w + h * 96 + c, 576, 384, g, acc);
#pragma unroll
              for (int r = 0; r < RG; ++r) qm[(r0 + r) * 576 + h * 96 + c] = f2bf(acc[r] * rq[r0 + r] * MLA_QS);
          } else { const int i = c - 64; float a1[RG], a2[RG];
              dot_rows<RG>(cq + r0 * 384, 384, w + h * 96 + 64 + i, 576, 384, g, a1); dot_rows<RG>(cq + r0 * 384, 384, w + h * 96 + 80 + i, 576, 384, g, a2);
#pragma unroll
              for (int r = 0; r < RG; ++r) { const long row = r0 + r; float cs, sn; rope_cs((int)(row % S), i, cs, sn); const float x1 = a1[r] * rq[row], x2 = a2[r] * rq[row];
                  qm[row * 576 + h * 96 + 64 + i] = f2bf((x1 * cs - x2 * sn) * MLA_QS); qm[row * 576 + h * 96 + 80 + i] = f2bf((x2 * cs + x1 * sn) * MLA_QS); } }
      } }
}
HD void nv_kvup(const P& p, int layer, long gtid, long gn) {
    { const bf16_t* ckv = WSP(bf16_t, OFF_CKV); const float* w = p.w_ukv + (size_t)layer * 256 * 768; const float* g = p.g_ckv + layer * 256; const float* rkv = WSP(float, OFF_RKV);
      for (long it = gtid; it < (long)(M / RG) * 768; it += gn) {
          const long rg = it / 768; const int col = (int)(it % 768), h = col / 128, c = col % 128; const long r0 = rg * RG;
          float acc[RG]; dot_rows<RG>(ckv + r0 * 256, 256, w + col, 768, 256, g, acc);
#pragma unroll
          for (int r = 0; r < RG; ++r) { const float v = acc[r] * rkv[r0 + r];
              if (c < 64) WSP(bf16_t, OFF_KM)[(r0 + r) * 576 + h * 96 + c] = f2bf(v); else WSP(bf16_t, OFF_VM)[(r0 + r) * 384 + h * 64 + (c - 64)] = f2bf(v); }
      } }
}
HD void nv_cmp1(const P& p, int layer, long gtid, long gn) {
    for (long it = gtid; it < (long)2 * NB * CMPP * 128; it += gn) {
        const int j = (int)(it % 128); const long t2 = it / 128; const int n = (int)(t2 % CMPP); const long t3 = t2 / CMPP; const int b = (int)(t3 % NB), wch = (int)(t3 / NB);
        float* hid = WSP(float, OFF_HID);
        if (n >= NCMP) { hid[it] = 0.f; continue; }
        const bf16_t* T = WSP(bf16_t, wch ? OFF_VCR : OFF_KCR) + ((long)b * S + 16 * n) * 64;
        const float* pe = (wch ? p.cvp : p.ckp) + (size_t)layer * 2048; const float* w1 = (wch ? p.cvw1 : p.ckw1) + (size_t)layer * 2048 * 128 + j;
        float acc = 0.f;
        for (int k = 0; k < 2048; ++k) acc += (bf2f(T[k]) + pe[k]) * w1[(long)k * 128];
        hid[it] = siluf_(acc);
    }
}

HD void nv_cmp2(const P& p, int layer, long gtid, long gn) {
    for (long it = gtid; it < (long)2 * NB * CMPP * 64; it += gn) {
        const int d = (int)(it % 64); const long t2 = it / 64; const int n = (int)(t2 % CMPP); const long t3 = t2 / CMPP; const int b = (int)(t3 % NB), wch = (int)(t3 / NB);
        const float* hid = WSP(float, OFF_HID) + (((long)wch * NB + b) * CMPP + n) * 128; const float* w2 = (wch ? p.cvw2 : p.ckw2) + (size_t)layer * 128 * 64 + d;
        float acc = 0.f;
        for (int j = 0; j < 128; ++j) acc += hid[j] * w2[j * 64];
        WSP(bf16_t, wch ? OFF_VCC : OFF_KCC)[((long)b * CMPP + n) * 64 + d] = f2bf(acc);
    }
}

HD float slope2(int h) { return LOG2E * (h == 0 ? 0.25f : h == 1 ? 0.0625f : h == 2 ? 0.015625f : 0.00390625f); }

template <int DK> HD float qk_dot(const float (&q)[DK], const bf16_t* k) {
    float s = 0.f;
#pragma unroll
    for (int d = 0; d < DK; d += 8) { const U4 a = *(const U4*)(k + d); s += dot8(a, &q[d]); }
    return s;
}
template <int DK> HD void load_q(float (&q)[DK], const bf16_t* src) {
#pragma unroll
    for (int d = 0; d < DK; d += 8) { const U4 a = *(const U4*)(src + d); unpack8(a, &q[d]); }
}
HD void sm_step(float sc, const bf16_t* v, float& m, float& l, float (&o)[64]) {
    if (sc > m) { const float f = exp2f(m - sc); l *= f;
#pragma unroll
        for (int d = 0; d < 64; ++d) o[d] *= f;
        m = sc; }
    const float pp = exp2f(sc - m); l += pp;
#pragma unroll
    for (int d = 0; d < 64; d += 8) { const U4 a = *(const U4*)(v + d); float vv[8]; unpack8(a, vv);
#pragma unroll
        for (int j = 0; j < 8; ++j) o[d + j] += pp * vv[j]; }
}

HD void nv_nsa_a(const P& p, long gtid, long gn) {
    for (long it = gtid; it < (long)M * 4; it += gn) {
        const int t = (int)(it % S); const long t2 = it / S; const int h = (int)(t2 % 4), b = (int)(t2 / 4); const long row = (long)b * S + t;
        float q[64]; load_q<64>(q, WSP(bf16_t, OFF_NQ) + row * 256 + h * 64);
        const int nmax = t >= 31 ? ((t - 31) / 16 < NCMP - 1 ? (t - 31) / 16 : NCMP - 1) : -1; const float sl = slope2(h);
        float m = -INFINITY, l = 0.f;
        for (int n = 0; n <= nmax; ++n) { const float sc = qk_dot<64>(q, WSP(bf16_t, OFF_KCC) + ((long)b * CMPP + n) * 64) - sl * (float)(t - (16 * n + 31));
            if (sc > m) { l *= exp2f(m - sc); m = sc; } l += exp2f(sc - m); }
        float* cst = WSP(float, OFF_CST) + (row * 4 + h) * 2; cst[0] = nmax >= 0 ? m : 0.f; cst[1] = l;
    }
}
HD void nv_nsa_b(const P& p, long gtid, long gn) {
    for (long it = gtid; it < (long)M * NBLK; it += gn) {
        const int j = (int)(it % NBLK); const long row = it / NBLK; const int t = (int)(row % S), b = (int)(row / S), cur = t / 64;
        float imp;
        if (j == 0 || j == cur || j == cur - 1) imp = 1.0e4f;
        else if (64 * j > t) imp = -1.0f;
        else { imp = 0.f;
            for (int h = 0; h < 4; ++h) { float q[64]; load_q<64>(q, WSP(bf16_t, OFF_NQ) + row * 256 + h * 64); const float* cst = WSP(float, OFF_CST) + (row * 4 + h) * 2; const float m = cst[0], l = cst[1], sl = slope2(h);
                float sum = 0.f;
                for (int n = 4 * j - 1; n <= 4 * j + 3; ++n) { if (n < 0 || n >= NCMP || 16 * n + 31 > t) continue;
                    const float sc = qk_dot<64>(q, WSP(bf16_t, OFF_KCC) + ((long)b * CMPP + n) * 64) - sl * (float)(t - (16 * n + 31)); sum += exp2f(sc - m); }
                imp += sum / fmaxf(l, 1e-30f); } }
        WSP(float, OFF_IMP)[row * 32 + j] = imp;
    }
}
HD void nv_nsa_c(const P& p, long gtid, long gn) {
    for (long row = gtid; row < M; row += gn) {
        const float* imp = WSP(float, OFF_IMP) + row * 32; uint32_t mask = 0;
        for (int j = 0; j < NBLK; ++j) { const float v = imp[j]; int rank = 0;
            for (int k = 0; k < NBLK; ++k) { const float u = imp[k]; rank += (u > v || (u == v && k < j)) ? 1 : 0; }
            if (rank < 8) mask |= 1u << j; }
        WSP(uint32_t, OFF_SEL)[row] = mask;
    }
}

HD void nv_attn(const P& p, long gtid, long gn) {
    for (long it = gtid; it < (long)M * 6; it += gn) {
        const int t = (int)(it % S); const long t2 = it / S; const int h = (int)(t2 % 6), b = (int)(t2 / 6); const long row = (long)b * S + t;
        float q[96]; load_q<96>(q, WSP(bf16_t, OFF_QM) + row * 576 + h * 96);
        float o[64]; float m = -INFINITY, l = 0.f;
#pragma unroll
        for (int d = 0; d < 64; ++d) o[d] = 0.f;
        for (int s = 0; s <= t; ++s) { const long sr = (long)b * S + s; const float sc = qk_dot<96>(q, WSP(bf16_t, OFF_KM) + sr * 576 + h * 96); sm_step(sc, WSP(bf16_t, OFF_VM) + sr * 384 + h * 64, m, l, o); }
        const float il = 1.0f / l; bf16_t* dst = WSP(bf16_t, OFF_MIX) + row * MIXW + h * 64;
#pragma unroll
        for (int d = 0; d < 64; ++d) dst[d] = f2bf(o[d] * il);
    }
    for (long it = gtid; it < (long)M * 6; it += gn) {
        const int t = (int)(it % S); const long t2 = it / S; const int h = (int)(t2 % 6), b = (int)(t2 / 6); const long row = (long)b * S + t;
        float q[64]; load_q<64>(q, WSP(bf16_t, OFF_FQ) + row * 384 + h * 64);
        const float* fc = WSP(float, OFF_FC) + ((long)b * 6 + h) * S; const float ct = fc[t];
        float o[64]; float m = -INFINITY, l = 0.f;
#pragma unroll
        for (int d = 0; d < 64; ++d) o[d] = 0.f;
        for (int s = 0; s <= t; ++s) { const long sr = (long)b * S + s; const float sc = qk_dot<64>(q, WSP(bf16_t, OFF_FK) + sr * 384 + h * 64) + (ct - fc[s]); sm_step(sc, WSP(bf16_t, OFF_FV) + sr * 384 + h * 64, m, l, o); }
        const float il = 1.0f / l; bf16_t* dst = WSP(bf16_t, OFF_MIX) + row * MIXW + 384 + h * 64;
#pragma unroll
        for (int d = 0; d < 64; ++d) dst[d] = f2bf(o[d] * il);
    }
    for (long it = gtid; it < (long)M * 4; it += gn) {
        const int t = (int)(it % S); const long t2 = it / S; const int h = (int)(t2 % 4), b = (int)(t2 / 4); const long row = (long)b * S + t; const float sl = slope2(h);
        float q[64]; load_q<64>(q, WSP(bf16_t, OFF_NQ) + row * 256 + h * 64);
        const float* ng = WSP(float, OFF_NG) + row * 16 + h * 3;
        float out[64], o[64];
#pragma unroll
        for (int d = 0; d < 64; ++d) out[d] = 0.f;
        {
            const int nmax = t >= 31 ? ((t - 31) / 16 < NCMP - 1 ? (t - 31) / 16 : NCMP - 1) : -1;
            if (nmax >= 0) { float m = -INFINITY, l = 0.f;
#pragma unroll
                for (int d = 0; d < 64; ++d) o[d] = 0.f;
                for (int n = 0; n <= nmax; ++n) { const long cr = ((long)b * CMPP + n) * 64; const float sc = qk_dot<64>(q, WSP(bf16_t, OFF_KCC) + cr) - sl * (float)(t - (16 * n + 31)); sm_step(sc, WSP(bf16_t, OFF_VCC) + cr, m, l, o); }
                const float g = sigmoidf_(ng[0]) / l;
#pragma unroll
                for (int d = 0; d < 64; ++d) out[d] += g * o[d]; } }
        {
            const uint32_t mask = WSP(uint32_t, OFF_SEL)[row]; float m = -INFINITY, l = 0.f;
#pragma unroll
            for (int d = 0; d < 64; ++d) o[d] = 0.f;
            for (int j = 0; j <= t / 64; ++j) { if (!((mask >> j) & 1u)) continue;
                const int s1 = (64 * j + 63 < t) ? 64 * j + 63 : t;
                for (int s = 64 * j; s <= s1; ++s) { const long sr = ((long)b * S + s) * 64; const float sc = qk_dot<64>(q, WSP(bf16_t, OFF_KS) + sr) - sl * (float)(t - s); sm_step(sc, WSP(bf16_t, OFF_VS) + sr, m, l, o); } }
            const float g = sigmoidf_(ng[1]) / l;
#pragma unroll
            for (int d = 0; d < 64; ++d) out[d] += g * o[d]; }
        {
            float m = -INFINITY, l = 0.f;
#pragma unroll
            for (int d = 0; d < 64; ++d) o[d] = 0.f;
            for (int s = (t >= 255 ? t - 255 : 0); s <= t; ++s) { const long sr = ((long)b * S + s) * 64; const float sc = qk_dot<64>(q, WSP(bf16_t, OFF_KW) + sr) - sl * (float)(t - s); sm_step(sc, WSP(bf16_t, OFF_VW) + sr, m, l, o); }
            const float g = sigmoidf_(ng[2]) / l;
#pragma unroll
            for (int d = 0; d < 64; ++d) out[d] += g * o[d]; }
        bf16_t* dst = WSP(bf16_t, OFF_MIX) + row * MIXW + 768 + h * 64;
#pragma unroll
        for (int d = 0; d < 64; ++d) dst[d] = f2bf(out[d]);
    }
}

HD void nv_wout(const P& p, int layer, long gtid, long gn) {
    const bf16_t* mix = WSP(bf16_t, OFF_MIX); const float* w = p.w_out + (size_t)layer * MIXW * D; const float* base = layer == 0 ? p.x : p.out;
    for (long it = gtid; it < (long)(M / RG) * D; it += gn) {
        const long rg = it / D; const int col = (int)(it % D); const long r0 = rg * RG;
        float acc[RG]; dot_rows<RG>(mix + r0 * MIXW, MIXW, w + col, D, MIXW, nullptr, acc);
#pragma unroll
        for (int r = 0; r < RG; ++r) p.out[(r0 + r) * D + col] = ALPHA * base[(r0 + r) * D + col] + acc[r];
    }
}

HD void nv_ln(const P& p, const float* g, const float* bta, const float* rw, long gtid, long gn) {
    for (long row = gtid; row < M; row += gn) {
        float* xr = p.out + row * D; bf16_t* xb = WSP(bf16_t, OFF_XB) + row * D;
        float s = 0.f; for (int k = 0; k < D; ++k) s += xr[k];
        const float mu = s / D; float q = 0.f; for (int k = 0; k < D; ++k) { const float d = xr[k] - mu; q += d * d; }
        const float rs = 1.0f / sqrtf(q / D + EPS);
        float lg[NE];
#pragma unroll
        for (int e = 0; e < NE; ++e) lg[e] = 0.f;
        for (int k = 0; k < D; ++k) { const float v = (xr[k] - mu) * rs * g[k] + bta[k]; xr[k] = v; xb[k] = f2bf(v);
            if (rw) {
#pragma unroll
                for (int e = 0; e < NE; ++e) lg[e] += v * rw[k * NE + e]; } }
        if (rw) { float mx = lg[0];
#pragma unroll
            for (int e = 1; e < NE; ++e) mx = fmaxf(mx, lg[e]);
            float pr[NE]; float sum = 0.f;
#pragma unroll
            for (int e = 0; e < NE; ++e) { pr[e] = expf(lg[e] - mx); sum += pr[e]; }
            int i1 = 0; float p1 = pr[0] / sum;
#pragma unroll
            for (int e = 1; e < NE; ++e) { const float pe = pr[e] / sum; if (pe > p1) { p1 = pe; i1 = e; } }
            int i2 = -1; float p2 = -1.f;
#pragma unroll
            for (int e = 0; e < NE; ++e) { const float pe = pr[e] / sum; if (e != i1 && pe > p2) { p2 = pe; i2 = e; } }
            WSP(int, OFF_EIDX)[row * 2] = i1; WSP(int, OFF_EIDX)[row * 2 + 1] = i2;
            WSP(float, OFF_EGATE)[row * 2] = p1 / (p1 + p2); WSP(float, OFF_EGATE)[row * 2 + 1] = p2 / (p1 + p2); }
    }
}

HD void nv_ffn_up(const P& p, long gtid, long gn) {
    const bf16_t* xb = WSP(bf16_t, OFF_XB); bf16_t* hb = WSP(bf16_t, OFF_H);
    for (long it = gtid; it < (long)(M / RG) * DFF; it += gn) {
        const long rg = it / DFF; const int j = (int)(it % DFF); const long r0 = rg * RG;
        float a[RG], c[RG]; dot_rows<RG>(xb + r0 * D, D, p.fw1 + j, DFF, D, nullptr, a); dot_rows<RG>(xb + r0 * D, D, p.fw3 + j, DFF, D, nullptr, c);
#pragma unroll
        for (int r = 0; r < RG; ++r) hb[(r0 + r) * DFF + j] = f2bf(siluf_(a[r]) * c[r]);
    }
}
HD void nv_ffn_down(const P& p, long gtid, long gn) {
    const bf16_t* hb = WSP(bf16_t, OFF_H);
    for (long it = gtid; it < (long)(M / RG) * D; it += gn) {
        const long rg = it / D; const int col = (int)(it % D); const long r0 = rg * RG;
        float acc[RG]; dot_rows<RG>(hb + r0 * DFF, DFF, p.fw2 + col, D, DFF, nullptr, acc);
#pragma unroll
        for (int r = 0; r < RG; ++r) p.out[(r0 + r) * D + col] = ALPHA * p.out[(r0 + r) * D + col] + acc[r];
    }
}
HD void nv_moe_up(const P& p, long gtid, long gn) {
    const bf16_t* xb = WSP(bf16_t, OFF_XB); bf16_t* h2 = WSP(bf16_t, OFF_H2);
    for (long it = gtid; it < (long)M * 2 * DFE; it += gn) {
        const int j = (int)(it % DFE); const long rs = it / DFE; const long row = rs / 2; const int e = WSP(int, OFF_EIDX)[rs];
        float a[1], c[1]; dot_rows<1>(xb + row * D, D, p.mw1 + (size_t)e * D * DFE + j, DFE, D, nullptr, a); dot_rows<1>(xb + row * D, D, p.mw3 + (size_t)e * D * DFE + j, DFE, D, nullptr, c);
        h2[rs * DFE + j] = f2bf(siluf_(a[0]) * c[0]);
    }
}
HD void nv_moe_down(const P& p, long gtid, long gn) {
    const bf16_t* h2 = WSP(bf16_t, OFF_H2);
    for (long it = gtid; it < (long)M * D; it += gn) {
        const int col = (int)(it % D); const long row = it / D; float tot = 0.f;
        for (int sl = 0; sl < 2; ++sl) { const int e = WSP(int, OFF_EIDX)[row * 2 + sl]; float acc[1];
            dot_rows<1>(h2 + (row * 2 + sl) * DFE, DFE, p.mw2 + (size_t)e * DFE * D + col, D, DFE, nullptr, acc); tot += WSP(float, OFF_EGATE)[row * 2 + sl] * acc[0]; }
        p.out[it] = ALPHA * p.out[it] + tot;
    }
}

constexpr int N_LAYER_PHASES = 13;
HD void run_phase(const P& p, int ph, int layer, long gtid, long gn) {
    switch (ph) {
        case 0: nv_prologue(p, gtid, gn); break;
        case 1: nv_inproj(p, layer, gtid, gn); break;
        case 2: nv_post1(p, layer, gtid, gn); break;
        case 3: nv_qup(p, layer, gtid, gn); nv_kvup(p, layer, gtid, gn); nv_cmp1(p, layer, gtid, gn); break;
        case 14: nv_cmp1(p, layer, gtid, gn); break;
        case 4: nv_cmp2(p, layer, gtid, gn); break;
        case 5: nv_nsa_a(p, gtid, gn); break;
        case 6: nv_nsa_b(p, gtid, gn); break;
        case 7: nv_nsa_c(p, gtid, gn); break;
        case 8: nv_attn(p, gtid, gn); break;
        case 9: nv_wout(p, layer, gtid, gn); break;
        case 10: nv_ln(p, p.ln1g + layer * D, p.ln1b + layer * D, (layer & 1) ? p.rw : nullptr, gtid, gn); break;
        case 11: if (layer & 1) nv_moe_up(p, gtid, gn); else nv_ffn_up(p, gtid, gn); break;
        case 12: if (layer & 1) nv_moe_down(p, gtid, gn); else nv_ffn_down(p, gtid, gn); break;
        case 13: nv_ln(p, p.ln2g + layer * D, p.ln2b + layer * D, nullptr, gtid, gn); break;
    }
}

#ifndef HOST_TEST
#define XB_TMO      128
#define XB_XCNT(j)  (256  + 64 * (j))
#define XB_XSUB(j)  (1280 + 64 * (j))
#define XB_XGEN(j)  (2304 + 64 * (j))
#define XB_TOP      3328
#define XB_TOPGEN   3392
#define XCD_BAR_WORDS 3456
#define XB_SPIN_CAP (1u << 24)
#define LAS __attribute__((address_space(3)))

__device__ __forceinline__ unsigned xb_ld(unsigned* p)              { return __hip_atomic_load(p, __ATOMIC_RELAXED, __HIP_MEMORY_SCOPE_AGENT); }
__device__ __forceinline__ unsigned xb_add(unsigned* p, unsigned v) { return __hip_atomic_fetch_add(p, v, __ATOMIC_RELAXED, __HIP_MEMORY_SCOPE_AGENT); }
__device__ __forceinline__ unsigned xb_xcc_id() { return (unsigned)__builtin_amdgcn_s_getreg((3 << 11) | 20) & 0xFu; }
#define XB_SPIN(cond, bar) do { unsigned _sp = 0; while (cond) { __builtin_amdgcn_s_sleep(1); \
    if ((++_sp & 255u) == 0u) { if (xb_ld(&(bar)[XB_TMO])) break; if (_sp > XB_SPIN_CAP) { atomicAdd(&(bar)[XB_TMO], 1u); break; } } } } while (0)

struct XcdBarrier {
    unsigned* bar; unsigned x;
    volatile LAS unsigned* st;
};
__device__ __forceinline__ XcdBarrier xcd_barrier_post(unsigned* bar, volatile LAS unsigned* st) {
    XcdBarrier b; b.bar = bar; b.x = xb_xcc_id(); b.st = st;
    if (threadIdx.x == 0) (void)xb_add(&bar[XB_XCNT(b.x)], 1u);
    return b;
}
__device__ __forceinline__ void xcd_barrier_complete(unsigned* bar, unsigned x, unsigned& nloc, unsigned& nx) {
    const unsigned G = gridDim.x * gridDim.y * gridDim.z;
    unsigned sum, cnt, mine, sp = 0u;
    for (;;) {
        sum = 0u; cnt = 0u; mine = 0u;
#pragma unroll
        for (unsigned j = 0; j < 16; ++j) { const unsigned c = xb_ld(&bar[XB_XCNT(j)]); sum += c; cnt += (c > 0u) ? 1u : 0u; mine = (j == x) ? c : mine; }
        if (sum == G) break;
        __builtin_amdgcn_s_sleep(1);
        if ((++sp & 255u) == 0u) { if (xb_ld(&bar[XB_TMO])) break; if (sp > XB_SPIN_CAP) { atomicAdd(&bar[XB_TMO], 1u); break; } }
    }
    nloc = mine > 0u ? mine : 1u; nx = cnt > 0u ? cnt : 1u;
}
__device__ __forceinline__ void xcd_barrier(const XcdBarrier& b) {
    asm volatile("s_waitcnt vmcnt(0)" ::: "memory");
    __syncthreads();
    if (threadIdx.x == 0) {
        unsigned* bar = b.bar;
        __builtin_amdgcn_s_waitcnt(0);
        unsigned nloc = b.st[0], nx = b.st[1];
        if (nloc == 0u) { xcd_barrier_complete(bar, b.x, nloc, nx); b.st[0] = nloc; b.st[1] = nx; }
        const unsigned old = xb_add(&bar[XB_XSUB(b.x)], 1u);
        const unsigned gen = old / nloc;
        if (old + 1u == (gen + 1u) * nloc) {
            __builtin_amdgcn_fence(__ATOMIC_RELEASE, "agent");
            asm volatile("s_waitcnt vmcnt(0)" ::: "memory");
            const unsigned og = xb_add(&bar[XB_TOP], 1u);
            const unsigned tg = og / nx;
            if (og + 1u == (tg + 1u) * nx) xb_add(&bar[XB_TOPGEN], 1u);
            else XB_SPIN(xb_ld(&bar[XB_TOPGEN]) == tg, bar);
            __builtin_amdgcn_fence(__ATOMIC_ACQUIRE, "agent");
            xb_add(&bar[XB_XGEN(b.x)], 1u);
            asm volatile("s_waitcnt vmcnt(0)" ::: "memory");
        } else {
            XB_SPIN(xb_ld(&bar[XB_XGEN(b.x)]) == gen, bar);
            __builtin_amdgcn_fence(__ATOMIC_ACQUIRE, "agent");
            asm volatile("s_waitcnt vmcnt(0)" ::: "memory");
        }
    }
    __syncthreads();
}


namespace pg8 {
#define PG8_LAS __attribute__((address_space(3)))
typedef unsigned short bf16_t;
typedef short bf16x8 __attribute__((ext_vector_type(8)));
typedef float f32x4 __attribute__((ext_vector_type(4)));
typedef unsigned u32x4 __attribute__((ext_vector_type(4)));
constexpr int BM = 256, BK = 64, HALF = 128, HTB = HALF * BK * 2  , STAGE_BYTES = 8 * HTB, NXCD = 8, WGM = 8;

__host__ __device__ __forceinline__ int lds_byte(int r, int c) { const int st = (r >> 4) * 2 + (c >> 5), rr = r & 15, cc = c & 31, ob = rr * 64 + cc * 2; return st * 1024 + (ob ^ (((ob >> 9) & 1) << 5)); }
__host__ __device__ __forceinline__ void stage_rc(int b, int& R, int& C) { const int st = b / 1024, sb = b % 1024, swz = sb ^ (((sb >> 9) & 1) << 5); R = (st >> 1) * 16 + swz / 64; C = (st & 1) * 32 + (swz % 64) / 2; }
__host__ __device__ __forceinline__ int perm32(int rho) { const int n = rho >> 4, i = rho & 15; return 8 * (i >> 2) + 4 * n + (i & 3); }

struct Unit { int pm, pn; };
struct Gemm { const bf16_t* A; const bf16_t* Bt; int M, N, K; };

struct StaticOrder {
    int nM, nN, nwg, G, c;
    __host__ __device__ void init(int M, int N, int G_, int c_) { nM = M / BM; nN = N / BM; nwg = nM * nN; G = G_; c = c_; }
    __host__ __device__ bool next(int i, Unit& u) const {
        const long L = (long)i * G + c; if (L >= nwg) return false;
        int wgid = (int)L; { const int q = nwg / NXCD, r = nwg % NXCD, xcd = wgid % NXCD, off = wgid / NXCD; wgid = (xcd < r ? xcd * (q + 1) : r * (q + 1) + (xcd - r) * q) + off; }
        const int nig = WGM * nN, gid = wgid / nig, fm = gid * WGM, gsz = (nM - fm) < WGM ? (nM - fm) : WGM;
        u.pm = fm + ((wgid % nig) % gsz); u.pn = (wgid % nig) / gsz; return true;
    }
    __device__ __forceinline__ void a_ready(const Unit&) const {}
    __device__ __forceinline__ void done(const Unit&) const {}
};

__device__ __forceinline__ unsigned cvt_pk_bf16(float lo, float hi) { unsigned r; asm volatile("v_cvt_pk_bf16_f32 %0, %1, %2" : "=v"(r) : "v"(lo), "v"(hi)); return r; }
typedef float f32x2 __attribute__((ext_vector_type(2)));
template <class Epi, class Sched, bool ALIGN_EPI = false, bool SP2 = false>
__device__ __forceinline__ void gemm_phase(PG8_LAS unsigned char* lds, const Gemm g, const Sched& S, const Epi& E, const int tid) {
    const int  wid = __builtin_amdgcn_readfirstlane(tid >> 6), lane = tid & 63, wr = wid >> 2, wc = wid & 3, fr = lane & 15, fq = lane >> 4;
    const int K = g.K, nt = K / BK;
    unsigned voffA[2], voffB[2];
#pragma unroll
    for (int i = 0; i < 2; ++i) { int R, C; stage_rc(tid * 16 + i * 8192, R, C); const int Rb = Epi::PERM ? ((R & ~31) + perm32(R & 31)) : R;
        voffA[i] = (unsigned)(R * K + C) * 2u; voffB[i] = (unsigned)(Rb * K + C) * 2u; }
    const size_t kstep = (size_t)(BK * 2);
    const size_t hstep = (size_t)HALF * K * 2;
    const size_t tstep = 2 * hstep;
    const unsigned ldsw = (unsigned)wid * 1024u;
    const int aoff = lds_byte(wr * 64 + fr, fq * 8), boff = lds_byte(wc * 32 + fr, fq * 8);
#define PG8_SA(b, h) (((b) * 2 + (h)) * HTB)
#define PG8_SB(b, h) ((4 + (b) * 2 + (h)) * HTB)
#define PG8_STAGE(bufoff, gbase, voff) do { _Pragma("unroll") for (int _i = 0; _i < 2; ++_i) \
        __builtin_amdgcn_global_load_lds((const unsigned*)((const char*)(gbase) + (voff)[_i]), (PG8_LAS unsigned*)(lds + (bufoff) + ldsw + _i * 8192), 16, 0, 0); } while (0)
#define PG8_LDA(dst, b, h) do { _Pragma("unroll") for (int m = 0; m < 4; ++m) _Pragma("unroll") for (int k = 0; k < 2; ++k) dst[m][k] = *(const PG8_LAS bf16x8*)(lds + PG8_SA(b, h) + aoff + m * 2048 + k * 1024); } while (0)
#define PG8_LDB(dst, b, h) do { _Pragma("unroll") for (int n = 0; n < 2; ++n) _Pragma("unroll") for (int k = 0; k < 2; ++k) dst[n][k] = *(const PG8_LAS bf16x8*)(lds + PG8_SB(b, h) + boff + n * 2048 + k * 1024); } while (0)
#define PG8_MMA(ai, bj, At, Bt) do { __builtin_amdgcn_s_setprio(1); _Pragma("unroll") for (int m = 0; m < 4; ++m) _Pragma("unroll") for (int n = 0; n < 2; ++n) _Pragma("unroll") for (int k = 0; k < 2; ++k) \
        acc[ai][bj][m][n] = __builtin_amdgcn_mfma_f32_16x16x32_bf16(Bt[n][k], At[m][k], acc[ai][bj][m][n], 0, 0, 0); __builtin_amdgcn_s_setprio(0); } while (0)
#define PG8_WAIT_V(n) asm volatile("s_waitcnt vmcnt(" #n ")" ::: "memory")
#define PG8_WAIT_L(n) asm volatile("s_waitcnt lgkmcnt(" #n ")" ::: "memory")
#define PG8_BAR __builtin_amdgcn_s_barrier()
#define PG8_SCHED __builtin_amdgcn_sched_barrier(0)
    Unit cur, nxt; int ui = 0;
    if (!S.next(0, cur)) return;
    f32x4 acc[2][2][4][2];
#pragma unroll
    for (int a = 0; a < 2; ++a)
#pragma unroll
        for (int b = 0; b < 2; ++b)
#pragma unroll
            for (int m = 0; m < 4; ++m)
#pragma unroll
                for (int n = 0; n < 2; ++n) acc[a][b][m][n] = (f32x4){0.f, 0.f, 0.f, 0.f};
    bf16x8 At[4][2], B0[2][2], B1[2][2];
    const char* cA = (const char*)g.A + (size_t)cur.pm * tstep; const char* cB = (const char*)g.Bt + (size_t)cur.pn * tstep;
    S.a_ready(cur);
    if constexpr (SP2) {
        PG8_STAGE(PG8_SB(0, 0), cB, voffB); PG8_STAGE(PG8_SB(0, 1), cB + hstep, voffB); PG8_STAGE(PG8_SA(0, 0), cA, voffA); PG8_STAGE(PG8_SA(0, 1), cA + hstep, voffA);
        if (wr == 1) PG8_BAR;
        PG8_WAIT_V(2); PG8_BAR;
        PG8_STAGE(PG8_SB(1, 0), cB + kstep, voffB); PG8_STAGE(PG8_SA(1, 0), cA + kstep, voffA); PG8_STAGE(PG8_SB(1, 1), cB + hstep + kstep, voffB);
        PG8_WAIT_V(6); PG8_BAR;
    } else {
        PG8_STAGE(PG8_SB(0, 0), cB, voffB); PG8_STAGE(PG8_SA(0, 0), cA, voffA); PG8_STAGE(PG8_SB(0, 1), cB + hstep, voffB); PG8_STAGE(PG8_SA(0, 1), cA + hstep, voffA);
        if (wr == 1) PG8_BAR;
        PG8_WAIT_V(4); PG8_BAR;
        PG8_STAGE(PG8_SB(1, 0), cB + kstep, voffB); PG8_STAGE(PG8_SA(1, 0), cA + kstep, voffA); PG8_STAGE(PG8_SB(1, 1), cB + hstep + kstep, voffB);
        PG8_WAIT_V(6); PG8_BAR;
    }
    for (;;) {
        const bool has_next = S.next(ui + 1, nxt);
        const char* nA = has_next ? (const char*)g.A + (size_t)nxt.pm * tstep : cA; const char* nB = has_next ? (const char*)g.Bt + (size_t)nxt.pn * tstep : cB;
#pragma nounroll
        for (int t = 0; t < nt; t += 2) {
            const bool last = (t == nt - 2);
            const char* a1 = cA + (size_t)(t + 1) * kstep;
            const char* a2 = last ? nA : cA + (size_t)(t + 2) * kstep; const char* b2 = last ? nB : cB + (size_t)(t + 2) * kstep;
            const char* a3 = a2 + kstep; const char* b3 = b2 + kstep;
            if (last && has_next) S.a_ready(nxt);
            if constexpr (SP2) {
            PG8_LDB(B0, 0, 0); PG8_LDB(B1, 0, 1); PG8_SCHED; PG8_LDA(At, 0, 0); PG8_STAGE(PG8_SA(1, 1), a1 + hstep, voffA);
            PG8_WAIT_V(8); PG8_WAIT_L(0); PG8_BAR; PG8_MMA(0, 0, At, B0); PG8_MMA(0, 1, At, B1); PG8_BAR; PG8_SCHED;
            PG8_LDA(At, 0, 1); PG8_STAGE(PG8_SB(0, 0), b2, voffB); PG8_STAGE(PG8_SB(0, 1), b2 + hstep, voffB); PG8_STAGE(PG8_SA(0, 0), a2, voffA);
            PG8_WAIT_V(8); PG8_WAIT_L(0); PG8_BAR; PG8_MMA(1, 0, At, B0); PG8_MMA(1, 1, At, B1); PG8_BAR; PG8_SCHED;
            PG8_LDB(B0, 1, 0); PG8_LDB(B1, 1, 1); PG8_SCHED; PG8_LDA(At, 1, 0); PG8_STAGE(PG8_SA(0, 1), a2 + hstep, voffA);
            PG8_WAIT_V(8); PG8_WAIT_L(0); PG8_BAR; PG8_MMA(0, 0, At, B0); PG8_MMA(0, 1, At, B1); PG8_BAR; PG8_SCHED;
            PG8_LDA(At, 1, 1); PG8_STAGE(PG8_SB(1, 0), b3, voffB); PG8_STAGE(PG8_SB(1, 1), b3 + hstep, voffB); PG8_STAGE(PG8_SA(1, 0), a3, voffA);
            PG8_WAIT_V(8); PG8_WAIT_L(0); PG8_BAR; PG8_MMA(1, 0, At, B0); PG8_MMA(1, 1, At, B1); PG8_BAR; PG8_SCHED;
            } else {
            PG8_LDB(B0, 0, 0); PG8_SCHED; PG8_LDA(At, 0, 0); PG8_STAGE(PG8_SA(1, 1), a1 + hstep, voffA);
            PG8_WAIT_L(8); PG8_BAR; PG8_WAIT_L(0); PG8_MMA(0, 0, At, B0); PG8_BAR; PG8_SCHED;
            PG8_LDB(B1, 0, 1); PG8_STAGE(PG8_SB(0, 0), b2, voffB);
            PG8_BAR; PG8_WAIT_L(0); PG8_MMA(0, 1, At, B1); PG8_BAR;
            PG8_LDA(At, 0, 1); PG8_STAGE(PG8_SA(0, 0), a2, voffA);
            PG8_BAR; PG8_WAIT_L(0); PG8_MMA(1, 0, At, B0); PG8_BAR; PG8_SCHED;
            PG8_STAGE(PG8_SB(0, 1), b2 + hstep, voffB);
            PG8_WAIT_V(6); PG8_BAR; PG8_MMA(1, 1, At, B1); PG8_BAR;
            PG8_LDB(B0, 1, 0); PG8_SCHED; PG8_LDA(At, 1, 0); PG8_STAGE(PG8_SA(0, 1), a2 + hstep, voffA);
            PG8_WAIT_L(8); PG8_BAR; PG8_WAIT_L(0); PG8_MMA(0, 0, At, B0); PG8_BAR; PG8_SCHED;
            PG8_LDB(B1, 1, 1); PG8_STAGE(PG8_SB(1, 0), b3, voffB);
            PG8_BAR; PG8_WAIT_L(0); PG8_MMA(0, 1, At, B1); PG8_BAR;
            PG8_LDA(At, 1, 1); PG8_STAGE(PG8_SA(1, 0), a3, voffA);
            PG8_BAR; PG8_WAIT_L(0); PG8_MMA(1, 0, At, B0); PG8_BAR; PG8_SCHED;
            PG8_STAGE(PG8_SB(1, 1), b3 + hstep, voffB);
            PG8_WAIT_V(6); PG8_BAR; PG8_MMA(1, 1, At, B1); PG8_BAR;
            }
        }
        if constexpr (ALIGN_EPI) { if (wr == 0) PG8_BAR; }
        if constexpr (!Epi::AFTER_DRAIN) { E(acc, cur, wr, wc, fr, fq); S.done(cur); }
        if (!has_next) break;
#pragma unroll
        for (int a = 0; a < 2; ++a)
#pragma unroll
            for (int b = 0; b < 2; ++b)
#pragma unroll
                for (int m = 0; m < 4; ++m)
#pragma unroll
                    for (int n = 0; n < 2; ++n) acc[a][b][m][n] = (f32x4){0.f, 0.f, 0.f, 0.f};
        cur = nxt; cA = nA; cB = nB; ++ui;
        if constexpr (ALIGN_EPI) { if (wr == 1) PG8_BAR; }
    }
    PG8_WAIT_V(0);
    if constexpr (!ALIGN_EPI) { if (wr == 0) PG8_BAR; }
    PG8_BAR;
    if constexpr (Epi::AFTER_DRAIN) { E.fused(acc, cur, wr, wc, fr, fq, lds, wid, lane); S.done(cur); }
#undef PG8_SA
#undef PG8_SB
#undef PG8_STAGE
#undef PG8_LDA
#undef PG8_LDB
#undef PG8_MMA
#undef PG8_WAIT_V
#undef PG8_WAIT_L
#undef PG8_BAR
#undef PG8_SCHED
}
}

#define OPT_THREADS 512
constexpr int LDS_BYTES = 147456;
typedef pg8::f32x4 f32x4;
#define GLB __attribute__((address_space(1)))

typedef float f32x2_t __attribute__((ext_vector_type(2))); typedef __bf16 bf16x2_t __attribute__((ext_vector_type(2)));
__device__ __forceinline__ unsigned pk2(float lo, float hi) { f32x2_t v = {lo, hi}; bf16x2_t b = __builtin_convertvector(v, bf16x2_t); return __builtin_bit_cast(unsigned, b); }
__device__ __forceinline__ U4 pack8(const f32x4& a, const f32x4& b) { U4 w; w.x = pk2(a[0], a[1]); w.y = pk2(a[2], a[3]); w.z = pk2(b[0], b[1]); w.w = pk2(b[2], b[3]); return w; }
__device__ __forceinline__ void atomic_addf(float* p, float v) { __hip_atomic_fetch_add(p, v, __ATOMIC_RELAXED, __HIP_MEMORY_SCOPE_AGENT); }

template <int MODE> __device__ __forceinline__ int wsrc_col(int n, int nsrc, int& which) {
    which = 0;
    if (MODE == 0) return n < nsrc ? n : -1;
    if (MODE == 1) { if (n >= 640 && n < 672) { const int c = n - 640; return 640 + ((c >> 2) & 1) * 16 + 4 * (c >> 3) + (c & 3); }
        if (n < 1824) return n; if (n < 2080) return n + 6; if (n < 2464) return n + 6; if (n < 2470) return n - 2464 + 1824; if (n < 2472) return -1; if (n < 2484) return n - 2472 + 2470; return -1; }
    if (MODE == 3) { if (n >= nsrc) return -1; const int h = n / 96, cc = n % 96; if (cc < 64) return n; const int c = cc - 64; return h * 96 + 64 + ((c >> 2) & 1) * 16 + 4 * (c >> 3) + (c & 3); }
    const int t = n >> 8, r = n & 255; which = r >> 7; return t * 128 + (r & 127);
}
template <int MODE> __device__ __forceinline__ void wconv(const float* W, const float* W2, int ldw, int K, int Nd, int nsrc, const float* gk, bf16_t* Bt, LAS float* scr, int gw, int ngw, int rot, int lane) {
    const int nkb = K / 64, nitems = nkb * (Nd / 32);
    for (int it = (gw + rot) % ngw; it < nitems; it += ngw) {
        const int kb = it % nkb, nb = it / nkb, k0 = 64 * kb, n0 = 32 * nb;
        int which; const int sc = wsrc_col<MODE>(n0 + (lane & 31), nsrc, which); const float* Ws = (MODE == 2 && which) ? W2 : W;
        float vv[32];
#pragma unroll
        for (int i = 0; i < 32; ++i) { const int kk = 2 * i + (lane >> 5); vv[i] = (sc >= 0) ? Ws[(size_t)(k0 + kk) * ldw + sc] : 0.f; }
        if (gk) {
#pragma unroll
            for (int i = 0; i < 32; ++i) vv[i] *= gk[k0 + 2 * i + (lane >> 5)]; }
#pragma unroll
        for (int i = 0; i < 32; ++i) scr[(2 * i + (lane >> 5)) * 33 + (lane & 31)] = vv[i];
        asm volatile("s_waitcnt lgkmcnt(0)" ::: "memory");
        const int c = lane & 7;
#pragma unroll
        for (int j = 0; j < 4; ++j) { const int n = (lane >> 3) + 8 * j; const LAS float* s = scr + (8 * c) * 33 + n;
            U4 o; o.x = pk2(s[0 * 33], s[1 * 33]); o.y = pk2(s[2 * 33], s[3 * 33]); o.z = pk2(s[4 * 33], s[5 * 33]); o.w = pk2(s[6 * 33], s[7 * 33]);
            *(U4*)(Bt + (size_t)(n0 + n) * K + k0 + 8 * c) = o; }
        asm volatile("s_waitcnt lgkmcnt(0)" ::: "memory");
    }
}
__device__ __forceinline__ void build_att_list(const P& p, int gw, int ngw, int lane);
__device__ __forceinline__ void op_prologue(const P& p, LAS unsigned char* lds, const int tid) {
    const int lane = tid & 63, wave = tid >> 6, gw = blockIdx.x * 8 + wave, ngw = gridDim.x * 8;
    const long gtid = (long)blockIdx.x * OPT_THREADS + tid, gn = (long)gridDim.x * OPT_THREADS;
    { const f32x4* x4 = (const f32x4*)p.x; U4* xb = WSP(U4, OFF_XB);
      for (long i = gtid; i < (long)M * D / 8; i += 4 * gn) { f32x4 a[4], b[4];
#pragma unroll
          for (int j = 0; j < 4; ++j) { a[j] = x4[2 * (i + j * gn)]; b[j] = x4[2 * (i + j * gn) + 1]; }
#pragma unroll
          for (int j = 0; j < 4; ++j) xb[i + j * gn] = pack8(a[j], b[j]); } }
    for (long i = gtid; i < 2048; i += gn) { WSP(bf16_t, OFF_KCR)[(long)M * 64 + i] = 0; WSP(bf16_t, OFF_VCR)[(long)M * 64 + i] = 0; }
    for (long i = gtid; i < (long)S * 16; i += gn) { float c, s; rope_cs((int)(i >> 4), (int)(i & 15), c, s); WSP(float, OFF_ROPE)[2 * i] = c; WSP(float, OFF_ROPE)[2 * i + 1] = s; }
    if (blockIdx.x < 8) {
        const int jh = blockIdx.x & 1, wch = (blockIdx.x >> 1) & 1, layer = blockIdx.x >> 2;
        const float* pe = (wch ? p.cvp : p.ckp) + (size_t)layer * 2048 + wave * 256; const float* w1 = (wch ? p.cvw1 : p.ckw1) + (size_t)layer * 2048 * 128 + (size_t)wave * 256 * 128 + jh * 64 + lane;
        float acc = 0.f;
#pragma unroll 8
        for (int k = 0; k < 256; ++k) acc += pe[k] * w1[(size_t)k * 128];
        LAS float* red = (LAS float*)lds; red[wave * 64 + lane] = acc;
        __syncthreads();
        if (tid < 64) { float s = 0.f;
#pragma unroll
            for (int w = 0; w < 8; ++w) s += red[w * 64 + tid];
            WSP(float, OFF_CBIAS)[(layer * 2 + wch) * 128 + jh * 64 + tid] = s; }
        __syncthreads();
    }
    build_att_list(p, gw, ngw, lane);
    LAS float* scr = (LAS float*)(lds + wave * 16384);
    for (int l = 0; l < 2; ++l) {
        wconv<1>(p.w_in + (size_t)l * D * IN_COLS, nullptr, IN_COLS, D, NPAD_IN, IN_COLS, nullptr, WSP(bf16_t, OFF_W_IN) + (size_t)l * NPAD_IN * D, scr, gw, ngw, 0, lane);
        wconv<3>(p.w_uq + (size_t)l * 384 * 576, nullptr, 576, 384, 768, 576, p.g_cq + l * 384, WSP(bf16_t, OFF_W_UQ) + (size_t)l * 768 * 384, scr, gw, ngw, 300, lane);
        wconv<0>(p.w_ukv + (size_t)l * 256 * 768, nullptr, 768, 256, 768, 768, p.g_ckv + l * 256, WSP(bf16_t, OFF_W_UKV) + (size_t)l * 768 * 256, scr, gw, ngw, 600, lane);
        wconv<0>(p.ckw1 + (size_t)l * 2048 * 128, nullptr, 128, 2048, 128, 128, nullptr, WSP(bf16_t, OFF_W_C1) + (size_t)(l * 2 + 0) * 128 * 2048, scr, gw, ngw, 900, lane);
        wconv<0>(p.cvw1 + (size_t)l * 2048 * 128, nullptr, 128, 2048, 128, 128, nullptr, WSP(bf16_t, OFF_W_C1) + (size_t)(l * 2 + 1) * 128 * 2048, scr, gw, ngw, 1000, lane);
        wconv<0>(p.ckw2 + (size_t)l * 128 * 64, nullptr, 64, 128, 64, 64, nullptr, WSP(bf16_t, OFF_W_C2) + (size_t)(l * 2 + 0) * 64 * 128, scr, gw, ngw, 1100, lane);
        wconv<0>(p.cvw2 + (size_t)l * 128 * 64, nullptr, 64, 128, 64, 64, nullptr, WSP(bf16_t, OFF_W_C2) + (size_t)(l * 2 + 1) * 64 * 128, scr, gw, ngw, 1104, lane);
        wconv<0>(p.w_out + (size_t)l * MIXW * D, nullptr, D, MIXW, D, D, nullptr, WSP(bf16_t, OFF_W_OUT) + (size_t)l * D * MIXW, scr, gw, ngw, 1200, lane);
    }
    wconv<2>(p.fw1, p.fw3, DFF, D, 2 * DFF, DFF, nullptr, WSP(bf16_t, OFF_W_F13), scr, gw, ngw, 0, lane);
    wconv<0>(p.fw2, nullptr, D, DFF, D, D, nullptr, WSP(bf16_t, OFF_W_F2), scr, gw, ngw, 400, lane);
    for (int e = 0; e < NE; ++e) {
        wconv<2>(p.mw1 + (size_t)e * D * DFE, p.mw3 + (size_t)e * D * DFE, DFE, D, 2 * DFE, DFE, nullptr, WSP(bf16_t, OFF_W_M13) + (size_t)e * 2 * DFE * D, scr, gw, ngw, e * 200, lane);
        wconv<0>(p.mw2 + (size_t)e * DFE * D, nullptr, D, DFE, D, D, nullptr, WSP(bf16_t, OFF_W_M2) + (size_t)e * D * DFE, scr, gw, ngw, e * 200 + 100, lane);
    }
}

struct EpiInproj {
    static constexpr bool PERM = true, AFTER_DRAIN = false;
    P p; int layer;
    __device__ __forceinline__ void operator()(const f32x4 (&acc)[2][2][4][2], const pg8::Unit& u, int wr, int wc, int fr, int fq) const {
        const int rowb = u.pm * 256 + wr * 64 + fr;
#pragma unroll
        for (int bj = 0; bj < 2; ++bj) {
            const int sb = u.pn * 256 + bj * 128 + wc * 32;
            if (sb >= 2496) continue;
            if (sb == 640) {
                const float* rt = WSP(float, OFF_ROPE);
#pragma unroll
                for (int ai = 0; ai < 2; ++ai)
#pragma unroll
                    for (int m = 0; m < 4; ++m) { const int row = rowb + ai * 128 + m * 16; const int pos = row % S;
                        const f32x4 v0 = acc[ai][bj][m][0], v1 = acc[ai][bj][m][1];
                        const f32x4* cs = (const f32x4*)(rt + (unsigned)(pos * 16 + 4 * fq) * 2u); const f32x4 c01 = cs[0], c23 = cs[1]; f32x4 o0, o1;
                        o0[0] = v0[0] * c01[0] - v1[0] * c01[1]; o0[1] = v0[1] * c01[2] - v1[1] * c01[3]; o0[2] = v0[2] * c23[0] - v1[2] * c23[1]; o0[3] = v0[3] * c23[2] - v1[3] * c23[3];
                        o1[0] = v1[0] * c01[0] + v0[0] * c01[1]; o1[1] = v1[1] * c01[2] + v0[1] * c01[3]; o1[2] = v1[2] * c23[0] + v0[2] * c23[1]; o1[3] = v1[3] * c23[2] + v0[3] * c23[3];
                        const U4 w = pack8(o0, o1); bf16_t* km = WSP(bf16_t, OFF_KM) + (size_t)row * 576 + 64 + 8 * fq;
#pragma unroll
                        for (int h = 0; h < 6; ++h) *(U4*)(km + h * 96) = w; }
            } else if (sb == 2464) {
#pragma unroll
                for (int ai = 0; ai < 2; ++ai)
#pragma unroll
                    for (int m = 0; m < 4; ++m) { const int row = rowb + ai * 128 + m * 16; const f32x4 v0 = acc[ai][bj][m][0], v1 = acc[ai][bj][m][1];
                        if (fq == 0) { f32x4* d = (f32x4*)(WSP(float, OFF_FL) + (size_t)row * 8); d[0] = v0; d[1] = v1; }
                        else if (fq < 3) { f32x4* d = (f32x4*)(WSP(float, OFF_NG) + (size_t)row * 16 + 8 * (fq - 1)); d[0] = v0; d[1] = v1; } }
            } else {
                bf16_t* dst; int pitch; float sc = 1.f; float* ssq = nullptr;
                if (sb < 384) { dst = WSP(bf16_t, OFF_CQ) + sb; pitch = 384; ssq = WSP(float, OFF_SSQ) + (sb >> 5); }
                else if (sb < 640) { dst = WSP(bf16_t, OFF_CKV) + (sb - 384); pitch = 256; ssq = WSP(float, OFF_SSQ) + (sb >> 5); }
                else if (sb < 1824) { const int c = sb - 672, which = c / 384, hd = c % 384; pitch = 384; dst = WSP(bf16_t, which == 0 ? OFF_FQ : which == 1 ? OFF_FK : OFF_FV) + hd; if (which == 0) sc = HD_QS; }
                else if (sb < 2080) { dst = WSP(bf16_t, OFF_NQ) + (sb - 1824); pitch = 256; sc = HD_QS; }
                else { const int c = sb - 2080, idx = c >> 6; pitch = 64;
                    dst = WSP(bf16_t, idx == 0 ? OFF_KCR : idx == 1 ? OFF_VCR : idx == 2 ? OFF_KS : idx == 3 ? OFF_VS : idx == 4 ? OFF_KW : OFF_VW) + (c & 63); }
#pragma unroll
                for (int ai = 0; ai < 2; ++ai)
#pragma unroll
                    for (int m = 0; m < 4; ++m) { const int row = rowb + ai * 128 + m * 16; const f32x4 v0 = acc[ai][bj][m][0] * sc, v1 = acc[ai][bj][m][1] * sc;
                        if (ssq) { float s = (v0[0] * v0[0] + v0[1] * v0[1]) + (v0[2] * v0[2] + v0[3] * v0[3]) + (v1[0] * v1[0] + v1[1] * v1[1]) + (v1[2] * v1[2] + v1[3] * v1[3]);
                            s += __shfl_xor(s, 16); s += __shfl_xor(s, 32); if (fq == 0) ssq[(size_t)row * 20] = s; }
                        *(U4*)(dst + (size_t)row * pitch + 8 * fq) = pack8(v0, v1); }
            }
        }
    }
};

__device__ __forceinline__ void op_inproj(const P& p, int layer, LAS unsigned char* lds, const int tid) {
    pg8::Gemm g{WSP(bf16_t, OFF_XB), WSP(bf16_t, OFF_W_IN) + (size_t)layer * NPAD_IN * D, M, NPAD_IN, D};
    pg8::StaticOrder S; S.init(M, NPAD_IN, (int)gridDim.x, (int)blockIdx.x);
    EpiInproj E{p, layer};
    pg8::gemm_phase<EpiInproj, pg8::StaticOrder, true, true>(lds, g, S, E, tid);
}

struct EpiQup {
    static constexpr bool PERM = true, AFTER_DRAIN = false;
    P p; int layer;
    __device__ __forceinline__ void operator()(const f32x4 (&acc)[2][2][4][2], const pg8::Unit& u, int wr, int wc, int fr, int fq) const {
        const int rowb = u.pm * 256 + wr * 64 + fr; const float* ssq = WSP(float, OFF_SSQ); const float* rt = WSP(float, OFF_ROPE); bf16_t* qm = WSP(bf16_t, OFF_QM);
#pragma unroll
        for (int bj = 0; bj < 2; ++bj) {
            const int sb = u.pn * 256 + bj * 128 + wc * 32;
            if (sb >= 576) continue;
            const int h = sb / 96, part = (sb % 96) / 32; const unsigned cofs = (unsigned)(h * 96 + part * 32 + 8 * fq);
            if (part == 2) {
#pragma unroll
                for (int ai = 0; ai < 2; ++ai)
#pragma unroll
                    for (int m = 0; m < 4; ++m) { const int row = rowb + ai * 128 + m * 16; const f32x4* sq = (const f32x4*)(ssq + (unsigned)row * 20u); const f32x4 s0 = sq[0], s1 = sq[1], s2 = sq[2]; const float r = MLA_QS * __builtin_amdgcn_rsqf((((s0[0] + s0[1]) + (s0[2] + s0[3])) + ((s1[0] + s1[1]) + (s1[2] + s1[3])) + ((s2[0] + s2[1]) + (s2[2] + s2[3]))) * (1.0f / 384.f) + EPS);
                        const f32x4 v0 = acc[ai][bj][m][0] * r, v1 = acc[ai][bj][m][1] * r; const int pos = row % S;
                        const f32x4* cs = (const f32x4*)(rt + (unsigned)(pos * 16 + 4 * fq) * 2u); const f32x4 c01 = cs[0], c23 = cs[1]; f32x4 o0, o1;
                        o0[0] = v0[0] * c01[0] - v1[0] * c01[1]; o0[1] = v0[1] * c01[2] - v1[1] * c01[3]; o0[2] = v0[2] * c23[0] - v1[2] * c23[1]; o0[3] = v0[3] * c23[2] - v1[3] * c23[3];
                        o1[0] = v1[0] * c01[0] + v0[0] * c01[1]; o1[1] = v1[1] * c01[2] + v0[1] * c01[3]; o1[2] = v1[2] * c23[0] + v0[2] * c23[1]; o1[3] = v1[3] * c23[2] + v0[3] * c23[3];
                        *(U4*)(qm + ((unsigned)row * 576u + cofs)) = pack8(o0, o1);
                        asm volatile("" ::: "memory"); }
            } else {
#pragma unroll
                for (int ai = 0; ai < 2; ++ai)
#pragma unroll
                    for (int m = 0; m < 4; ++m) { const int row = rowb + ai * 128 + m * 16; const f32x4* sq = (const f32x4*)(ssq + (unsigned)row * 20u); const f32x4 s0 = sq[0], s1 = sq[1], s2 = sq[2]; const float r = MLA_QS * __builtin_amdgcn_rsqf((((s0[0] + s0[1]) + (s0[2] + s0[3])) + ((s1[0] + s1[1]) + (s1[2] + s1[3])) + ((s2[0] + s2[1]) + (s2[2] + s2[3]))) * (1.0f / 384.f) + EPS);
                        *(U4*)(qm + ((unsigned)row * 576u + cofs)) = pack8(acc[ai][bj][m][0] * r, acc[ai][bj][m][1] * r);
                        asm volatile("" ::: "memory"); }
            }
        }
    }
};
struct EpiKVup {
    static constexpr bool PERM = true, AFTER_DRAIN = false;
    P p; int layer;
    __device__ __forceinline__ void operator()(const f32x4 (&acc)[2][2][4][2], const pg8::Unit& u, int wr, int wc, int fr, int fq) const {
        const int rowb = u.pm * 256 + wr * 64 + fr; const float* ssq = WSP(float, OFF_SSQ) + 12;
        bf16_t* km = WSP(bf16_t, OFF_KM); bf16_t* vm = WSP(bf16_t, OFF_VM);
        const int sb0 = u.pn * 256 + wc * 32;
#pragma unroll
        for (int ai = 0; ai < 2; ++ai)
#pragma unroll
            for (int m = 0; m < 4; ++m) { const int row = rowb + ai * 128 + m * 16; const f32x4* sq = (const f32x4*)(ssq + (unsigned)row * 20u); const f32x4 s0 = sq[0], s1 = sq[1]; const float r = __builtin_amdgcn_rsqf((((s0[0] + s0[1]) + (s0[2] + s0[3])) + ((s1[0] + s1[1]) + (s1[2] + s1[3]))) * (1.0f / 256.f) + EPS);
#pragma unroll
                for (int bj = 0; bj < 2; ++bj) { const int sb = sb0 + bj * 128, h = sb >> 7, cc = sb & 127;
                    const U4 w = pack8(acc[ai][bj][m][0] * r, acc[ai][bj][m][1] * r);
                    if (cc < 64) *(U4*)(km + (unsigned)(row * 576 + h * 96 + cc + 8 * fq)) = w; else *(U4*)(vm + (unsigned)(row * 384 + h * 64 + (cc - 64) + 8 * fq)) = w; }
                asm volatile("" ::: "memory"); }
    }
};
struct EpiResid {
    static constexpr bool PERM = true, AFTER_DRAIN = false;
    const float* base; float* out;
    __device__ __forceinline__ void operator()(const f32x4 (&acc)[2][2][4][2], const pg8::Unit& u, int wr, int wc, int fr, int fq) const {
        const int rowb = u.pm * 256 + wr * 64 + fr;
#pragma unroll
        for (int ai = 0; ai < 2; ++ai)
#pragma unroll
            for (int m = 0; m < 4; ++m) { const size_t ro = (size_t)(rowb + ai * 128 + m * 16) * D;
#pragma unroll
                for (int bj = 0; bj < 2; ++bj) { const size_t o = ro + u.pn * 256 + bj * 128 + wc * 32 + 8 * fq;
                    const f32x4 b0 = *(const f32x4*)(base + o), b1 = *(const f32x4*)(base + o + 4);
                    *(f32x4*)(out + o) = b0 * ALPHA + acc[ai][bj][m][0]; *(f32x4*)(out + o + 4) = b1 * ALPHA + acc[ai][bj][m][1]; } }
    }
};
struct EpiSwiglu {
    static constexpr bool PERM = true, AFTER_DRAIN = false;
    bf16_t* Hout; int ldh;
    __device__ __forceinline__ void operator()(const f32x4 (&acc)[2][2][4][2], const pg8::Unit& u, int wr, int wc, int fr, int fq) const {
        const int rowb = u.pm * 256 + wr * 64 + fr; const int col = u.pn * 128 + wc * 32 + 8 * fq;
#pragma unroll
        for (int ai = 0; ai < 2; ++ai)
#pragma unroll
            for (int m = 0; m < 4; ++m) { f32x4 h0, h1;
#pragma unroll
                for (int j = 0; j < 4; ++j) { const float a0 = acc[ai][0][m][0][j], a1 = acc[ai][0][m][1][j];
                    h0[j] = a0 * acc[ai][1][m][0][j] * __builtin_amdgcn_rcpf(1.0f + __expf(-a0)); h1[j] = a1 * acc[ai][1][m][1][j] * __builtin_amdgcn_rcpf(1.0f + __expf(-a1)); }
                *(U4*)(Hout + (size_t)(rowb + ai * 128 + m * 16) * ldh + col) = pack8(h0, h1); }
    }
};

__device__ __forceinline__ void op_mla_qup(const P& p, int layer, LAS unsigned char* lds, const int tid) {
    { pg8::Gemm g{WSP(bf16_t, OFF_CQ), WSP(bf16_t, OFF_W_UQ) + (size_t)layer * 768 * 384, M, 768, 384};
      pg8::StaticOrder S; S.init(M, 768, (int)gridDim.x, (int)blockIdx.x); EpiQup E{p, layer};
      pg8::gemm_phase<EpiQup, pg8::StaticOrder, true, true>(lds, g, S, E, tid); }
}
__device__ __forceinline__ void op_mla_kvup(const P& p, int layer, LAS unsigned char* lds, const int tid) {
    { pg8::Gemm g{WSP(bf16_t, OFF_CKV), WSP(bf16_t, OFF_W_UKV) + (size_t)layer * 768 * 256, M, 768, 256};
      pg8::StaticOrder S; S.init(M, 768, (int)gridDim.x, (int)((blockIdx.x + gridDim.x / 2) % gridDim.x)); EpiKVup E{p, layer};
      pg8::gemm_phase<EpiKVup, pg8::StaticOrder, true, true>(lds, g, S, E, tid); }
}
__device__ __forceinline__ void op_wout(const P& p, int layer, LAS unsigned char* lds, const int tid) {
    pg8::Gemm g{WSP(bf16_t, OFF_MIX), WSP(bf16_t, OFF_W_OUT) + (size_t)layer * D * MIXW, M, D, MIXW};
    pg8::StaticOrder S; S.init(M, D, (int)gridDim.x, (int)blockIdx.x); EpiResid E{layer == 0 ? p.x : p.out, p.out};
    pg8::gemm_phase<EpiResid, pg8::StaticOrder, true, true>(lds, g, S, E, tid);
}
__device__ __forceinline__ void op_ffn_up(const P& p, LAS unsigned char* lds, const int tid) {
    pg8::Gemm g{WSP(bf16_t, OFF_XB), WSP(bf16_t, OFF_W_F13), M, 2 * DFF, D};
    pg8::StaticOrder S; S.init(M, 2 * DFF, (int)gridDim.x, (int)blockIdx.x); EpiSwiglu E{WSP(bf16_t, OFF_H), DFF};
    pg8::gemm_phase<EpiSwiglu, pg8::StaticOrder, true, true>(lds, g, S, E, tid);
}
__device__ __forceinline__ void op_ffn_down(const P& p, LAS unsigned char* lds, const int tid) {
    pg8::Gemm g{WSP(bf16_t, OFF_H), WSP(bf16_t, OFF_W_F2), M, D, DFF};
    pg8::StaticOrder S; S.init(M, D, (int)gridDim.x, (int)blockIdx.x); EpiResid E{p.out, p.out};
    pg8::gemm_phase<EpiResid, pg8::StaticOrder, true, true>(lds, g, S, E, tid);
}
__device__ __forceinline__ float wave_sum(float v) {
#pragma unroll
    for (int o = 1; o < 64; o <<= 1) v += __shfl_xor(v, o);
    return v;
}
__device__ __forceinline__ void op_ln(const P& p, const float* g, const float* bta, const int tid) {
    static_assert(D == 1024, "op_ln: 16 floats per lane");
    const int lane = tid & 63, gw = blockIdx.x * (OPT_THREADS / 64) + (tid >> 6), ngw = gridDim.x * (OPT_THREADS / 64);
    f32x4 gv[4], bv[4];
#pragma unroll
    for (int j = 0; j < 4; ++j) { gv[j] = ((const f32x4*)g)[lane + 64 * j]; bv[j] = ((const f32x4*)bta)[lane + 64 * j]; }
    for (int row = gw; row < M; row += ngw) {
        f32x4* xr = (f32x4*)(p.out + (size_t)row * D) + lane; f32x4 v[4]; float s = 0.f;
#pragma unroll
        for (int j = 0; j < 4; ++j) { v[j] = xr[64 * j]; s += (v[j][0] + v[j][1]) + (v[j][2] + v[j][3]); }
        const float mean = wave_sum(s) * (1.f / D); float s2 = 0.f;
#pragma unroll
        for (int j = 0; j < 4; ++j) { v[j] = v[j] - mean; s2 += (v[j][0] * v[j][0] + v[j][1] * v[j][1]) + (v[j][2] * v[j][2] + v[j][3] * v[j][3]); }
        const float rstd = 1.f / sqrtf(wave_sum(s2) * (1.f / D) + EPS);
        unsigned long long* o8 = (unsigned long long*)(WSP(bf16_t, OFF_XB) + (size_t)row * D) + lane;
#pragma unroll
        for (int j = 0; j < 4; ++j) { const f32x4 y = v[j] * rstd * gv[j] + bv[j]; xr[64 * j] = y; o8[64 * j] = (unsigned long long)pk2(y[0], y[1]) | ((unsigned long long)pk2(y[2], y[3]) << 32); }
    }
}

constexpr int CW_GCNT = 4096;
__device__ __forceinline__ float bf_lo(unsigned u) { return __uint_as_float(u << 16); }
__device__ __forceinline__ float bf_hi(unsigned u) { return __uint_as_float(u & 0xffff0000u); }
__device__ __forceinline__ void op_ln_router(const P& p, const float* g, const float* bta, LAS unsigned char* lds, const int tid) {
    static_assert(D == 1024, "op_ln_router: 16 floats per lane");
    const int lane = tid & 63, gw = blockIdx.x * (OPT_THREADS / 64) + (tid >> 6), ngw = gridDim.x * (OPT_THREADS / 64);
    LAS unsigned* lcnt = (LAS unsigned*)lds; LAS unsigned* lbase = lcnt + 8;
    if (tid < 16) lcnt[tid] = 0u;
    __syncthreads();
    f32x4 gv[4], bv[4];
#pragma unroll
    for (int j = 0; j < 4; ++j) { gv[j] = ((const f32x4*)g)[lane + 64 * j]; bv[j] = ((const f32x4*)bta)[lane + 64 * j]; }
    unsigned* gcnt = WSP(unsigned, OFF_CTL) + CW_GCNT; int* eidx = WSP(int, OFF_EIDX); float* egate = WSP(float, OFF_EGATE); int* tsl = WSP(int, OFF_TOKSLOT);
    for (int row = gw; row < M; row += ngw) {
        f32x4* xr = (f32x4*)(p.out + (size_t)row * D) + lane; f32x4 v[4]; float s = 0.f;
#pragma unroll
        for (int j = 0; j < 4; ++j) { v[j] = xr[64 * j]; s += (v[j][0] + v[j][1]) + (v[j][2] + v[j][3]); }
        const float mean = wave_sum(s) * (1.f / D); float s2 = 0.f;
#pragma unroll
        for (int j = 0; j < 4; ++j) { v[j] = v[j] - mean; s2 += (v[j][0] * v[j][0] + v[j][1] * v[j][1]) + (v[j][2] * v[j][2] + v[j][3] * v[j][3]); }
        const float rstd = 1.f / sqrtf(wave_sum(s2) * (1.f / D) + EPS);
        unsigned long long* o8 = (unsigned long long*)(WSP(bf16_t, OFF_XB) + (size_t)row * D) + lane;
        float lg[NE];
#pragma unroll
        for (int e = 0; e < NE; ++e) lg[e] = 0.f;
#pragma unroll
        for (int j = 0; j < 4; ++j) { const f32x4 y = v[j] * rstd * gv[j] + bv[j]; xr[64 * j] = y; o8[64 * j] = (unsigned long long)pk2(y[0], y[1]) | ((unsigned long long)pk2(y[2], y[3]) << 32);
            const f32x4* rw4 = (const f32x4*)(p.rw + (size_t)(4 * lane + 256 * j) * NE);
#pragma unroll
            for (int c = 0; c < 4; ++c) { const f32x4 r0 = rw4[2 * c], r1 = rw4[2 * c + 1];
                lg[0] += y[c] * r0[0]; lg[1] += y[c] * r0[1]; lg[2] += y[c] * r0[2]; lg[3] += y[c] * r0[3]; lg[4] += y[c] * r1[0]; lg[5] += y[c] * r1[1]; lg[6] += y[c] * r1[2]; lg[7] += y[c] * r1[3]; } }
#pragma unroll
        for (int e = 0; e < NE; ++e) lg[e] = wave_sum(lg[e]);
        float mx = lg[0];
#pragma unroll
        for (int e = 1; e < NE; ++e) mx = fmaxf(mx, lg[e]);
        float pr[NE]; float sum = 0.f;
#pragma unroll
        for (int e = 0; e < NE; ++e) { pr[e] = expf(lg[e] - mx); sum += pr[e]; }
        int i1 = 0; float p1 = pr[0] / sum;
#pragma unroll
        for (int e = 1; e < NE; ++e) { const float pe = pr[e] / sum; if (pe > p1) { p1 = pe; i1 = e; } }
        int i2 = -1; float p2 = -1.f;
#pragma unroll
        for (int e = 0; e < NE; ++e) { const float pe = pr[e] / sum; if (e != i1 && pe > p2) { p2 = pe; i2 = e; } }
        if (lane == 0) {
            const unsigned q1 = __hip_atomic_fetch_add(lcnt + i1, 1u, __ATOMIC_RELAXED, __HIP_MEMORY_SCOPE_WORKGROUP), q2 = __hip_atomic_fetch_add(lcnt + i2, 1u, __ATOMIC_RELAXED, __HIP_MEMORY_SCOPE_WORKGROUP);
            eidx[row * 2] = i1; eidx[row * 2 + 1] = i2; egate[row * 2] = p1 / (p1 + p2); egate[row * 2 + 1] = p2 / (p1 + p2); tsl[row * 2] = (int)q1; tsl[row * 2 + 1] = (int)q2; }
    }
    __syncthreads();
    if (tid < NE) lbase[tid] = __hip_atomic_fetch_add(gcnt + 64 * tid, lcnt[tid], __ATOMIC_RELAXED, __HIP_MEMORY_SCOPE_AGENT);
    __syncthreads();
    if (lane == 0) for (int row = gw; row < M; row += ngw) { tsl[row * 2] += (int)lbase[eidx[row * 2]]; tsl[row * 2 + 1] += (int)lbase[eidx[row * 2 + 1]]; }
}
__device__ __forceinline__ void moe_offsets(const P& p, int (&offs)[NE + 1]) {
    const unsigned* gcnt = WSP(unsigned, OFF_CTL) + CW_GCNT; int o = 0;
#pragma unroll
    for (int e = 0; e < NE; ++e) { offs[e] = o; o += (int)((__hip_atomic_load(gcnt + 64 * e, __ATOMIC_RELAXED, __HIP_MEMORY_SCOPE_AGENT) + 255u) & ~255u); }
    offs[NE] = o;
}
__device__ __forceinline__ void op_moe_scatter(const P& p, const int tid) {
    const int lane = tid & 63, gw = blockIdx.x * (OPT_THREADS / 64) + (tid >> 6), ngw = gridDim.x * (OPT_THREADS / 64);
    int offs[NE + 1]; moe_offsets(p, offs);
    int* eidx = WSP(int, OFF_EIDX); float* egate = WSP(float, OFF_EGATE); int* tsl = WSP(int, OFF_TOKSLOT); float* gates = WSP(float, OFF_GATES);
    for (int pr = gw; pr < 2 * M; pr += ngw) {
        const int e = eidx[pr]; int ob = offs[0];
#pragma unroll
        for (int k = 1; k < NE; ++k) ob = (e == k) ? offs[k] : ob;
        const int srow = ob + tsl[pr];
        const U4* src = (const U4*)(WSP(bf16_t, OFF_XB) + (size_t)(pr >> 1) * D); U4* dst = (U4*)(WSP(bf16_t, OFF_XS) + (size_t)srow * D);
        const U4 a = src[lane], b = src[lane + 64]; dst[lane] = a; dst[lane + 64] = b;
        if (lane == 0) { gates[srow] = egate[pr]; }
        asm volatile("s_waitcnt vmcnt(0)" ::: "memory");
        if (lane == 0) tsl[pr] = srow;
    }
}
struct MoeOrder {
    int ts[NE + 1]; int nN, G, c;
    __device__ __forceinline__ void init(const int (&offs)[NE + 1], int nN_, int G_, int c_) {
#pragma unroll
        for (int e = 0; e <= NE; ++e) ts[e] = offs[e] >> 8;
        nN = nN_; G = G_; c = c_; }
    __device__ __forceinline__ bool next(int i, pg8::Unit& u) const {
        const int L = i * G + c; if (L >= ts[NE] * nN) return false;
        const int tau = L / nN, pn = L - tau * nN; int e = 0;
#pragma unroll
        for (int k = 1; k < NE; ++k) e += (tau >= ts[k]) ? 1 : 0;
        u.pm = tau; u.pn = e * nN + pn; return true; }
    __device__ __forceinline__ void a_ready(const pg8::Unit&) const {}
    __device__ __forceinline__ void done(const pg8::Unit&) const {}
};
struct EpiSwigluMoe {
    static constexpr bool PERM = true, AFTER_DRAIN = false;
    bf16_t* Hout; int ldh, nN;
    __device__ __forceinline__ void operator()(const f32x4 (&acc)[2][2][4][2], const pg8::Unit& u, int wr, int wc, int fr, int fq) const {
        const int rowb = u.pm * 256 + wr * 64 + fr; const int col = (u.pn % nN) * 128 + wc * 32 + 8 * fq;
#pragma unroll
        for (int ai = 0; ai < 2; ++ai)
#pragma unroll
            for (int m = 0; m < 4; ++m) { f32x4 h0, h1;
#pragma unroll
                for (int j = 0; j < 4; ++j) { const float a0 = acc[ai][0][m][0][j], a1 = acc[ai][0][m][1][j];
                    h0[j] = a0 * acc[ai][1][m][0][j] * __builtin_amdgcn_rcpf(1.0f + __expf(-a0)); h1[j] = a1 * acc[ai][1][m][1][j] * __builtin_amdgcn_rcpf(1.0f + __expf(-a1)); }
                *(U4*)(Hout + (size_t)(rowb + ai * 128 + m * 16) * ldh + col) = pack8(h0, h1); }
    }
};
struct EpiMoeDown {
    static constexpr bool PERM = true, AFTER_DRAIN = false;
    bf16_t* Y; const float* gates;
    __device__ __forceinline__ void operator()(const f32x4 (&acc)[2][2][4][2], const pg8::Unit& u, int wr, int wc, int fr, int fq) const {
        const int rowb = u.pm * 256 + wr * 64 + fr; const int col = (u.pn & 3) * 256 + wc * 32 + 8 * fq;
#pragma unroll
        for (int ai = 0; ai < 2; ++ai)
#pragma unroll
            for (int m = 0; m < 4; ++m) { const int row = rowb + ai * 128 + m * 16; const float gt = gates[row];
#pragma unroll
                for (int bj = 0; bj < 2; ++bj) *(U4*)(Y + (size_t)row * D + col + bj * 128) = pack8(acc[ai][bj][m][0] * gt, acc[ai][bj][m][1] * gt); }
    }
};
__device__ __forceinline__ void op_moe_up(const P& p, LAS unsigned char* lds, const int tid) {
    static_assert(D / 256 == 4, "EpiMoeDown: four column tiles");
    int offs[NE + 1]; moe_offsets(p, offs);
    pg8::Gemm g{WSP(bf16_t, OFF_XS), WSP(bf16_t, OFF_W_M13), ROWS_PAD, 2 * DFE, D};
    MoeOrder S; S.init(offs, 2 * DFE / 256, (int)gridDim.x, (int)blockIdx.x); EpiSwigluMoe E{WSP(bf16_t, OFF_HE), DFE, 2 * DFE / 256};
    pg8::gemm_phase<EpiSwigluMoe, MoeOrder, true, true>(lds, g, S, E, tid);
}
__device__ __forceinline__ void op_moe_down(const P& p, LAS unsigned char* lds, const int tid) {
    int offs[NE + 1]; moe_offsets(p, offs);
    pg8::Gemm g{WSP(bf16_t, OFF_HE), WSP(bf16_t, OFF_W_M2), ROWS_PAD, D, DFE};
    MoeOrder S; S.init(offs, D / 256, (int)gridDim.x, (int)blockIdx.x); EpiMoeDown E{WSP(bf16_t, OFF_XS), WSP(float, OFF_GATES)};
    pg8::gemm_phase<EpiMoeDown, MoeOrder, true, true>(lds, g, S, E, tid);
}
__device__ __forceinline__ void op_ln_moe(const P& p, const float* g, const float* bta, const int tid) {
    const int lane = tid & 63, gw = blockIdx.x * (OPT_THREADS / 64) + (tid >> 6), ngw = gridDim.x * (OPT_THREADS / 64);
    f32x4 gv[4], bv[4];
#pragma unroll
    for (int j = 0; j < 4; ++j) { gv[j] = ((const f32x4*)g)[lane + 64 * j]; bv[j] = ((const f32x4*)bta)[lane + 64 * j]; }
    const int* tsl = WSP(int, OFF_TOKSLOT);
    for (int row = gw; row < M; row += ngw) {
        f32x4* xr = (f32x4*)(p.out + (size_t)row * D) + lane; f32x4 v[4]; float s = 0.f;
        const unsigned long long* y0 = (const unsigned long long*)(WSP(bf16_t, OFF_XS) + (size_t)tsl[row * 2] * D) + lane;
        const unsigned long long* y1 = (const unsigned long long*)(WSP(bf16_t, OFF_XS) + (size_t)tsl[row * 2 + 1] * D) + lane;
#pragma unroll
        for (int j = 0; j < 4; ++j) { const unsigned long long a = y0[64 * j], b = y1[64 * j]; const unsigned al = (unsigned)a, ah = (unsigned)(a >> 32), bl = (unsigned)b, bh = (unsigned)(b >> 32);
            f32x4 f; f[0] = bf_lo(al) + bf_lo(bl); f[1] = bf_hi(al) + bf_hi(bl); f[2] = bf_lo(ah) + bf_lo(bh); f[3] = bf_hi(ah) + bf_hi(bh);
            v[j] = xr[64 * j] * ALPHA + f; s += (v[j][0] + v[j][1]) + (v[j][2] + v[j][3]); }
        const float mean = wave_sum(s) * (1.f / D); float s2 = 0.f;
#pragma unroll
        for (int j = 0; j < 4; ++j) { v[j] = v[j] - mean; s2 += (v[j][0] * v[j][0] + v[j][1] * v[j][1]) + (v[j][2] * v[j][2] + v[j][3] * v[j][3]); }
        const float rstd = 1.f / sqrtf(wave_sum(s2) * (1.f / D) + EPS);
#pragma unroll
        for (int j = 0; j < 4; ++j) xr[64 * j] = v[j] * rstd * gv[j] + bv[j];
    }
}

typedef pg8::bf16x8 bf16x8;
typedef float f32x16 __attribute__((ext_vector_type(16)));
typedef short s16x4 __attribute__((ext_vector_type(4)));
typedef unsigned v4u __attribute__((ext_vector_type(4)));
constexpr int AT_KBUF = 64 * 208, AT_VSTR = 144, AT_VBUF = 64 * AT_VSTR;
constexpr int AT_K0 = 0, AT_V0 = 2 * AT_KBUF, AT_BIAS = AT_V0 + 2 * AT_VBUF, AT_WS = AT_BIAS + 512, AT_WSB = 3072, AT_OST = AT_WS + 8 * AT_WSB, AT_OSTB = 32 * 272, AT_MISC = AT_OST + 8 * AT_OSTB;
static_assert(AT_MISC + 256 <= LDS_BYTES, "attention LDS map");
constexpr int CW_QHEAD = 8192;
constexpr int N_ATT_UNITS = NB * 6 * (S / 256) * 2 + NB * (S / 64);
constexpr float AT_THR = 4.0f, AT_NEG = -1.0e30f;
enum { AM_MLA = 0, AM_FOX = 1, AM_SEL = 2, AM_WIN = 3, AM_CMP = 4 };

__device__ __forceinline__ float xhalf_max(float v) { auto rr = __builtin_amdgcn_permlane32_swap(__float_as_uint(v), __float_as_uint(v), false, false); return fmaxf(__uint_as_float(rr[0]), __uint_as_float(rr[1])); }
__device__ __forceinline__ float xhalf_sum(float v) { auto rr = __builtin_amdgcn_permlane32_swap(__float_as_uint(v), __float_as_uint(v), false, false); return __uint_as_float(rr[0]) + __uint_as_float(rr[1]); }
__device__ __forceinline__ s16x4 vtr(LAS const unsigned char* p) { typedef short v4i16_t __attribute__((ext_vector_type(4))); return __builtin_bit_cast(s16x4, __builtin_amdgcn_ds_read_tr16_b64_v4i16((LAS v4i16_t*)p)); }
__device__ __forceinline__ int crow_c(int r) { return (r & 3) + 8 * (r >> 2); }

template <int DK> struct TileRegs { v4u k0, k1, v0; float bias; };
template <int DK, bool BIAS> __device__ __forceinline__ void tile_load(TileRegs<DK>& R, const bf16_t* Kg, int kpitch, const bf16_t* Vg, int vpitch, const float* Bg, int tile, int tid) {
    constexpr int CPR = DK / 8;
    { const int key = tid / CPR, part = tid % CPR; R.k0 = *(const v4u*)(Kg + (size_t)(tile * 64 + key) * kpitch + part * 8); }
    if (DK == 96) { if (tid < 256) { const int c2 = tid + 512, key = c2 / CPR, part = c2 % CPR; R.k1 = *(const v4u*)(Kg + (size_t)(tile * 64 + key) * kpitch + part * 8); } }
    R.v0 = *(const v4u*)(Vg + (size_t)(tile * 64 + (tid >> 3)) * vpitch + (tid & 7) * 8);
    if (BIAS) { if (tid < 64) R.bias = Bg[tile * 64 + tid]; }
}
template <int DK, bool BIAS> __device__ __forceinline__ void tile_store(const TileRegs<DK>& R, LAS unsigned char* lds, int buf, int tid) {
    constexpr int CPR = DK / 8, KSTR = DK * 2 + 16;
    { const int key = tid / CPR, part = tid % CPR; *(LAS v4u*)(lds + AT_K0 + buf * AT_KBUF + key * KSTR + part * 16) = R.k0; }
    if (DK == 96) { if (tid < 256) { const int c2 = tid + 512, key = c2 / CPR, part = c2 % CPR; *(LAS v4u*)(lds + AT_K0 + buf * AT_KBUF + key * KSTR + part * 16) = R.k1; } }
    *(LAS v4u*)(lds + AT_V0 + buf * AT_VBUF + (tid >> 3) * AT_VSTR + (tid & 7) * 16) = R.v0;
    if (BIAS) { if (tid < 64) *(LAS float*)(lds + AT_BIAS + buf * 256 + tid * 4) = R.bias; }
}
template <int DK> __device__ __forceinline__ void tile_scores(LAS const unsigned char* lds, int buf, const bf16x8 (&qr)[DK / 16], f32x16& p0, f32x16& p1, int lane) {
    constexpr int KSTR = DK * 2 + 16;
    LAS const unsigned char* Kb = lds + AT_K0 + buf * AT_KBUF + (lane & 31) * KSTR + (lane >> 5) * 16;
#pragma unroll
    for (int r = 0; r < 16; ++r) { p0[r] = 0.f; p1[r] = 0.f; }
#pragma unroll
    for (int d0 = 0; d0 < DK / 16; ++d0) { const bf16x8 a0 = *(LAS const bf16x8*)(Kb + d0 * 32), a1 = *(LAS const bf16x8*)(Kb + 32 * KSTR + d0 * 32);
        p0 = __builtin_amdgcn_mfma_f32_32x32x16_bf16(a0, qr[d0], p0, 0, 0, 0); p1 = __builtin_amdgcn_mfma_f32_32x32x16_bf16(a1, qr[d0], p1, 0, 0, 0); }
}
template <int MODE> __device__ __forceinline__ void tile_bias_mask(LAS const unsigned char* lds, int buf, f32x16& p0, f32x16& p1, int lane, int kbase, int qpos, float rowf, bool rowsel, bool need_mask) {
    const int hi = lane >> 5;
    if (MODE == AM_FOX) { LAS const float* cb = (LAS const float*)(lds + AT_BIAS + buf * 256) + 4 * hi;
#pragma unroll
        for (int i = 0; i < 4; ++i) { const f32x4 c0 = *(LAS const f32x4*)(cb + 8 * i), c1 = *(LAS const f32x4*)(cb + 32 + 8 * i);
#pragma unroll
            for (int j = 0; j < 4; ++j) { p0[4 * i + j] += rowf - c0[j]; p1[4 * i + j] += rowf - c1[j]; } } }
    if (MODE == AM_SEL || MODE == AM_WIN || MODE == AM_CMP) { const float kf = (float)(kbase + 4 * hi);
#pragma unroll
        for (int r = 0; r < 16; ++r) { p0[r] = fmaf(rowf, kf + (float)crow_c(r), p0[r]); p1[r] = fmaf(rowf, kf + (float)(32 + crow_c(r)), p1[r]); } }
    if (need_mask) { const int k0 = kbase + 4 * hi;
#pragma unroll
        for (int r = 0; r < 16; ++r) { const int ka = k0 + crow_c(r), kb = ka + 32; bool oa = ka <= qpos, ob = kb <= qpos;
            if (MODE == AM_WIN) { oa = oa && (ka >= qpos - 255); ob = ob && (kb >= qpos - 255); }
            if (MODE == AM_SEL) { oa = oa && rowsel; ob = ob && rowsel; }
            p0[r] = oa ? p0[r] : AT_NEG; p1[r] = ob ? p1[r] : AT_NEG; } }
}
__device__ __forceinline__ void tile_softmax_pv(LAS const unsigned char* lds, int buf, f32x16& p0, f32x16& p1, f32x16 (&o)[2], float& m, float& l, LAS float* wsf, int lane) {
    const int r32 = lane & 31, hi = lane >> 5;
    float rm = fmaxf(p0[0], p1[0]);
#pragma unroll
    for (int r = 1; r < 16; ++r) rm = fmaxf(rm, fmaxf(p0[r], p1[r]));
    rm = xhalf_max(rm);
    const bool need = rm > m + AT_THR;
    if (__any(need)) {
        const float mn = need ? rm : m; const float alpha = __builtin_amdgcn_exp2f(m - mn); m = mn; l *= alpha;
        if (hi == 0) wsf[r32] = alpha;
#pragma unroll
        for (int i = 0; i < 4; ++i) { const f32x4 a = *(LAS const f32x4*)(wsf + 8 * i + 4 * hi);
#pragma unroll
            for (int j = 0; j < 4; ++j) { o[0][4 * i + j] *= a[j]; o[1][4 * i + j] *= a[j]; } }
    }
    float rs = 0.f;
#pragma unroll
    for (int r = 0; r < 16; ++r) { p0[r] = __builtin_amdgcn_exp2f(p0[r] - m); p1[r] = __builtin_amdgcn_exp2f(p1[r] - m); rs += p0[r] + p1[r]; }
    l += rs;
    v4u w0, w1, w2, w3;
    w0[0] = pk2(p0[0], p0[1]); w0[1] = pk2(p0[2], p0[3]); w0[2] = pk2(p0[4], p0[5]); w0[3] = pk2(p0[6], p0[7]);
    w1[0] = pk2(p0[8], p0[9]); w1[1] = pk2(p0[10], p0[11]); w1[2] = pk2(p0[12], p0[13]); w1[3] = pk2(p0[14], p0[15]);
    w2[0] = pk2(p1[0], p1[1]); w2[1] = pk2(p1[2], p1[3]); w2[2] = pk2(p1[4], p1[5]); w2[3] = pk2(p1[6], p1[7]);
    w3[0] = pk2(p1[8], p1[9]); w3[1] = pk2(p1[10], p1[11]); w3[2] = pk2(p1[12], p1[13]); w3[3] = pk2(p1[14], p1[15]);
    const bf16x8 pa[4] = {__builtin_bit_cast(bf16x8, w0), __builtin_bit_cast(bf16x8, w1), __builtin_bit_cast(bf16x8, w2), __builtin_bit_cast(bf16x8, w3)};
    LAS const unsigned char* Vb = lds + AT_V0 + buf * AT_VBUF + (4 * hi + ((lane & 15) >> 2)) * AT_VSTR + (((lane >> 4) & 1) * 16 + (lane & 3) * 4) * 2;
#pragma unroll
    for (int d0 = 0; d0 < 2; ++d0)
#pragma unroll
        for (int ks = 0; ks < 4; ++ks) { const s16x4 lo = vtr(Vb + (16 * ks) * AT_VSTR + d0 * 64), h4 = vtr(Vb + (16 * ks + 8) * AT_VSTR + d0 * 64);
            const bf16x8 vf = {lo[0], lo[1], lo[2], lo[3], h4[0], h4[1], h4[2], h4[3]};
            o[d0] = __builtin_amdgcn_mfma_f32_32x32x16_bf16(pa[ks], vf, o[d0], 0, 0, 0); }
}
template <bool ADD> __device__ __forceinline__ void rows_scale(f32x16 (&o)[2], f32x16 (&acc)[2], float f, LAS float* wsf, int lane) {
    const int r32 = lane & 31, hi = lane >> 5;
    if (hi == 0) wsf[r32] = f;
#pragma unroll
    for (int i = 0; i < 4; ++i) { const f32x4 a = *(LAS const f32x4*)(wsf + 8 * i + 4 * hi);
#pragma unroll
        for (int j = 0; j < 4; ++j) { if (ADD) { acc[0][4 * i + j] += a[j] * o[0][4 * i + j]; acc[1][4 * i + j] += a[j] * o[1][4 * i + j]; } else { o[0][4 * i + j] *= a[j]; o[1][4 * i + j] *= a[j]; } } }
}
__device__ __forceinline__ void out_store(const f32x16 (&o)[2], LAS unsigned char* stg, bf16_t* dst0, int lane, int mode_nsa) {
    const int r32 = lane & 31, hi = lane >> 5;
#pragma unroll
    for (int r = 0; r < 16; ++r) { const int orow = crow_c(r) + 4 * hi;
        *(LAS bf16_t*)(stg + orow * 144 + r32 * 2) = (bf16_t)(pk2(o[0][r], 0.f) & 0xffffu); *(LAS bf16_t*)(stg + orow * 144 + 64 + r32 * 2) = (bf16_t)(pk2(o[1][r], 0.f) & 0xffffu); }
#pragma unroll
    for (int i = 0; i < 4; ++i) { const int row = i * 8 + (lane >> 3), ch = lane & 7; const v4u v = *(LAS const v4u*)(stg + row * 144 + ch * 16);
        const size_t off = mode_nsa ? ((size_t)(row >> 2) * MIXW + (row & 3) * 64) : (size_t)row * MIXW;
        *(v4u*)(dst0 + off + ch * 8) = v; }
}

template <bool FIRST> __device__ __forceinline__ void rows_accum_lds(const f32x16 (&o)[2], float f, LAS float* wsf, LAS float* img, int lane) {
    const int r32 = lane & 31, hi = lane >> 5;
    if (hi == 0) wsf[r32] = f;
#pragma unroll
    for (int i = 0; i < 4; ++i) { const f32x4 a = *(LAS const f32x4*)(wsf + 8 * i + 4 * hi);
#pragma unroll
        for (int j = 0; j < 4; ++j) { LAS float* q = img + (8 * i + 4 * hi + j) * 68 + r32;
            if (FIRST) { q[0] = a[j] * o[0][4 * i + j]; q[32] = a[j] * o[1][4 * i + j]; } else { q[0] += a[j] * o[0][4 * i + j]; q[32] += a[j] * o[1][4 * i + j]; } } }
}
__device__ __forceinline__ void out_store_img(LAS const float* img, bf16_t* dst0, int lane) {
#pragma unroll
    for (int i = 0; i < 4; ++i) { const int row = i * 8 + (lane >> 3), ch = lane & 7; const f32x4 a = *(LAS const f32x4*)(img + row * 68 + ch * 8), b = *(LAS const f32x4*)(img + row * 68 + ch * 8 + 4);
        *(U4*)(dst0 + (size_t)(row >> 2) * MIXW + (row & 3) * 64 + ch * 8) = pack8(a, b); }
}

template <int DK, int MODE> __device__ __forceinline__ void attn_unit_causal(const P& p, LAS unsigned char* lds, int b, int h, int qb, const int tid) {
    const int lane = tid & 63, wave = __builtin_amdgcn_readfirstlane(tid >> 6), r32 = lane & 31, hi = lane >> 5;
    constexpr bool BIAS = (MODE == AM_FOX);
    const int qpitch = (MODE == AM_MLA) ? 576 : 384, hoff = (MODE == AM_MLA) ? h * 96 : h * 64;
    const bf16_t* Qg = WSP(bf16_t, MODE == AM_MLA ? OFF_QM : OFF_FQ) + (size_t)b * S * qpitch + hoff;
    const bf16_t* Kg = WSP(bf16_t, MODE == AM_MLA ? OFF_KM : OFF_FK) + (size_t)b * S * qpitch + hoff;
    const bf16_t* Vg = WSP(bf16_t, MODE == AM_MLA ? OFF_VM : OFF_FV) + (size_t)b * S * 384 + h * 64;
    const float* Bg = WSP(float, OFF_FC) + ((size_t)b * 6 + h) * S;
    const int q0w = qb * 256 + wave * 32, qpos = q0w + r32;
    bf16x8 qr[DK / 16];
#pragma unroll
    for (int d0 = 0; d0 < DK / 16; ++d0) qr[d0] = *(const bf16x8*)(Qg + (size_t)qpos * qpitch + d0 * 16 + hi * 8);
    const float rowf = BIAS ? Bg[qpos] : 0.f;
    LAS float* wsf = (LAS float*)(lds + AT_WS + wave * AT_WSB);
    f32x16 o[2]; float m = AT_NEG, l = 0.f;
#pragma unroll
    for (int r = 0; r < 16; ++r) { o[0][r] = 0.f; o[1][r] = 0.f; }
    const int nt = 4 * (qb + 1);
    TileRegs<DK> R; tile_load<DK, BIAS>(R, Kg, qpitch, Vg, 384, Bg, 0, tid); tile_store<DK, BIAS>(R, lds, 0, tid);
    __syncthreads();
    for (int t = 0; t < nt; ++t) {
        const int buf = t & 1;
        if (t + 1 < nt) tile_load<DK, BIAS>(R, Kg, qpitch, Vg, 384, Bg, t + 1, tid);
        if (t * 64 <= q0w + 31) {
            f32x16 p0, p1; tile_scores<DK>(lds, buf, qr, p0, p1, lane);
            tile_bias_mask<MODE>(lds, buf, p0, p1, lane, t * 64, qpos, rowf, true, t * 64 + 63 > q0w);
            tile_softmax_pv(lds, buf, p0, p1, o, m, l, wsf, lane);
        }
        if (t + 1 < nt) tile_store<DK, BIAS>(R, lds, buf ^ 1, tid);
        __syncthreads();
    }
    const float inv = 1.0f / xhalf_sum(l);
    rows_scale<false>(o, o, inv, wsf, lane);
    out_store(o, lds + AT_OST + wave * AT_OSTB, WSP(bf16_t, OFF_MIX) + (size_t)(b * S + q0w) * MIXW + (MODE == AM_MLA ? 0 : 384) + h * 64, lane, 0);
}

template <int MODE> __device__ __forceinline__ void nsa_branch_tiles(const P& p, LAS unsigned char* lds, const bf16_t* Kg, const bf16_t* Vg, unsigned tmask, const bf16x8 (&qr)[4], f32x16 (&o)[2], float& m, float& l,
                                                                     LAS float* wsf, int lane, int tid, int qpos, float rowf, unsigned selmask) {
    TileRegs<64> R; unsigned rem = tmask; int cur = __builtin_ctz(rem); rem &= rem - 1u; int buf = 0;
    tile_load<64, false>(R, Kg, 64, Vg, 64, nullptr, cur, tid); tile_store<64, false>(R, lds, 0, tid);
    __syncthreads();
    for (;;) {
        const int nxt = rem ? __builtin_ctz(rem) : -1; rem &= rem - 1u;
        if (nxt >= 0) tile_load<64, false>(R, Kg, 64, Vg, 64, nullptr, nxt, tid);
        { f32x16 p0, p1; tile_scores<64>(lds, buf, qr, p0, p1, lane);
          tile_bias_mask<MODE>(lds, buf, p0, p1, lane, cur * 64, qpos, rowf, ((selmask >> cur) & 1u) != 0u, true);
          tile_softmax_pv(lds, buf, p0, p1, o, m, l, wsf, lane); }
        if (nxt >= 0) tile_store<64, false>(R, lds, buf ^ 1, tid);
        __syncthreads();
        if (nxt < 0) break;
        cur = nxt; buf ^= 1;
    }
}
__device__ __forceinline__ void attn_unit_nsa(const P& p, LAS unsigned char* lds, int b, int tb, const int tid) {
    static_assert(S == 2048, "NSA unit: 32 selection blocks, 128 compressed keys");
    const int lane = tid & 63, wave = __builtin_amdgcn_readfirstlane(tid >> 6), r32 = lane & 31, hi = lane >> 5;
    const int tok0 = tb * 64 + wave * 8, t = tok0 + (r32 >> 2), hd = r32 & 3;
    const size_t rowg = (size_t)b * S + t;
    const float sl2 = LOG2E * (hd == 0 ? 0.25f : hd == 1 ? 0.0625f : hd == 2 ? 0.015625f : 0.00390625f);
    bf16x8 qr[4];
#pragma unroll
    for (int d0 = 0; d0 < 4; ++d0) qr[d0] = *(const bf16x8*)(WSP(bf16_t, OFF_NQ) + rowg * 256 + hd * 64 + d0 * 16 + hi * 8);
    const float* ng = WSP(float, OFF_NG) + rowg * 16 + hd * 3;
    const float g0 = 1.0f / (1.0f + __expf(-ng[0])), g1 = 1.0f / (1.0f + __expf(-ng[1])), g2 = 1.0f / (1.0f + __expf(-ng[2]));
    LAS float* wsf = (LAS float*)(lds + AT_WS + wave * AT_WSB); LAS float* Gs = wsf + 32; LAS float* Lx = wsf + 32 + 256; LAS unsigned* msk = (LAS unsigned*)(wsf + 32 + 256 + 8 * 33);
    LAS unsigned* umask = (LAS unsigned*)(lds + AT_MISC + 64);
    LAS float* img = (LAS float*)(lds + AT_OST + wave * AT_OSTB);
    f32x16 o[2];
#pragma unroll
    for (int r = 0; r < 16; ++r) { o[0][r] = 0.f; o[1][r] = 0.f; }
    const int nmax = t >= 31 ? (t - 31) >> 4 : -1;
    const bool two = tb >= 16;
    const bf16_t* KCg = WSP(bf16_t, OFF_KCC) + (size_t)b * CMPP * 64; const bf16_t* VCg = WSP(bf16_t, OFF_VCC) + (size_t)b * CMPP * 64;
    { TileRegs<64> R; tile_load<64, false>(R, KCg, 64, VCg, 64, nullptr, 0, tid); tile_store<64, false>(R, lds, 0, tid);
      if (two) { tile_load<64, false>(R, KCg, 64, VCg, 64, nullptr, 1, tid); tile_store<64, false>(R, lds, 1, tid); } }
    for (int i = lane; i < 256 + 8 * 33; i += 64) Gs[i] = 0.f;
    __syncthreads();
    float mc = AT_NEG, lc = 0.f;
    { f32x16 p0, p1; tile_scores<64>(lds, 0, qr, p0, p1, lane); tile_bias_mask<AM_CMP>(lds, 0, p0, p1, lane, 0, nmax, 16.f * sl2, true, true); tile_softmax_pv(lds, 0, p0, p1, o, mc, lc, wsf, lane); }
    if (two) { f32x16 p0, p1; tile_scores<64>(lds, 1, qr, p0, p1, lane); tile_bias_mask<AM_CMP>(lds, 1, p0, p1, lane, 64, nmax, 16.f * sl2, true, true); tile_softmax_pv(lds, 1, p0, p1, o, mc, lc, wsf, lane); }
    const float lct = xhalf_sum(lc); const float invc = (t >= 31) ? 1.0f / lct : 0.f;
    rows_accum_lds<true>(o, g0 * invc, wsf, img, lane);
#pragma unroll
    for (int tau = 0; tau < 2; ++tau) {
        if (tau == 1 && !two) break;
        f32x16 p0, p1; tile_scores<64>(lds, tau, qr, p0, p1, lane); tile_bias_mask<AM_CMP>(lds, tau, p0, p1, lane, 64 * tau, nmax, 16.f * sl2, true, true);
#pragma unroll
        for (int half = 0; half < 2; ++half)
#pragma unroll
            for (int i = 0; i < 4; ++i) { float e[4];
#pragma unroll
                for (int j = 0; j < 4; ++j) e[j] = __builtin_amdgcn_exp2f((half ? p1[4 * i + j] : p0[4 * i + j]) - mc) * invc;
                float gsum = (e[0] + e[1]) + (e[2] + e[3]), last = e[3];
                gsum += __shfl_xor(gsum, 1); gsum += __shfl_xor(gsum, 2); last += __shfl_xor(last, 1); last += __shfl_xor(last, 2);
                const int j = 16 * tau + 8 * half + 2 * i + hi;
                if (hd == 0) { Gs[(r32 >> 2) * 32 + j] = gsum; Lx[(r32 >> 2) * 33 + j + 1] = last; } }
    }
    { const int tl = lane >> 3, jq = lane & 7, tt = tok0 + tl, cur = tt >> 6; float mine[4]; int rank[4] = {0, 0, 0, 0};
#pragma unroll
      for (int c = 0; c < 4; ++c) { const int j = 4 * jq + c; float v = Gs[tl * 32 + j] + Lx[tl * 33 + j];
          v = (j == 0 || j == cur || j == cur - 1) ? 1.0e4f : (j > cur ? -1.0f : v); mine[c] = v; }
#pragma nounroll
      for (int k = 0; k < 32; ++k) { float u = Gs[tl * 32 + k] + Lx[tl * 33 + k]; u = (k == 0 || k == cur || k == cur - 1) ? 1.0e4f : (k > cur ? -1.0f : u);
#pragma unroll
          for (int c = 0; c < 4; ++c) rank[c] += (u > mine[c] || (u == mine[c] && k < 4 * jq + c)) ? 1 : 0; }
      unsigned bits = 0u;
#pragma unroll
      for (int c = 0; c < 4; ++c) bits |= (rank[c] < 8 ? 1u : 0u) << (4 * jq + c);
      bits |= __shfl_xor(bits, 1); bits |= __shfl_xor(bits, 2); bits |= __shfl_xor(bits, 4);
      if (jq == 0) msk[tl] = bits;
      unsigned ub = bits; ub |= __shfl_xor(ub, 8); ub |= __shfl_xor(ub, 16); ub |= __shfl_xor(ub, 32);
      if (lane == 0) umask[wave] = ub; }
    const unsigned selmask = msk[r32 >> 2];
    __syncthreads();
    unsigned U = 0u;
#pragma unroll
    for (int w = 0; w < 8; ++w) U |= umask[w];
    U &= (tb == 31) ? 0xffffffffu : ((2u << tb) - 1u);
    U = __builtin_amdgcn_readfirstlane(U);
    { float ms = AT_NEG, ls = 0.f;
#pragma unroll
      for (int r = 0; r < 16; ++r) { o[0][r] = 0.f; o[1][r] = 0.f; }
      nsa_branch_tiles<AM_SEL>(p, lds, WSP(bf16_t, OFF_KS) + (size_t)b * S * 64, WSP(bf16_t, OFF_VS) + (size_t)b * S * 64, U, qr, o, ms, ls, wsf, lane, tid, t, sl2, selmask);
      rows_accum_lds<false>(o, g1 / xhalf_sum(ls), wsf, img, lane); }
    { float mw = AT_NEG, lw = 0.f;
#pragma unroll
      for (int r = 0; r < 16; ++r) { o[0][r] = 0.f; o[1][r] = 0.f; }
      const int lo = tb >= 4 ? tb - 4 : 0; const unsigned W = ((tb == 31) ? 0xffffffffu : ((2u << tb) - 1u)) & ~((1u << lo) - 1u);
      nsa_branch_tiles<AM_WIN>(p, lds, WSP(bf16_t, OFF_KW) + (size_t)b * S * 64, WSP(bf16_t, OFF_VW) + (size_t)b * S * 64, W, qr, o, mw, lw, wsf, lane, tid, t, sl2, 0xffffffffu);
      rows_accum_lds<false>(o, g2 / xhalf_sum(lw), wsf, img, lane); }
    out_store_img(img, WSP(bf16_t, OFF_MIX) + (size_t)(b * S + tok0) * MIXW + 768, lane);
}

__device__ __forceinline__ int att_unit_cost(int id) {
    const int type = id >> 16, qb = id & 31;
    if (type == 0) return 4 * (qb + 1) * 20; if (type == 1) return 4 * (qb + 1) * 16;
    return ((qb >= 16 ? 4 : 2) + (qb + 1) + (qb < 4 ? qb + 1 : 5)) * 16 + 24;
}
__device__ __forceinline__ int att_unit_id(int i) {
    if (i < NB * 6 * 8) { const int qb = i & 7, h = (i >> 3) % 6, b = i / 48; return (0 << 16) | (b << 8) | (h << 5) | qb; }
    i -= NB * 6 * 8;
    if (i < NB * 6 * 8) { const int qb = i & 7, h = (i >> 3) % 6, b = i / 48; return (1 << 16) | (b << 8) | (h << 5) | qb; }
    i -= NB * 6 * 8; return (2 << 16) | ((i >> 5) << 8) | (i & 31);
}
__device__ __forceinline__ void build_att_list(const P& p, int gw, int ngw, int lane) {
    int* list = WSP(int, OFF_ATTLIST);
    for (int i = gw; i < N_ATT_UNITS; i += ngw) { const int id = att_unit_id(i), c = att_unit_cost(id); int rank = 0;
        for (int k = lane; k < N_ATT_UNITS; k += 64) { const int ck = att_unit_cost(att_unit_id(k)); rank += (ck > c || (ck == c && k < i)) ? 1 : 0; }
#pragma unroll
        for (int o = 1; o < 64; o <<= 1) rank += __shfl_xor(rank, o);
        if (lane == 0) list[rank] = id; }
}
__device__ __forceinline__ void op_attn(const P& p, int layer, LAS unsigned char* lds, const int tid0) {
    const int* list = WSP(int, OFF_ATTLIST); unsigned* qhead = WSP(unsigned, OFF_CTL) + CW_QHEAD + 64 * layer; LAS int* slot = (LAS int*)(lds + AT_MISC);
    for (;;) {
        if (tid0 == 0) *slot = (int)__hip_atomic_fetch_add(qhead, 1u, __ATOMIC_RELAXED, __HIP_MEMORY_SCOPE_AGENT);
        __syncthreads();
        const int idx = __builtin_amdgcn_readfirstlane(*slot);
        __syncthreads();
        if (idx >= N_ATT_UNITS) break;
        const int id = __builtin_amdgcn_readfirstlane(list[idx]); const int type = id >> 16, b = (id >> 8) & 255, h = (id >> 5) & 7, qb = id & 31;
        int tidv = tid0; asm volatile("" : "+v"(tidv));
        if (type == 0) attn_unit_causal<96, AM_MLA>(p, lds, b, h, qb, tidv);
        else if (type == 1) attn_unit_causal<64, AM_FOX>(p, lds, b, h, qb, tidv);
        else attn_unit_nsa(p, lds, b, qb, tidv);
        __syncthreads();
    }
}

__device__ __forceinline__ void op_fox_scan(const P& p, int layer, int tid) {
    static_assert(S == 2048, "op_fox_scan: 32 steps per lane");
    const int lane = tid & 63, gw = (int)(gridDim.x * 8 - 1) - (int)(blockIdx.x * 8 + (tid >> 6));
    if (gw >= NB * 6) return;
    const int b = gw / 6, h = gw % 6; const float bias = p.b_forget[layer * 6 + h];
    const float* fl = WSP(float, OFF_FL) + ((size_t)b * S + 32 * lane) * 8 + h; float* fc = WSP(float, OFF_FC) + ((size_t)b * 6 + h) * S + 32 * lane;
    float ls[32]; float run = 0.f;
#pragma unroll
    for (int i = 0; i < 32; ++i) { const float xv = fl[i * 8] + bias; ls[i] = fminf(xv, 0.f) - log1pf(__expf(-fabsf(xv))); run += ls[i]; }
    float inc = run;
#pragma unroll
    for (int o = 1; o < 64; o <<= 1) { const float v = __shfl_up(inc, o); if (lane >= o) inc += v; }
    float c = inc - run;
#pragma unroll
    for (int i = 0; i < 32; ++i) { c += ls[i]; fc[i] = c * LOG2E; }
}
__device__ __forceinline__ void op_compress(const P& p, int layer, LAS unsigned char* lds, int tid) {
    const int lane = tid & 63, wave = __builtin_amdgcn_readfirstlane(tid >> 6), r32 = lane & 31, hi = lane >> 5, wc = wave & 3, kh = wave >> 2;
    LAS float* part = (LAS float*)lds;
    LAS bf16_t* hids = (LAS bf16_t*)(lds + 32 * 132 * 4);
    for (int u = blockIdx.x; u < 2 * (NB * CMPP / 32); u += gridDim.x) {
        const int wch = u & 1, rt = u >> 1;
        const bf16_t* A = WSP(bf16_t, wch ? OFF_VCR : OFF_KCR) + (size_t)(32 * rt + r32) * 1024 + kh * 1024 + hi * 8;
        const bf16_t* B = WSP(bf16_t, OFF_W_C1) + ((size_t)(layer * 2 + wch) * 128 + 32 * wc + r32) * 2048 + kh * 1024 + hi * 8;
        f32x16 acc;
#pragma unroll
        for (int r = 0; r < 16; ++r) acc[r] = 0.f;
#pragma unroll 8
        for (int ks = 0; ks < 64; ++ks) { const bf16x8 a = *(const bf16x8*)(A + ks * 16), bb = *(const bf16x8*)(B + ks * 16); acc = __builtin_amdgcn_mfma_f32_32x32x16_bf16(a, bb, acc, 0, 0, 0); }
        if (kh == 1) {
#pragma unroll
            for (int r = 0; r < 16; ++r) part[(crow_c(r) + 4 * hi) * 132 + 32 * wc + r32] = acc[r]; }
        __syncthreads();
        if (kh == 0) { const float cb = WSP(float, OFF_CBIAS)[(layer * 2 + wch) * 128 + 32 * wc + r32];
#pragma unroll
            for (int r = 0; r < 16; ++r) { const int row = crow_c(r) + 4 * hi; const float v = acc[r] + part[row * 132 + 32 * wc + r32] + cb;
                hids[row * 136 + 32 * wc + r32] = (bf16_t)(pk2(v * __builtin_amdgcn_rcpf(1.0f + __expf(-v)), 0.f) & 0xffffu); } }
        __syncthreads();
        if (wave < 2) {
            const bf16_t* W2 = WSP(bf16_t, OFF_W_C2) + ((size_t)(layer * 2 + wch) * 64 + 32 * wave + r32) * 128 + hi * 8;
            f32x16 o2;
#pragma unroll
            for (int r = 0; r < 16; ++r) o2[r] = 0.f;
#pragma unroll
            for (int ks = 0; ks < 8; ++ks) { const bf16x8 a = *(LAS const bf16x8*)(hids + r32 * 136 + ks * 16 + hi * 8), bb = *(const bf16x8*)(W2 + ks * 16); o2 = __builtin_amdgcn_mfma_f32_32x32x16_bf16(a, bb, o2, 0, 0, 0); }
            bf16_t* dst = WSP(bf16_t, wch ? OFF_VCC : OFF_KCC) + (size_t)(32 * rt) * 64 + 32 * wave + r32;
#pragma unroll
            for (int r = 0; r < 16; ++r) dst[(crow_c(r) + 4 * hi) * 64] = (bf16_t)(pk2(o2[r], 0.f) & 0xffffu);
        }
        __syncthreads();
    }
}

#define TIDV(t) int t = threadIdx.x; asm volatile("" : "+v"(t))
template <int LAYER> __device__ __forceinline__ void mega_layer(const P& p, LAS unsigned char* lds, const XcdBarrier& bar) {
    { TIDV(t); op_inproj(p, LAYER, lds, t); } xcd_barrier(bar);
    { TIDV(t); op_compress(p, LAYER, lds, t); op_fox_scan(p, LAYER, t); }
    { TIDV(t); op_mla_qup(p, LAYER, lds, t); }
    { TIDV(t); op_mla_kvup(p, LAYER, lds, t); } xcd_barrier(bar);
    { TIDV(t); op_attn(p, LAYER, lds, t); } xcd_barrier(bar);
    { TIDV(t); op_wout(p, LAYER, lds, t); } xcd_barrier(bar);
    if (LAYER == 0) {
        { TIDV(t); op_ln(p, p.ln1g + LAYER * D, p.ln1b + LAYER * D, t); } xcd_barrier(bar);
        { TIDV(t); op_ffn_up(p, lds, t); } xcd_barrier(bar);
        { TIDV(t); op_ffn_down(p, lds, t); } xcd_barrier(bar);
        { TIDV(t); op_ln(p, p.ln2g + LAYER * D, p.ln2b + LAYER * D, t); } xcd_barrier(bar);
    } else {
        { TIDV(t); op_ln_router(p, p.ln1g + LAYER * D, p.ln1b + LAYER * D, lds, t); } xcd_barrier(bar);
        { TIDV(t); op_moe_scatter(p, t); } xcd_barrier(bar);
        { TIDV(t); op_moe_up(p, lds, t); } xcd_barrier(bar);
        { TIDV(t); op_moe_down(p, lds, t); } xcd_barrier(bar);
        { TIDV(t); op_ln_moe(p, p.ln2g + LAYER * D, p.ln2b + LAYER * D, t); }
    }
}
__global__ void __launch_bounds__(OPT_THREADS, 2) mega(P p) {
    extern __shared__ __attribute__((aligned(16))) unsigned char smem[];
    LAS unsigned char* lds = (LAS unsigned char*)smem;
    volatile LAS unsigned* xbw = (volatile LAS unsigned*)(lds + LDS_BYTES - 64);
    if (threadIdx.x < 4) xbw[threadIdx.x] = 0u;
    __syncthreads();
    XcdBarrier bar = xcd_barrier_post((unsigned*)(p.ws + OFF_CTL), xbw);
    { TIDV(t); op_prologue(p, lds, t); } xcd_barrier(bar);
    mega_layer<0>(p, lds, bar);
    mega_layer<1>(p, lds, bar);
}

extern "C" void kernel_launch(void* const* d_in, const int* in_sizes, int n_in, void* d_out, int out_size, void* d_ws, size_t ws_size, hipStream_t stream) {
    P p{};
    const float** pp = (const float**)&p;
    for (int i = 0; i < 25; ++i) pp[i] = (const float*)d_in[i];
    p.out = (float*)d_out; p.ws = (unsigned char*)d_ws;
    if (ws_size < WS_NEEDED) return;
    static int grid = 0;
    if (!grid) {
        int dev = 0, cus = 0, per_cu = 0;
        (void)hipGetDevice(&dev);
        (void)hipDeviceGetAttribute(&cus, hipDeviceAttributeMultiprocessorCount, dev);
        (void)hipFuncSetAttribute((const void*)mega, hipFuncAttributeMaxDynamicSharedMemorySize, LDS_BYTES);
        (void)hipOccupancyMaxActiveBlocksPerMultiprocessor(&per_cu, (const void*)mega, OPT_THREADS, LDS_BYTES);
        (void)hipGetLastError();
        grid = (per_cu >= 1) ? cus : -1;
    }
    if (grid <= 0) return;
    (void)hipMemsetAsync(d_ws, 0, 65536, stream);
    mega<<<grid, OPT_THREADS, LDS_BYTES, stream>>>(p);
}
#endif
```
